# Optimizing an MI355X kernel written in HIP

```python
import math
import jax, jax.numpy as jnp
from jax import lax
import numpy as np

D_MODEL = 1024
BATCH = 16
SEQ = 256
DEPTH = 2
DEC_BATCH = 4
DEC_SEQ = 2048
PAST_LEN = 512

GRID_W = 64
N_EVEN = (DEPTH + 1) // 2
N_ODD = DEPTH // 2
MLSTM_HEADS = 4
MLSTM_WIDTH = D_MODEL // 2
MLSTM_HD = MLSTM_WIDTH // MLSTM_HEADS
MLSTM_CHUNK = 64
HYENA_WIDTH = D_MODEL // 2
N_BANDS = 16
FILTER_EMB = 2 * N_BANDS + 1
FILTER_HIDDEN = 64
DECAY_FAST = 0.3
DECAY_SLOW = 1.5
DECAY_TARGET = 1e-2
NA_HEADS = 16
NA_HD = D_MODEL // NA_HEADS
NA_KH = 8
NA_KW = 16
Q_BLOCK = 128
FF = 2816
CONV_W = 3
EPS = 1e-6
IN_AB = 4 * MLSTM_WIDTH + 4 * MLSTM_HEADS + 3 * HYENA_WIDTH

kernel_name = 'hybrid_mlstm_hyena_natten_dit_step'

F32 = jnp.float32


def rmsnorm(x, g):
    x32 = x.astype(F32)
    y = x32 * lax.rsqrt(jnp.mean(x32 * x32, axis=-1, keepdims=True) + EPS)
    return (y * g.astype(F32)).astype(x.dtype)


def dwconv3(x, w):
    xp = jnp.pad(x, ((0, 0), (1, 1), (0, 0)))
    return xp[:, :-2] * w[0] + xp[:, 1:-1] * w[1] + xp[:, 2:] * w[2]


def adaln(cvec, w, b):
    mod = jax.nn.silu(cvec) @ w + b
    return jnp.split(mod[:, None, :], 6, axis=-1)


def mlstm_chunked(q, k, v, ig, lf, C0, n0, m0):
    B, H, L, d = q.shape
    nc = L // MLSTM_CHUNK

    def to_chunks(t):
        return jnp.moveaxis(t.reshape((B, H, nc, MLSTM_CHUNK) + t.shape[3:]), 2, 0)

    lower = jnp.tril(jnp.ones((MLSTM_CHUNK, MLSTM_CHUNK), dtype=bool))

    def step(carry, xs):
        C, n, m = carry
        qc, kc, vc, ic, fc = xs
        b = jnp.cumsum(fc, axis=-1)
        dmat = jnp.where(lower, b[..., :, None] - b[..., None, :] + ic[..., None, :], -jnp.inf)
        m_inter = b + m[..., None]
        m_t = jnp.maximum(m_inter, jnp.max(dmat, axis=-1))
        s = jnp.exp(dmat - m_t[..., None]) * jnp.einsum('bhtd,bhsd->bhts', qc, kc)
        sc = jnp.exp(m_inter - m_t)
        num = sc[..., None] * jnp.einsum('bhtd,bhde->bhte', qc, C) + jnp.einsum('bhts,bhse->bhte', s, vc)
        den = sc * jnp.einsum('bhtd,bhd->bht', qc, n) + jnp.sum(s, axis=-1)
        hc = num / jnp.maximum(jnp.abs(den), jnp.exp(-m_t))[..., None]
        b_end = b[..., -1]
        to_end = b_end[..., None] - b + ic
        m_new = jnp.maximum(b_end + m, jnp.max(to_end, axis=-1))
        w = jnp.exp(to_end - m_new[..., None])
        decay = jnp.exp(b_end + m - m_new)
        C_new = decay[..., None, None] * C + jnp.einsum('bhs,bhsd,bhse->bhde', w, kc, vc)
        n_new = decay[..., None] * n + jnp.einsum('bhs,bhsd->bhd', w, kc)
        return (C_new, n_new, m_new), hc

    xs = (to_chunks(q), to_chunks(k), to_chunks(v), to_chunks(ig), to_chunks(lf))
    (C, n, m), hs = lax.scan(step, (C0, n0, m0), xs)
    return jnp.moveaxis(hs, 0, 2).reshape(B, H, L, d), (C, n, m)


def mlstm_bidir(q, k, v, gates, state0):
    B, L, _ = q.shape

    def heads(t):
        return t.astype(F32).reshape(B, L, MLSTM_HEADS, MLSTM_HD).transpose(0, 2, 1, 3)

    qh, kh, vh = heads(q), heads(k) * (MLSTM_HD ** -0.5), heads(v)
    g = gates.astype(F32).transpose(0, 2, 1)
    i_f, f_f, i_b, f_b = jnp.split(g, 4, axis=1)
    C0, n0, m0 = state0[0].astype(F32), state0[1].astype(F32), state0[2].astype(F32)
    h_f, (Cf, nf, mf) = mlstm_chunked(qh, kh, vh, i_f, jax.nn.log_sigmoid(f_f), C0[:, 0], n0[:, 0], m0[:, 0])

    def flip(t):
        return jnp.flip(t, axis=2)

    h_b, (Cb, nb, mb) = mlstm_chunked(flip(qh), flip(kh), flip(vh), flip(i_b), flip(jax.nn.log_sigmoid(f_b)),
                                      C0[:, 1], n0[:, 1], m0[:, 1])
    h = h_f + flip(h_b)
    state = (jnp.stack([Cf, Cb], axis=1), jnp.stack([nf, nb], axis=1), jnp.stack([mf, mb], axis=1))
    return h, state


def hyena_filters(L, w1, b1, w2, b2, w3, freq):
    t = jnp.linspace(0.0, 1.0, L, dtype=F32)[:, None]
    wpos = 2.0 * math.pi * jnp.arange(L, dtype=F32)[:, None] / L
    bands = jnp.linspace(1e-4, N_BANDS - 1, N_BANDS, dtype=F32)[None, :]
    z = jnp.concatenate([t, jnp.cos(bands * wpos), -jnp.sin(bands * wpos)], axis=-1)
    fr = freq.astype(F32)
    hdn = jnp.sin(fr * (z @ w1.astype(F32) + b1.astype(F32)))
    hdn = jnp.sin(fr * (hdn @ w2.astype(F32) + b2.astype(F32)))
    filt = hdn @ w3.astype(F32)
    max_decay = math.log(DECAY_TARGET) / DECAY_FAST
    min_decay = math.log(DECAY_TARGET) / DECAY_SLOW
    deltas = jnp.abs(jnp.linspace(min_decay, max_decay, HYENA_WIDTH, dtype=F32))
    decay = jnp.exp(-t * jnp.concatenate([deltas, deltas])[None, :])
    filt = filt * decay
    return filt[:, :HYENA_WIDTH], filt[:, HYENA_WIDTH:]


def long_conv_bidir(u, h_past, h_future):
    B, L, C = u.shape
    two_sided = jnp.concatenate([h_past, jnp.zeros((1, C), F32), h_future[1:][::-1]], axis=0)
    U = jnp.fft.rfft(u, n=2 * L, axis=1)
    K = jnp.fft.rfft(two_sided, axis=0)
    return jnp.fft.irfft(U * K[None], n=2 * L, axis=1)[:, :L]


def mixer_ab(h, state0, w_in, b_gates, w_conv_qk, g_head, w_conv_hy, w_f1, b_f1, w_f2, b_f2, w_f3, freq,
             hy_bias, w_out):
    B, L, _ = h.shape
    MW = MLSTM_WIDTH
    proj = h @ w_in
    qk_raw = proj[..., :2 * MW]
    v_m = proj[..., 2 * MW:3 * MW]
    o_pre = proj[..., 3 * MW:4 * MW]
    gates = proj[..., 4 * MW:4 * MW + 4 * MLSTM_HEADS] + b_gates
    hy = proj[..., 4 * MW + 4 * MLSTM_HEADS:]
    qk = jax.nn.silu(dwconv3(qk_raw, w_conv_qk))
    hm, state = mlstm_bidir(qk[..., :MW], qk[..., MW:], v_m, gates, state0)
    hm = hm * lax.rsqrt(jnp.mean(hm * hm, axis=-1, keepdims=True) + EPS)
    hm = hm.transpose(0, 2, 1, 3).reshape(B, L, MW) * g_head.astype(F32)
    y_m = (hm * jax.nn.sigmoid(o_pre.astype(F32))).astype(h.dtype)
    hy = dwconv3(hy, w_conv_hy)
    v_h, x1, x2 = jnp.split(hy, 3, axis=-1)
    u = (x1 * v_h).astype(F32)
    h_past, h_future = hyena_filters(L, w_f1, b_f1, w_f2, b_f2, w_f3, freq)
    y_h = x2.astype(F32) * (long_conv_bidir(u, h_past, h_future) + hy_bias.astype(F32) * u)
    out = jnp.concatenate([y_m, y_h.astype(h.dtype)], axis=-1) @ w_out
    return out, (state[0].astype(h.dtype), state[1].astype(h.dtype), state[2].astype(h.dtype))


def na_heads(t):
    B, L, _ = t.shape
    return t.reshape(B, L, NA_HEADS, NA_HD).transpose(0, 2, 1, 3)


def dense_attention(q, k, v):
    B, H, L, d = q.shape
    nb = L // Q_BLOCK
    qb = jnp.moveaxis(q.reshape(B, H, nb, Q_BLOCK, d), 2, 0)

    def block(qi):
        s = jnp.einsum('bhqd,bhkd->bhqk', qi, k).astype(F32) * (d ** -0.5)
        p = jax.nn.softmax(s, axis=-1)
        return jnp.einsum('bhqk,bhkd->bhqd', p.astype(v.dtype), v)

    o = lax.map(block, qb)
    return jnp.moveaxis(o, 0, 2).reshape(B, H, L, d)


def mixer_c_context(h, w_in, w_out):
    B, L, _ = h.shape
    q, k, v = jnp.split(h @ w_in, 3, axis=-1)
    q, k, v = na_heads(q), na_heads(k), na_heads(v)
    o = dense_attention(q, k, v)
    return o.transpose(0, 2, 1, 3).reshape(B, L, D_MODEL) @ w_out, k, v


def na_attention(q, k, v, k_ctx, v_ctx, rpb):
    B, H, L, d = q.shape
    R = L // GRID_W
    kh = min(NA_KH, R)
    rows = jnp.arange(R)
    cols = jnp.arange(GRID_W)
    r_start = jnp.clip(rows - kh // 2, 0, R - kh)
    key_rows = r_start[:, None] + jnp.arange(kh)[None, :]
    c_start = jnp.clip(cols - NA_KW // 2, 0, GRID_W - NA_KW)
    col_mask = (cols[None, :] >= c_start[:, None]) & (cols[None, :] < c_start[:, None] + NA_KW)
    qg = q.reshape(B, H, R, GRID_W, d) * (d ** -0.5)
    kg = k.reshape(B, H, R, GRID_W, d)[:, :, key_rows]
    vg = v.reshape(B, H, R, GRID_W, d)[:, :, key_rows]
    s_loc = jnp.einsum('bhrqd,bhrjwd->bhrqjw', qg, kg).astype(F32)
    idx_r = key_rows - rows[:, None] + (NA_KH - 1)
    idx_c = jnp.clip(cols[None, :] - cols[:, None] + (NA_KW - 1), 0, 2 * NA_KW - 2)
    bias = rpb[:, idx_r[:, None, :, None], idx_c[None, :, None, :]]
    s_loc = jnp.where(col_mask[:, None, :], s_loc + bias.astype(F32)[None], -jnp.inf)
    s_ctx = jnp.einsum('bhrqd,bhnd->bhrqn', qg, k_ctx).astype(F32)
    n_loc = kh * GRID_W
    s = jnp.concatenate([s_loc.reshape(B, H, R, GRID_W, n_loc), s_ctx], axis=-1)
    p = jax.nn.softmax(s, axis=-1).astype(v.dtype)
    p_loc = p[..., :n_loc].reshape(B, H, R, GRID_W, kh, GRID_W)
    p_ctx = p[..., n_loc:]
    o = jnp.einsum('bhrqjw,bhrjwd->bhrqd', p_loc, vg) + jnp.einsum('bhrqn,bhnd->bhrqd', p_ctx, v_ctx)
    return o.reshape(B, H, L, d)


def mixer_c_latent(h, k_ctx, v_ctx, w_in, rpb, w_out):
    B, L, _ = h.shape
    q, k, v = jnp.split(h @ w_in, 3, axis=-1)
    o = na_attention(na_heads(q), na_heads(k), na_heads(v), k_ctx, v_ctx, rpb)
    return o.transpose(0, 2, 1, 3).reshape(B, L, D_MODEL) @ w_out


def conv_ffn(h, w_up, w_conv, w_down):
    a, g = jnp.split(h @ w_up, 2, axis=-1)
    return (jax.nn.gelu(dwconv3(a, w_conv)) * g) @ w_down


def setup_inputs(seed: int = 0) -> dict:
    key = jax.random.key(seed)
    ks = jax.random.split(key, 40)

    def nrm(i, shape, scale):
        return jax.random.normal(ks[i], shape, F32) * scale

    D = D_MODEL
    H = MLSTM_HEADS
    gate_noise = nrm(10, (N_EVEN, 4, H), 0.1)
    f_bias = jnp.linspace(3.0, 6.0, H, dtype=F32)[None, :]
    b_gates = jnp.concatenate([gate_noise[:, 0], gate_noise[:, 1] + f_bias,
                               gate_noise[:, 2], gate_noise[:, 3] + f_bias], axis=-1)
    return {
        'x_prompt': nrm(0, (BATCH, SEQ, D), 1.0),
        'x_sample': nrm(1, (DEC_BATCH, DEC_SEQ, D), 1.0),
        'state_mlstm_C': nrm(2, (DEC_BATCH, N_EVEN, 2, H, MLSTM_HD, MLSTM_HD), 0.1),
        'state_mlstm_n': nrm(3, (DEC_BATCH, N_EVEN, 2, H, MLSTM_HD), 0.1),
        'state_mlstm_m': nrm(4, (DEC_BATCH, N_EVEN, 2, H), 0.5),
        'cache_na_k': nrm(5, (DEC_BATCH, N_ODD, NA_HEADS, PAST_LEN, NA_HD), 1.0),
        'cache_na_v': nrm(6, (DEC_BATCH, N_ODD, NA_HEADS, PAST_LEN, NA_HD), 1.0),
        'c': nrm(7, (DEC_BATCH, D), 1.0),
        'c_ctx': nrm(8, (D,), 1.0),
        'w_ada': nrm(9, (DEPTH, D, 6 * D), D ** -0.5),
        'b_ada': nrm(11, (DEPTH, 6 * D), 0.02),
        'g_mix': 1.0 + nrm(12, (DEPTH, D), 0.05),
        'g_ffn': 1.0 + nrm(13, (DEPTH, D), 0.05),
        'g_final': 1.0 + nrm(14, (D,), 0.05),
        'w_in_ab': nrm(15, (N_EVEN, D, IN_AB), D ** -0.5),
        'b_gates': b_gates,
        'w_conv_qk': nrm(16, (N_EVEN, CONV_W, 2 * MLSTM_WIDTH), 0.5),
        'g_mlstm': 1.0 + nrm(17, (N_EVEN, MLSTM_WIDTH), 0.05),
        'w_conv_hy': nrm(18, (N_EVEN, CONV_W, 3 * HYENA_WIDTH), 0.5),
        'w_filt1': nrm(19, (N_EVEN, FILTER_EMB, FILTER_HIDDEN), FILTER_EMB ** -0.5),
        'b_filt1': nrm(20, (N_EVEN, FILTER_HIDDEN), 0.1),
        'w_filt2': nrm(21, (N_EVEN, FILTER_HIDDEN, FILTER_HIDDEN), FILTER_HIDDEN ** -0.5),
        'b_filt2': nrm(22, (N_EVEN, FILTER_HIDDEN), 0.1),
        'w_filt3': nrm(23, (N_EVEN, FILTER_HIDDEN, 2 * HYENA_WIDTH), 0.01),
        'filt_freq': 1.0 + nrm(24, (N_EVEN, FILTER_HIDDEN), 0.1),
        'hyena_bias': nrm(25, (N_EVEN, HYENA_WIDTH), 0.5),
        'w_out_ab': nrm(26, (N_EVEN, D, D), D ** -0.5),
        'w_in_c': nrm(27, (N_ODD, D, 3 * D), D ** -0.5),
        'rpb_c': nrm(28, (N_ODD, NA_HEADS, 2 * NA_KH - 1, 2 * NA_KW - 1), 0.1),
        'w_out_c': nrm(29, (N_ODD, D, D), D ** -0.5),
        'w_up': nrm(30, (DEPTH, D, 2 * FF), D ** -0.5),
        'w_conv_ffn': nrm(31, (DEPTH, CONV_W, FF), 0.5),
        'w_down': nrm(32, (DEPTH, FF, D), FF ** -0.5),
    }


def reference(x_prompt, x_sample, state_mlstm_C, state_mlstm_n, state_mlstm_m, cache_na_k, cache_na_v, c, c_ctx,
              w_ada, b_ada, g_mix, g_ffn, g_final, w_in_ab, b_gates, w_conv_qk, g_mlstm, w_conv_hy,
              w_filt1, b_filt1, w_filt2, b_filt2, w_filt3, filt_freq, hyena_bias, w_out_ab,
              w_in_c, rpb_c, w_out_c, w_up, w_conv_ffn, w_down):
    xp, xs = x_prompt, x_sample
    Bp = xp.shape[0]
    zero_state = (jnp.zeros((Bp, 2, MLSTM_HEADS, MLSTM_HD, MLSTM_HD), xp.dtype),
                  jnp.zeros((Bp, 2, MLSTM_HEADS, MLSTM_HD), xp.dtype),
                  jnp.zeros((Bp, 2, MLSTM_HEADS), xp.dtype))
    new_C, new_n, new_m, new_k, new_v = [], [], [], [], []
    for l in range(DEPTH):
        sh_p1, sc_p1, gt_p1, sh_p2, sc_p2, gt_p2 = adaln(c_ctx[None, :], w_ada[l], b_ada[l])
        sh_s1, sc_s1, gt_s1, sh_s2, sc_s2, gt_s2 = adaln(c, w_ada[l], b_ada[l])
        hp = rmsnorm(xp, g_mix[l]) * (1.0 + sc_p1) + sh_p1
        hs = rmsnorm(xs, g_mix[l]) * (1.0 + sc_s1) + sh_s1
        e = l // 2
        if l % 2 == 0:
            ab = (w_in_ab[e], b_gates[e], w_conv_qk[e], g_mlstm[e], w_conv_hy[e], w_filt1[e], b_filt1[e],
                  w_filt2[e], b_filt2[e], w_filt3[e], filt_freq[e], hyena_bias[e], w_out_ab[e])
            op, (Cp, np_, mp) = mixer_ab(hp, zero_state, *ab)
            os_, _ = mixer_ab(hs, (state_mlstm_C[:, e], state_mlstm_n[:, e], state_mlstm_m[:, e]), *ab)
            new_C.append(Cp)
            new_n.append(np_)
            new_m.append(mp)
        else:
            op, kp, vp = mixer_c_context(hp, w_in_c[e], w_out_c[e])
            os_ = mixer_c_latent(hs, cache_na_k[:, e], cache_na_v[:, e], w_in_c[e], rpb_c[e], w_out_c[e])
            new_k.append(kp)
            new_v.append(vp)
        xp = xp + gt_p1 * op
        xs = xs + gt_s1 * os_
        xp = xp + gt_p2 * conv_ffn(rmsnorm(xp, g_ffn[l]) * (1.0 + sc_p2) + sh_p2, w_up[l], w_conv_ffn[l], w_down[l])
        xs = xs + gt_s2 * conv_ffn(rmsnorm(xs, g_ffn[l]) * (1.0 + sc_s2) + sh_s2, w_up[l], w_conv_ffn[l], w_down[l])
    y_prompt = rmsnorm(xp, g_final)
    y_sample = rmsnorm(xs, g_final)
    new_state_mlstm_C = jnp.stack(new_C, axis=1)
    new_state_mlstm_n = jnp.stack(new_n, axis=1)
    new_state_mlstm_m = jnp.stack(new_m, axis=1)
    new_cache_na_k = jnp.stack(new_k, axis=1)
    new_cache_na_v = jnp.stack(new_v, axis=1)
    return (y_prompt, y_sample, new_state_mlstm_C, new_state_mlstm_n, new_state_mlstm_m, new_cache_na_k, new_cache_na_v)
```

```cpp
#include <hip/hip_runtime.h>
#include <cstdio>
#include <cstdint>
namespace pg8 {
#define PG8_LAS __attribute__((address_space(3)))
typedef unsigned short bf16_t;
typedef short bf16x8 __attribute__((ext_vector_type(8)));
typedef float f32x4 __attribute__((ext_vector_type(4)));
typedef unsigned u32x4 __attribute__((ext_vector_type(4)));
constexpr int BM = 256, BK = 64, HALF = 128, HTB = HALF * BK * 2  , STAGE_BYTES = 8 * HTB, NXCD = 8, WGM = 8;

__host__ __device__ __forceinline__ int lds_byte(int r, int c) { const int st = (r >> 4) * 2 + (c >> 5), rr = r & 15, cc = c & 31, ob = rr * 64 + cc * 2; return st * 1024 + (ob ^ (((ob >> 9) & 1) << 5)); }
__host__ __device__ __forceinline__ void stage_rc(int b, int& R, int& C) { const int st = b / 1024, sb = b % 1024, swz = sb ^ (((sb >> 9) & 1) << 5); R = (st >> 1) * 16 + swz / 64; C = (st & 1) * 32 + (swz % 64) / 2; }
__host__ __device__ __forceinline__ int perm32(int rho) { const int n = rho >> 4, i = rho & 15; return 8 * (i >> 2) + 4 * n + (i & 3); }

struct Unit { int pm, pn; };
struct Gemm { const bf16_t* A; const bf16_t* Bt; int M, N, K; };

struct StaticOrder {
    int nM, nN, nwg, G, c;
    __host__ __device__ void init(int M, int N, int G_, int c_) { nM = M / BM; nN = N / BM; nwg = nM * nN; G = G_; c = c_; }
    __host__ __device__ bool next(int i, Unit& u) const {
        const long L = (long)i * G + c; if (L >= nwg) return false;
        int wgid = (int)L; { const int q = nwg / NXCD, r = nwg % NXCD, xcd = wgid % NXCD, off = wgid / NXCD; wgid = (xcd < r ? xcd * (q + 1) : r * (q + 1) + (xcd - r) * q) + off; }
        const int nig = WGM * nN, gid = wgid / nig, fm = gid * WGM, gsz = (nM - fm) < WGM ? (nM - fm) : WGM;
        u.pm = fm + ((wgid % nig) % gsz); u.pn = (wgid % nig) / gsz; return true;
    }
    __device__ __forceinline__ void a_ready(const Unit&) const {}
    __device__ __forceinline__ void done(const Unit&) const {}
};

__device__ __forceinline__ unsigned cvt_pk_bf16(float lo, float hi) { unsigned r; asm volatile("v_cvt_pk_bf16_f32 %0, %1, %2" : "=v"(r) : "v"(lo), "v"(hi)); return r; }
typedef float f32x2 __attribute__((ext_vector_type(2)));
__device__ __forceinline__ f32x2 gelu_pk(f32x2 v) {
    const f32x2 av = __builtin_elementwise_abs(v), d = av * 0.2316418882f + 1.0f;
    f32x2 t; t.x = __builtin_amdgcn_rcpf(d.x); t.y = __builtin_amdgcn_rcpf(d.y);
    f32x2 q = t * 0.5307027145f + (-0.7265760135f); q = q * t + 0.7107068705f; q = q * t + (-0.142248368f); q = q * t + 0.127414796f; q = q * t;
    const f32x2 s = (v * v) * (-0.72134752044f);
    f32x2 e; e.x = __builtin_amdgcn_exp2f(s.x); e.y = __builtin_amdgcn_exp2f(s.y);
    const f32x2 m = v * (q * e), r = v - m;
    f32x2 o; o.x = v.x < 0.f ? m.x : r.x; o.y = v.y < 0.f ? m.y : r.y; return o;
}

template <int ACT  > struct EpiBf16 {
    static constexpr bool PERM = true, AFTER_DRAIN = false; static_assert(ACT == 0 || ACT == 1, "EpiBf16: ACT is 0 (none) or 1 (gelu_pk)");
    bf16_t* O; int ldc; const float* bias; int split_cols; size_t split_stride; float scale0;
    __device__ __forceinline__ void operator()(const f32x4 (&acc)[2][2][4][2], const Unit& u, int wr, int wc, int fr, int fq) const {
        const int row0 = u.pm * BM + wr * 64 + fr; int colt = u.pn * BM; bf16_t* base = O;
        float sc = 1.f; if (split_cols) { const int t = colt / split_cols; base += (size_t)t * split_stride; colt -= t * split_cols; if (t == 0) sc = scale0; }
        const int col0 = colt + wc * 32 + 8 * fq, bcol0 = u.pn * BM + wc * 32 + 8 * fq;
        f32x4 bv[2][2];
#pragma unroll
        for (int bj = 0; bj < 2; ++bj)
#pragma unroll
            for (int n = 0; n < 2; ++n) bv[bj][n] = bias ? *(const f32x4*)(bias + bcol0 + bj * HALF + 4 * n) : (f32x4){0.f, 0.f, 0.f, 0.f};
#pragma unroll
        for (int ai = 0; ai < 2; ++ai)
#pragma unroll
            for (int m = 0; m < 4; ++m) { bf16_t* rowp = base + (size_t)(row0 + ai * HALF + m * 16) * ldc + col0;
#pragma unroll
                for (int bj = 0; bj < 2; ++bj) { f32x4 v0 = acc[ai][bj][m][0] + bv[bj][0], v1 = acc[ai][bj][m][1] + bv[bj][1];
                    if (ACT == 1) { f32x2 a = gelu_pk((f32x2){v0[0], v0[1]}), b = gelu_pk((f32x2){v0[2], v0[3]}), c = gelu_pk((f32x2){v1[0], v1[1]}), d = gelu_pk((f32x2){v1[2], v1[3]});
                        v0 = (f32x4){a.x, a.y, b.x, b.y}; v1 = (f32x4){c.x, c.y, d.x, d.y}; }
                    v0 = v0 * sc; v1 = v1 * sc; u32x4 w; w.x = cvt_pk_bf16(v0[0], v0[1]); w.y = cvt_pk_bf16(v0[2], v0[3]); w.z = cvt_pk_bf16(v1[0], v1[1]); w.w = cvt_pk_bf16(v1[2], v1[3]);
                    *(u32x4*)(rowp + bj * HALF) = w; } }
    }
};
typedef float f32x2e __attribute__((ext_vector_type(2)));
typedef __bf16 bf2e __attribute__((ext_vector_type(2)));
__device__ __forceinline__ unsigned pkbf(float lo, float hi) { f32x2e v = {lo, hi}; bf2e b = __builtin_convertvector(v, bf2e); return __builtin_bit_cast(unsigned, b); }
struct EpiProj {
    static constexpr bool PERM = true, AFTER_DRAIN = false;
    bf16_t* O; int ldc; float* gates; int gate_pn;
    __device__ __forceinline__ void operator()(const f32x4 (&acc)[2][2][4][2], const Unit& u, int wr, int wc, int fr, int fq) const {
        const int row0 = u.pm * BM + wr * 64 + fr, col0 = u.pn * BM + wc * 32 + 8 * fq;
        const bool gt = (u.pn == gate_pn) && (wc == 0) && (fq < 2);
#pragma unroll
        for (int ai = 0; ai < 2; ++ai)
#pragma unroll
            for (int m = 0; m < 4; ++m) { const int row = row0 + ai * HALF + m * 16; bf16_t* rowp = O + (size_t)row * ldc + col0;
#pragma unroll
                for (int bj = 0; bj < 2; ++bj) { const f32x4 v0 = acc[ai][bj][m][0], v1 = acc[ai][bj][m][1];
                    u32x4 w; w.x = pkbf(v0[0], v0[1]); w.y = pkbf(v0[2], v0[3]); w.z = pkbf(v1[0], v1[1]); w.w = pkbf(v1[2], v1[3]);
                    *(u32x4*)(rowp + bj * HALF) = w;
                    if (bj == 0 && gt) { *(f32x4*)(gates + (size_t)row * 16 + 8 * fq) = v0; *(f32x4*)(gates + (size_t)row * 16 + 8 * fq + 4) = v1; } } }
    }
};
struct EpiDelta {
    static constexpr bool PERM = true, AFTER_DRAIN = false;
    bf16_t* Dl; const float* gate5;
    __device__ __forceinline__ void operator()(const f32x4 (&acc)[2][2][4][2], const Unit& u, int wr, int wc, int fr, int fq) const {
        const int row0 = u.pm * BM + wr * 64 + fr, col0 = u.pn * BM + wc * 32 + 8 * fq;
        const int v = u.pm < 16 ? 4 : ((u.pm - 16) >> 3);
        const float* g = gate5 + (size_t)v * 6144;
        f32x4 gv[2][2];
#pragma unroll
        for (int bj = 0; bj < 2; ++bj)
#pragma unroll
            for (int n = 0; n < 2; ++n) gv[bj][n] = *(const f32x4*)(g + col0 + bj * HALF + 4 * n);
#pragma unroll
        for (int ai = 0; ai < 2; ++ai)
#pragma unroll
            for (int m = 0; m < 4; ++m) { bf16_t* rowp = Dl + (size_t)(row0 + ai * HALF + m * 16) * 1024 + col0;
#pragma unroll
                for (int bj = 0; bj < 2; ++bj) { const f32x4 v0 = acc[ai][bj][m][0] * gv[bj][0], v1 = acc[ai][bj][m][1] * gv[bj][1];
                    u32x4 w; w.x = pkbf(v0[0], v0[1]); w.y = pkbf(v0[2], v0[3]); w.z = pkbf(v1[0], v1[1]); w.w = pkbf(v1[2], v1[3]);
                    *(u32x4*)(rowp + bj * HALF) = w; } }
    }
};
struct EpiQKV {
    static constexpr bool PERM = true, AFTER_DRAIN = false;
    bf16_t* Q; size_t qkv_stride; float* outk; size_t kv_stride;
    __device__ __forceinline__ void operator()(const f32x4 (&acc)[2][2][4][2], const Unit& u, int wr, int wc, int fr, int fq) const {
        const int t = u.pn >> 2; const int colt = (u.pn & 3) * BM;
        bf16_t* base = Q + (size_t)t * qkv_stride; float* fo = outk + (size_t)(t == 2 ? 1 : 0) * kv_stride; const float sc = t == 0 ? 0.18033688011112042f : 1.0f;
        const int row0 = u.pm * BM + wr * 64 + fr, col0 = colt + wc * 32 + 8 * fq;
        const bool cache = (t != 0) && (u.pm < 16);
#pragma unroll
        for (int ai = 0; ai < 2; ++ai)
#pragma unroll
            for (int m = 0; m < 4; ++m) { const int row = row0 + ai * HALF + m * 16; bf16_t* rowp = base + (size_t)row * 1024 + col0;
#pragma unroll
                for (int bj = 0; bj < 2; ++bj) { const f32x4 v0 = acc[ai][bj][m][0] * sc, v1 = acc[ai][bj][m][1] * sc;
                    u32x4 w; w.x = pkbf(v0[0], v0[1]); w.y = pkbf(v0[2], v0[3]); w.z = pkbf(v1[0], v1[1]); w.w = pkbf(v1[2], v1[3]);
                    *(u32x4*)(rowp + bj * HALF) = w;
                    if (cache) { const int col = col0 + bj * HALF, hh = col >> 6, d = col & 63, b = row >> 8, tt = row & 255;
                        float* p = fo + ((size_t)((b * 16 + hh) * 256 + tt)) * 64 + d; *(f32x4*)p = v0; *(f32x4*)(p + 4) = v1; } } }
    }
};
template <int CTRL> __device__ __forceinline__ float dpp_mov(float old, float src) {
    return __builtin_bit_cast(float, __builtin_amdgcn_update_dpp(__builtin_bit_cast(int, old), __builtin_bit_cast(int, src), CTRL, 0xF, 0xF, false)); }
struct EpiFfn {
    static constexpr bool PERM = true, AFTER_DRAIN = false;
    bf16_t* act; const float* wconv; float* abnd; float* gbnd; PG8_LAS float* xch;
    __device__ __forceinline__ void operator()(const f32x4 (&acc)[2][2][4][2], const Unit& u, int wr, int wc, int fr, int fq) const {
        constexpr int FFW = 2816;
        const int cl = 32 * wc + 8 * fq, col8 = 128 * u.pn + cl;
        float w0[8], w1[8], w2[8];
        { const f32x4 a0 = *(const f32x4*)(wconv + col8), a1 = *(const f32x4*)(wconv + col8 + 4), b0 = *(const f32x4*)(wconv + FFW + col8), b1 = *(const f32x4*)(wconv + FFW + col8 + 4),
                      c0 = *(const f32x4*)(wconv + 2 * FFW + col8), c1 = *(const f32x4*)(wconv + 2 * FFW + col8 + 4);
#pragma unroll
          for (int i = 0; i < 4; ++i) { w0[i] = a0[i]; w0[4 + i] = a1[i]; w1[i] = b0[i]; w1[4 + i] = b1[i]; w2[i] = c0[i]; w2[4 + i] = c1[i]; } }
#pragma unroll
        for (int ai = 0; ai < 2; ++ai) { const int s = ai * 2 + wr;
            if (fr == 0) { *(PG8_LAS f32x4*)(xch + (s * 2 + 0) * 128 + cl) = acc[ai][0][0][0]; *(PG8_LAS f32x4*)(xch + (s * 2 + 0) * 128 + cl + 4) = acc[ai][0][0][1]; }
            if (fr == 15) { *(PG8_LAS f32x4*)(xch + (s * 2 + 1) * 128 + cl) = acc[ai][0][3][0]; *(PG8_LAS f32x4*)(xch + (s * 2 + 1) * 128 + cl + 4) = acc[ai][0][3][1]; } }
        asm volatile("s_waitcnt lgkmcnt(0)" ::: "memory"); __builtin_amdgcn_s_barrier(); asm volatile("" ::: "memory");
#pragma unroll
        for (int ai = 0; ai < 2; ++ai) { const int s = ai * 2 + wr;
            f32x4 up[2], dn[2];
#pragma unroll
            for (int n = 0; n < 2; ++n) { up[n] = s > 0 ? *(const PG8_LAS f32x4*)(xch + ((s - 1) * 2 + 1) * 128 + cl + 4 * n) : (f32x4){0.f, 0.f, 0.f, 0.f};
                                          dn[n] = s < 3 ? *(const PG8_LAS f32x4*)(xch + ((s + 1) * 2 + 0) * 128 + cl + 4 * n) : (f32x4){0.f, 0.f, 0.f, 0.f}; }
#pragma unroll
            for (int m = 0; m < 4; ++m) { const int row = u.pm * BM + ai * HALF + wr * 64 + m * 16 + fr; float o[8];
#pragma unroll
                for (int n = 0; n < 2; ++n)
#pragma unroll
                    for (int i = 0; i < 4; ++i) { const float cur = acc[ai][0][m][n][i];
                        const float pold = m > 0 ? dpp_mov<0x121>(0.f, acc[ai][0][m > 0 ? m - 1 : 0][n][i]) : up[n][i];
                        const float prev = dpp_mov<0x111>(pold, cur);
                        const float nold = m < 3 ? dpp_mov<0x12F>(0.f, acc[ai][0][m < 3 ? m + 1 : 3][n][i]) : dn[n][i];
                        const float next = dpp_mov<0x101>(nold, cur);
                        const float v = w0[4 * n + i] * prev + w1[4 * n + i] * cur + w2[4 * n + i] * next;
                        const float u2 = v * (-2.3022081981f + -0.1029432396f * v * v);
                        o[4 * n + i] = v * __builtin_amdgcn_rcpf(1.f + __builtin_amdgcn_exp2f(u2)) * acc[ai][1][m][n][i]; }
                const bool edge = (s == 0 && m == 0 && fr == 0) || (s == 3 && m == 3 && fr == 15);
                if (!edge) { u32x4 w; w.x = pkbf(o[0], o[1]); w.y = pkbf(o[2], o[3]); w.z = pkbf(o[4], o[5]); w.w = pkbf(o[6], o[7]); *(u32x4*)(act + (size_t)row * FFW + col8) = w; }
                if (s == 0 && m == 0 && fr < 2) { float* p = abnd + ((size_t)(u.pm * 4 + fr)) * FFW + col8; *(f32x4*)p = acc[ai][0][m][0]; *(f32x4*)(p + 4) = acc[ai][0][m][1];
                    if (fr == 0) { float* q = gbnd + ((size_t)(u.pm * 2 + 0)) * FFW + col8; *(f32x4*)q = acc[ai][1][m][0]; *(f32x4*)(q + 4) = acc[ai][1][m][1]; } }
                if (s == 3 && m == 3 && fr >= 14) { float* p = abnd + ((size_t)(u.pm * 4 + 2 + (fr - 14))) * FFW + col8; *(f32x4*)p = acc[ai][0][m][0]; *(f32x4*)(p + 4) = acc[ai][0][m][1];
                    if (fr == 15) { float* q = gbnd + ((size_t)(u.pm * 2 + 1)) * FFW + col8; *(f32x4*)q = acc[ai][1][m][0]; *(f32x4*)(q + 4) = acc[ai][1][m][1]; } }
            }
        }
    }
};
template <class Epi, class Sched, bool ALIGN_EPI = false, bool SP2 = false>
__device__ __forceinline__ void gemm_phase(PG8_LAS unsigned char* lds, const Gemm g, const Sched& S, const Epi& E) {
    const int tid = threadIdx.x, wid = __builtin_amdgcn_readfirstlane(tid >> 6), lane = tid & 63, wr = wid >> 2, wc = wid & 3, fr = lane & 15, fq = lane >> 4;
    const int K = g.K, nt = K / BK;
    unsigned voffA[2], voffB[2];
#pragma unroll
    for (int i = 0; i < 2; ++i) { int R, C; stage_rc(tid * 16 + i * 8192, R, C); const int Rb = Epi::PERM ? ((R & ~31) + perm32(R & 31)) : R;
        voffA[i] = (unsigned)(R * K + C) * 2u; voffB[i] = (unsigned)(Rb * K + C) * 2u; }
    const size_t kstep = (size_t)(BK * 2);
    const size_t hstep = (size_t)HALF * K * 2;
    const size_t tstep = 2 * hstep;
    const unsigned ldsw = (unsigned)wid * 1024u;
    const int aoff = lds_byte(wr * 64 + fr, fq * 8), boff = lds_byte(wc * 32 + fr, fq * 8);
#define PG8_SA(b, h) (((b) * 2 + (h)) * HTB)
#define PG8_SB(b, h) ((4 + (b) * 2 + (h)) * HTB)
#define PG8_STAGE(bufoff, gbase, voff) do { _Pragma("unroll") for (int _i = 0; _i < 2; ++_i) \
        __builtin_amdgcn_global_load_lds((const unsigned*)((const char*)(gbase) + (voff)[_i]), (PG8_LAS unsigned*)(lds + (bufoff) + ldsw + _i * 8192), 16, 0, 0); } while (0)
#define PG8_LDA(dst, b, h) do { _Pragma("unroll") for (int m = 0; m < 4; ++m) _Pragma("unroll") for (int k = 0; k < 2; ++k) dst[m][k] = *(const PG8_LAS bf16x8*)(lds + PG8_SA(b, h) + aoff + m * 2048 + k * 1024); } while (0)
#define PG8_LDB(dst, b, h) do { _Pragma("unroll") for (int n = 0; n < 2; ++n) _Pragma("unroll") for (int k = 0; k < 2; ++k) dst[n][k] = *(const PG8_LAS bf16x8*)(lds + PG8_SB(b, h) + boff + n * 2048 + k * 1024); } while (0)
#define PG8_MMA(ai, bj, At, Bt) do { __builtin_amdgcn_s_setprio(1); _Pragma("unroll") for (int m = 0; m < 4; ++m) _Pragma("unroll") for (int n = 0; n < 2; ++n) _Pragma("unroll") for (int k = 0; k < 2; ++k) \
        acc[ai][bj][m][n] = __builtin_amdgcn_mfma_f32_16x16x32_bf16(Bt[n][k], At[m][k], acc[ai][bj][m][n], 0, 0, 0); __builtin_amdgcn_s_setprio(0); } while (0)
#define PG8_WAIT_V(n) asm volatile("s_waitcnt vmcnt(" #n ")" ::: "memory")
#define PG8_WAIT_L(n) asm volatile("s_waitcnt lgkmcnt(" #n ")" ::: "memory")
#define PG8_BAR __builtin_amdgcn_s_barrier()
#define PG8_SCHED __builtin_amdgcn_sched_barrier(0)
    Unit cur, nxt; int ui = 0;
    if (!S.next(0, cur)) return;
    f32x4 acc[2][2][4][2];
#pragma unroll
    for (int a = 0; a < 2; ++a)
#pragma unroll
        for (int b = 0; b < 2; ++b)
#pragma unroll
            for (int m = 0; m < 4; ++m)
#pragma unroll
                for (int n = 0; n < 2; ++n) acc[a][b][m][n] = (f32x4){0.f, 0.f, 0.f, 0.f};
    bf16x8 At[4][2], B0[2][2], B1[2][2];
    const char* cA = (const char*)g.A + (size_t)cur.pm * tstep; const char* cB = (const char*)g.Bt + (size_t)cur.pn * tstep;
    S.a_ready(cur);
    if constexpr (SP2) {
        PG8_STAGE(PG8_SB(0, 0), cB, voffB); PG8_STAGE(PG8_SB(0, 1), cB + hstep, voffB); PG8_STAGE(PG8_SA(0, 0), cA, voffA); PG8_STAGE(PG8_SA(0, 1), cA + hstep, voffA);
        if (wr == 1) PG8_BAR;
        PG8_WAIT_V(2); PG8_BAR;
        PG8_STAGE(PG8_SB(1, 0), cB + kstep, voffB); PG8_STAGE(PG8_SA(1, 0), cA + kstep, voffA); PG8_STAGE(PG8_SB(1, 1), cB + hstep + kstep, voffB);
        PG8_WAIT_V(6); PG8_BAR;
    } else {
        PG8_STAGE(PG8_SB(0, 0), cB, voffB); PG8_STAGE(PG8_SA(0, 0), cA, voffA); PG8_STAGE(PG8_SB(0, 1), cB + hstep, voffB); PG8_STAGE(PG8_SA(0, 1), cA + hstep, voffA);
        if (wr == 1) PG8_BAR;
        PG8_WAIT_V(4); PG8_BAR;
        PG8_STAGE(PG8_SB(1, 0), cB + kstep, voffB); PG8_STAGE(PG8_SA(1, 0), cA + kstep, voffA); PG8_STAGE(PG8_SB(1, 1), cB + hstep + kstep, voffB);
        PG8_WAIT_V(6); PG8_BAR;
    }
    for (;;) {
        const bool has_next = S.next(ui + 1, nxt);
        const char* nA = has_next ? (const char*)g.A + (size_t)nxt.pm * tstep : cA; const char* nB = has_next ? (const char*)g.Bt + (size_t)nxt.pn * tstep : cB;
        for (int t = 0; t < nt; t += 2) {
            const bool last = (t == nt - 2);
            const char* a1 = cA + (size_t)(t + 1) * kstep;
            const char* a2 = last ? nA : cA + (size_t)(t + 2) * kstep; const char* b2 = last ? nB : cB + (size_t)(t + 2) * kstep;
            const char* a3 = a2 + kstep; const char* b3 = b2 + kstep;
            if (last && has_next) S.a_ready(nxt);
            if constexpr (SP2) {
            PG8_LDB(B0, 0, 0); PG8_LDB(B1, 0, 1); PG8_SCHED; PG8_LDA(At, 0, 0); PG8_STAGE(PG8_SA(1, 1), a1 + hstep, voffA);
            PG8_WAIT_V(8); PG8_WAIT_L(0); PG8_BAR; PG8_MMA(0, 0, At, B0); PG8_MMA(0, 1, At, B1); PG8_BAR; PG8_SCHED;
            PG8_LDA(At, 0, 1); PG8_STAGE(PG8_SB(0, 0), b2, voffB); PG8_STAGE(PG8_SB(0, 1), b2 + hstep, voffB); PG8_STAGE(PG8_SA(0, 0), a2, voffA);
            PG8_WAIT_V(8); PG8_WAIT_L(0); PG8_BAR; PG8_MMA(1, 0, At, B0); PG8_MMA(1, 1, At, B1); PG8_BAR; PG8_SCHED;
            PG8_LDB(B0, 1, 0); PG8_LDB(B1, 1, 1); PG8_SCHED; PG8_LDA(At, 1, 0); PG8_STAGE(PG8_SA(0, 1), a2 + hstep, voffA);
            PG8_WAIT_V(8); PG8_WAIT_L(0); PG8_BAR; PG8_MMA(0, 0, At, B0); PG8_MMA(0, 1, At, B1); PG8_BAR; PG8_SCHED;
            PG8_LDA(At, 1, 1); PG8_STAGE(PG8_SB(1, 0), b3, voffB); PG8_STAGE(PG8_SB(1, 1), b3 + hstep, voffB); PG8_STAGE(PG8_SA(1, 0), a3, voffA);
            PG8_WAIT_V(8); PG8_WAIT_L(0); PG8_BAR; PG8_MMA(1, 0, At, B0); PG8_MMA(1, 1, At, B1); PG8_BAR; PG8_SCHED;
            } else {
            PG8_LDB(B0, 0, 0); PG8_SCHED; PG8_LDA(At, 0, 0); PG8_STAGE(PG8_SA(1, 1), a1 + hstep, voffA);
            PG8_WAIT_L(8); PG8_BAR; PG8_WAIT_L(0); PG8_MMA(0, 0, At, B0); PG8_BAR; PG8_SCHED;
            PG8_LDB(B1, 0, 1); PG8_STAGE(PG8_SB(0, 0), b2, voffB);
            PG8_BAR; PG8_WAIT_L(0); PG8_MMA(0, 1, At, B1); PG8_BAR;
            PG8_LDA(At, 0, 1); PG8_STAGE(PG8_SA(0, 0), a2, voffA);
            PG8_BAR; PG8_WAIT_L(0); PG8_MMA(1, 0, At, B0); PG8_BAR; PG8_SCHED;
            PG8_STAGE(PG8_SB(0, 1), b2 + hstep, voffB);
            PG8_WAIT_V(6); PG8_BAR; PG8_MMA(1, 1, At, B1); PG8_BAR;
            PG8_LDB(B0, 1, 0); PG8_SCHED; PG8_LDA(At, 1, 0); PG8_STAGE(PG8_SA(0, 1), a2 + hstep, voffA);
            PG8_WAIT_L(8); PG8_BAR; PG8_WAIT_L(0); PG8_MMA(0, 0, At, B0); PG8_BAR; PG8_SCHED;
            PG8_LDB(B1, 1, 1); PG8_STAGE(PG8_SB(1, 0), b3, voffB);
            PG8_BAR; PG8_WAIT_L(0); PG8_MMA(0, 1, At, B1); PG8_BAR;
            PG8_LDA(At, 1, 1); PG8_STAGE(PG8_SA(1, 0), a3, voffA);
            PG8_BAR; PG8_WAIT_L(0); PG8_MMA(1, 0, At, B0); PG8_BAR; PG8_SCHED;
            PG8_STAGE(PG8_SB(1, 1), b3 + hstep, voffB);
            PG8_WAIT_V(6); PG8_BAR; PG8_MMA(1, 1, At, B1); PG8_BAR;
            }
        }
        if constexpr (ALIGN_EPI) { if (wr == 0) PG8_BAR; }
        if constexpr (!Epi::AFTER_DRAIN) { E(acc, cur, wr, wc, fr, fq); S.done(cur); }
        if (!has_next) break;
#pragma unroll
        for (int a = 0; a < 2; ++a)
#pragma unroll
            for (int b = 0; b < 2; ++b)
#pragma unroll
                for (int m = 0; m < 4; ++m)
#pragma unroll
                    for (int n = 0; n < 2; ++n) acc[a][b][m][n] = (f32x4){0.f, 0.f, 0.f, 0.f};
        cur = nxt; cA = nA; cB = nB; ++ui;
        if constexpr (ALIGN_EPI) { if (wr == 1) PG8_BAR; }
    }
    PG8_WAIT_V(0);
    if constexpr (!ALIGN_EPI) { if (wr == 0) PG8_BAR; }
    PG8_BAR;
    if constexpr (Epi::AFTER_DRAIN) { E.fused(acc, cur, wr, wc, fr, fq, lds, wid, lane); S.done(cur); }
#undef PG8_SA
#undef PG8_SB
#undef PG8_STAGE
#undef PG8_LDA
#undef PG8_LDB
#undef PG8_MMA
#undef PG8_WAIT_V
#undef PG8_WAIT_L
#undef PG8_BAR
#undef PG8_SCHED
}
}
#define GAS __attribute__((address_space(1)))
#define LAS __attribute__((address_space(3)))
#define DI __device__ __forceinline__
typedef unsigned short bf16;
typedef float f32x2 __attribute__((ext_vector_type(2)));
typedef float f32x4 __attribute__((ext_vector_type(4)));
typedef float f32x16 __attribute__((ext_vector_type(16)));
typedef short bf16x8 __attribute__((ext_vector_type(8)));
typedef unsigned u32x2 __attribute__((ext_vector_type(2)));
typedef unsigned u32x4 __attribute__((ext_vector_type(4)));
#define MFMA32(a, b, c) __builtin_amdgcn_mfma_f32_32x32x16_bf16((a), (b), (c), 0, 0, 0)

#ifndef MK_ONE_LAUNCH
#define MK_ONE_LAUNCH 1
#endif
namespace mk {
constexpr int NWAVES = 8, NTHR = 512;
constexpr int D = 1024, M = 12288, MPR = 4096;
constexpr int NPROJ = 3840, FF = 2816;
constexpr float EPS = 1e-6f;
constexpr int NPHASES = 20;
constexpr size_t OFF_C = 12582912, OFF_N = 14680064, OFF_MM = 14696448, OFF_K = 14696576, OFF_V = 18890880;
constexpr size_t MiB = 1u << 20;
constexpr size_t WS_CTL = 0, CTL_ZERO_BYTES = 1 * MiB;
constexpr size_t WS_MODP = 105 * MiB;
constexpr size_t WS_MODF = 5 * MiB;
constexpr size_t WS_GATES = 6 * MiB;
constexpr size_t WS_AS = 7 * MiB, WS_MS = 7 * MiB + 512 * 1024, WS_BS = 8 * MiB;
constexpr size_t WS_H2 = 10 * MiB;
constexpr size_t WS_NS = 9 * MiB;
constexpr size_t WS_R2048 = 12 * MiB;
constexpr size_t WS_R256 = 16 * MiB;
constexpr size_t WS_CK = 22 * MiB, WS_CV = 26 * MiB;
constexpr size_t WS_WAB = 30 * MiB, WS_WOAB = 38 * MiB, WS_WC = 40 * MiB, WS_WOC = 46 * MiB, WS_WUP = 48 * MiB, WS_WDN = 70 * MiB;
constexpr size_t WS_H = 81 * MiB;
constexpr size_t WS_BIG = 105 * MiB;
constexpr size_t WS_PROJ = WS_BIG;
constexpr size_t WS_QB = 195 * MiB, WS_KB = 207 * MiB;
constexpr size_t WS_UT = 219 * MiB;
constexpr size_t WS_X2T = 231 * MiB;
constexpr size_t WS_FG = 171 * MiB;
constexpr size_t WS_ABND = 140 * MiB, WS_GBND = 144 * MiB;
constexpr size_t WS_Q1 = WS_BIG, WS_K1 = 129 * MiB, WS_V1 = 153 * MiB;
constexpr size_t WS_DL = WS_BIG;
constexpr size_t WS_END = 256 * MiB;
constexpr int CW_BAR = 4096;
constexpr int RING_BYTES = 131072, LDSCTL_OFF = RING_BYTES, MISC_OFF = LDSCTL_OFF + 320, XCH_OFF = RING_BYTES + 1024, LDS_BYTES = 147456;

DI float bf2f(unsigned short b) { return __uint_as_float((unsigned)b << 16); }
DI unsigned pk2(float lo, float hi) { return pg8::pkbf(lo, hi); }
DI void unpack8(const u32x4 v, float (&f)[8]) {
    f[0] = __uint_as_float(v.x << 16); f[1] = __uint_as_float(v.x & 0xffff0000u); f[2] = __uint_as_float(v.y << 16); f[3] = __uint_as_float(v.y & 0xffff0000u);
    f[4] = __uint_as_float(v.z << 16); f[5] = __uint_as_float(v.z & 0xffff0000u); f[6] = __uint_as_float(v.w << 16); f[7] = __uint_as_float(v.w & 0xffff0000u); }
DI u32x4 pack8(const float (&f)[8]) { u32x4 w; w.x = pk2(f[0], f[1]); w.y = pk2(f[2], f[3]); w.z = pk2(f[4], f[5]); w.w = pk2(f[6], f[7]); return w; }
DI float rcp_f(float x) { return __builtin_amdgcn_rcpf(x); }
DI float exp2_f(float x) { return __builtin_amdgcn_exp2f(x); }
DI float silu_f(float x) { return x * rcp_f(1.f + exp2_f(-1.4426950408889634f * x)); }
DI float sigm_f(float x) { return rcp_f(1.f + exp2_f(-1.4426950408889634f * x)); }
DI float gelu_tanh_f(float x) { const float u2 = x * (-2.3022081986f + -0.1029432396f * x * x); return x * rcp_f(1.f + exp2_f(u2)); }
DI float logsig_f(float x) { return fminf(x, 0.f) - log1pf(__expf(-fabsf(x))); }
DI float wave_sum(float v) {
#pragma unroll
    for (int o = 1; o < 64; o <<= 1) v += __shfl_xor(v, o);
    return v; }
#define LDS_WAIT() asm volatile("s_waitcnt lgkmcnt(0)" ::: "memory")

#define XB_TMO      128
#define XB_XCNT(j)  (256  + 64 * (j))
#define XB_XSUB(j)  (1280 + 64 * (j))
#define XB_XGEN(j)  (2304 + 64 * (j))
#define XB_TOP      3328
#define XB_TOPGEN   3392
#define XCD_BAR_WORDS 3456
#define XB_SPIN_CAP (1u << 20)
DI unsigned xb_ld(unsigned* p)              { return __hip_atomic_load(p, __ATOMIC_RELAXED, __HIP_MEMORY_SCOPE_AGENT); }
DI unsigned xb_add(unsigned* p, unsigned v) { return __hip_atomic_fetch_add(p, v, __ATOMIC_RELAXED, __HIP_MEMORY_SCOPE_AGENT); }
DI unsigned xb_xcc_id() { return (unsigned)__builtin_amdgcn_s_getreg((3 << 11) | 20) & 0xFu; }
#define XB_SPIN(cond, bar) do { unsigned _sp = 0; while (cond) { __builtin_amdgcn_s_sleep(1); \
    if ((++_sp & 255u) == 0u) { if (xb_ld(&(bar)[XB_TMO])) break; if (_sp > XB_SPIN_CAP) { atomicAdd(&(bar)[XB_TMO], 1u); break; } } } } while (0)
struct XcdBarrier { unsigned* bar; unsigned x; volatile LAS unsigned* st; };
DI XcdBarrier xcd_barrier_post(unsigned* bar, volatile LAS unsigned* st) {
    XcdBarrier b; b.bar = bar; b.x = xb_xcc_id(); b.st = st;
    if (threadIdx.x == 0) (void)xb_add(&bar[XB_XCNT(b.x)], 1u);
    return b;
}
DI void xcd_barrier_complete(unsigned* bar, unsigned x, unsigned& nloc, unsigned& nx) {
    const unsigned G = gridDim.x * gridDim.y * gridDim.z;
    unsigned sum, cnt, mine, sp = 0u;
    for (;;) {
        sum = 0u; cnt = 0u; mine = 0u;
#pragma unroll
        for (unsigned j = 0; j < 16; ++j) { const unsigned c = xb_ld(&bar[XB_XCNT(j)]); sum += c; cnt += (c > 0u) ? 1u : 0u; mine = (j == x) ? c : mine; }
        if (sum == G) break;
        __builtin_amdgcn_s_sleep(1);
        if ((++sp & 255u) == 0u) { if (xb_ld(&bar[XB_TMO])) break; if (sp > XB_SPIN_CAP) { atomicAdd(&bar[XB_TMO], 1u); break; } }
    }
    nloc = mine > 0u ? mine : 1u; nx = cnt > 0u ? cnt : 1u;
}
DI void xcd_barrier(const XcdBarrier& b) {
    asm volatile("s_waitcnt vmcnt(0)" ::: "memory");
    __syncthreads();
    if (threadIdx.x == 0) {
        unsigned* bar = b.bar;
        __builtin_amdgcn_s_waitcnt(0);
        unsigned nloc = b.st[0], nx = b.st[1];
        if (nloc == 0u) { xcd_barrier_complete(bar, b.x, nloc, nx); b.st[0] = nloc; b.st[1] = nx; }
        const unsigned old = xb_add(&bar[XB_XSUB(b.x)], 1u);
        const unsigned gen = old / nloc;
        if (old + 1u == (gen + 1u) * nloc) {
            __builtin_amdgcn_fence(__ATOMIC_RELEASE, "agent");
            asm volatile("s_waitcnt vmcnt(0)" ::: "memory");
            const unsigned og = xb_add(&bar[XB_TOP], 1u);
            const unsigned tg = og / nx;
            if (og + 1u == (tg + 1u) * nx) xb_add(&bar[XB_TOPGEN], 1u);
            else XB_SPIN(xb_ld(&bar[XB_TOPGEN]) == tg, bar);
            __builtin_amdgcn_fence(__ATOMIC_ACQUIRE, "agent");
            xb_add(&bar[XB_XGEN(b.x)], 1u);
            asm volatile("s_waitcnt vmcnt(0)" ::: "memory");
        } else {
            XB_SPIN(xb_ld(&bar[XB_XGEN(b.x)]) == gen, bar);
            __builtin_amdgcn_fence(__ATOMIC_ACQUIRE, "agent");
            asm volatile("s_waitcnt vmcnt(0)" ::: "memory");
        }
    }
    __syncthreads();
}

struct Args { const float* in[33]; float* out; unsigned char* ws; int ph_lo, ph_hi; };
enum { I_XP = 0, I_XS, I_STC, I_STN, I_STM, I_CK, I_CV, I_C, I_CCTX, I_WADA, I_BADA, I_GMIX, I_GFFN, I_GFIN, I_WINAB, I_BGATES, I_WCQK, I_GMLSTM, I_WCHY,
       I_WF1, I_BF1, I_WF2, I_BF2, I_WF3, I_FREQ, I_HYB, I_WOUTAB, I_WINC, I_RPB, I_WOUTC, I_WUP, I_WCFFN, I_WDOWN };

DI void row_seq(int row, int& base, int& L) { if (row < MPR) { base = row & ~255; L = 256; } else { base = MPR + ((row - MPR) & ~2047); L = 2048; } }
DI int row_vec(int row) { return row < MPR ? 4 : ((row - MPR) >> 11); }
template <bool FFN_PERM = false> DI void p0_transpose_tile(const float* W, int K, int N, int Npad, bf16* WT, LAS float* T, int item, int tid) {
    const int nblk = Npad / 256, kb = item / nblk, nb = item % nblk, k0 = 64 * kb, n0 = 256 * nb;
    __syncthreads();
    { const int col = n0 + (tid & 63) * 4; const bool ok = col < N; const float* src = W + (size_t)k0 * N + col;
      f32x4 v[8];
#pragma unroll
      for (int i = 0; i < 8; ++i) { const int kk = i * 8 + (tid >> 6); v[i] = ok ? *(const f32x4*)(src + (size_t)kk * N) : (f32x4){0.f, 0.f, 0.f, 0.f}; }
#pragma unroll
      for (int i = 0; i < 8; ++i) { const int kk = i * 8 + (tid >> 6); *(LAS f32x4*)(T + kk * 260 + (tid & 63) * 4) = v[i]; } }
    __syncthreads();
#pragma unroll
    for (int j = 0; j < 4; ++j) { const int n = tid & 255, kg = (tid >> 8) + 2 * j; const LAS float* p = T + (8 * kg) * 260 + n;
        u32x4 o; o.x = pk2(p[0], p[260]); o.y = pk2(p[520], p[780]); o.z = pk2(p[1040], p[1300]); o.w = pk2(p[1560], p[1820]);
        int dr = n0 + n;
        if (FFN_PERM) { const int gsel = dr >= 2816, c = gsel ? dr - 2816 : dr; dr = (c >> 7) * 256 + gsel * 128 + (c & 127); }
        *(u32x4*)(WT + (size_t)dr * K + k0 + 8 * kg) = o; }
}
DI void p0_filter_stage1(const Args& a, int L, int p0, int gcol0, float* H2, LAS float* T, int tid, int lane, int wave) {
    const float* b1 = a.in[I_BF1]; const float* b2 = a.in[I_BF2]; const float* fr = a.in[I_FREQ];
    LAS float* w1s = T; LAS float* w2s = T + 2112; LAS float* hs = T + 2112 + 4096;
    __syncthreads();
    for (int i = tid; i < 2112; i += NTHR) w1s[i] = a.in[I_WF1][i];
    for (int i = tid; i < 4096; i += NTHR) w2s[i] = a.in[I_WF2][i];
    __syncthreads();
    const int p = p0 + lane; const float tpos = (float)p / (float)(L - 1), wrev = (float)p / (float)L;
    float z[33]; z[0] = tpos;
#pragma unroll
    for (int k = 0; k < 16; ++k) { const float band = 1e-4f + (float)k * ((15.0f - 1e-4f) / 15.0f); const float rv = band * wrev; const float ph = 6.283185307179586f * (rv - floorf(rv));
        z[1 + k] = __cosf(ph); z[17 + k] = -__sinf(ph); }
#pragma unroll
    for (int jj = 0; jj < 8; ++jj) { const int j = 8 * wave + jj; float t = b1[j];
#pragma unroll
        for (int i = 0; i < 33; ++i) t += z[i] * w1s[i * 64 + j];
        hs[j * 64 + lane] = sinf(fr[j] * t); }
    __syncthreads();
    float acc[8];
#pragma unroll
    for (int jj = 0; jj < 8; ++jj) acc[jj] = b2[8 * wave + jj];
#pragma unroll 8
    for (int i = 0; i < 64; ++i) { const float hv = hs[i * 64 + lane]; const LAS float* wr = w2s + i * 64 + 8 * wave;
#pragma unroll
        for (int jj = 0; jj < 8; ++jj) acc[jj] += hv * wr[jj]; }
#pragma unroll
    for (int jj = 0; jj < 8; ++jj) { const int j = 8 * wave + jj; H2[(size_t)j * 2304 + gcol0 + lane] = sinf(fr[j] * acc[jj]); }
}
DI void p1_filter_stage2(const Args& a, int L, int p0, int gcol0, int cb, const float* H2, bf16* R, LAS float* w3t, int lane) {
    const float* w3 = a.in[I_WF3];
    const int p = p0 + lane; const float tpos = (float)p / (float)(L - 1);
    float h2[64];
#pragma unroll
    for (int i = 0; i < 64; ++i) h2[i] = H2[(size_t)i * 2304 + gcol0 + lane];
#pragma unroll
    for (int r = 0; r < 16; ++r) { const int i = (lane >> 4) + 4 * r; w3t[(lane & 15) * 64 + i] = w3[i * 1024 + cb * 16 + (lane & 15)]; }
    LDS_WAIT(); asm volatile("" ::: "memory");
    const float mind = -3.0701134573f, maxd = -15.3505672866f;
#pragma unroll 2
    for (int cc = 0; cc < 16; ++cc) { const int c = cb * 16 + cc, c5 = c & 511; float t0 = 0.f, t1 = 0.f, t2 = 0.f, t3 = 0.f;
#pragma unroll
        for (int q = 0; q < 16; ++q) { const f32x4 w = *(const LAS f32x4*)(w3t + cc * 64 + 4 * q); t0 += h2[4 * q] * w[0]; t1 += h2[4 * q + 1] * w[1]; t2 += h2[4 * q + 2] * w[2]; t3 += h2[4 * q + 3] * w[3]; }
        const float delta = fabsf(mind + (float)c5 * ((maxd - mind) / 511.0f)); const float v = ((t0 + t1) + (t2 + t3)) * __expf(-tpos * delta);
        const bf16 vb = (bf16)(pk2(v, 0.f) & 0xffffu);
        if (c < 512) { R[(size_t)c * (2 * L) + (L - p)] = vb; if (p == 0) R[(size_t)c * (2 * L)] = 0; }
        else if (p >= 1) R[(size_t)c5 * (2 * L) + (L + p)] = vb; }
    LDS_WAIT(); asm volatile("" ::: "memory");
}
DI void bg_convert(const Args& a, LAS unsigned char* lds, int set, int widx, int nw, int tid) {
    unsigned char* ws = a.ws; LAS float* T = (LAS float*)lds;
    constexpr int I2 = 16 * 12, I3 = 16 * 4, I4 = 16 * 22, I5 = 44 * 4;
    if (set == 0) { for (int r = widx; r < I4 + I5; r += nw) {
            if (r < I4) p0_transpose_tile<true>(a.in[I_WUP], 1024, 5632, 5632, (bf16*)(ws + WS_WUP), T, r, tid);
            else p0_transpose_tile(a.in[I_WDOWN], 2816, 1024, 1024, (bf16*)(ws + WS_WDN), T, r - I4, tid); } }
    else { for (int r0 = widx; r0 < I2 + I3 + I4 + I5; r0 += nw) { int r = r0;
            if (r < I2) { p0_transpose_tile(a.in[I_WINC], 1024, 3072, 3072, (bf16*)(ws + WS_WC), T, r, tid); continue; } r -= I2;
            if (r < I3) { p0_transpose_tile(a.in[I_WOUTC], 1024, 1024, 1024, (bf16*)(ws + WS_WOC), T, r, tid); continue; } r -= I3;
            if (r < I4) { p0_transpose_tile<true>(a.in[I_WUP] + (size_t)1024 * 5632, 1024, 5632, 5632, (bf16*)(ws + WS_WUP) + (size_t)5632 * 1024, T, r, tid); continue; } r -= I4;
            p0_transpose_tile(a.in[I_WDOWN] + (size_t)2816 * 1024, 2816, 1024, 1024, (bf16*)(ws + WS_WDN) + (size_t)1024 * 2816, T, r, tid); } }
    __syncthreads();
}
DI void ph_prologue(const Args& a, LAS unsigned char* lds, int tid, int lane, int wave, int bid, int G) {
    unsigned char* ws = a.ws;
    constexpr int NF1 = 36, NA = 192, I0 = 16 * 15, I1 = 16 * 4, NT = I0 + I1;
    LAS float* T = (LAS float*)lds;
#ifndef MK_P0A
#define MK_P0A 1
#define MK_P0T 1
#define MK_P0F 1
#endif
    for (int rep_ = 0; rep_ < (MK_P0A > MK_P0T ? (MK_P0A > MK_P0F ? MK_P0A : MK_P0F) : (MK_P0T > MK_P0F ? MK_P0T : MK_P0F)); ++rep_)
    for (int it0 = bid; it0 < NF1 + NA + NT; it0 += G) {
        if (it0 < NF1) { if (rep_ < MK_P0F) p0_filter_stage1(a, it0 < 32 ? 2048 : 256, it0 < 32 ? 64 * it0 : 64 * (it0 - 32), 64 * it0, (float*)(ws + WS_H2), T, tid, lane, wave); continue; }
        const int it = it0 - NF1;
        if (it < NA ? rep_ >= MK_P0A : rep_ >= MK_P0T) continue;
        if (it < NA) {
            const int l = it / 96, rem = it % 96, cb = rem >> 5, ks = rem & 31;
            __syncthreads();
            if (tid < 160) { const int v = tid >> 5, k = tid & 31; const float cv = v < 4 ? a.in[I_C][v * 1024 + ks * 32 + k] : a.in[I_CCTX][ks * 32 + k]; T[tid] = silu_f(cv); }
            __syncthreads();
            const int col = cb * 2048 + tid * 4; const float* w = a.in[I_WADA] + ((size_t)(l * 1024 + ks * 32)) * 6144 + col;
            f32x4 a0 = {0.f, 0.f, 0.f, 0.f}, a1 = a0, a2 = a0, a3 = a0, a4 = a0;
#pragma unroll 16
            for (int k = 0; k < 32; ++k) { const f32x4 wv = *(const f32x4*)(w + (size_t)k * 6144); a0 += wv * T[k]; a1 += wv * T[32 + k]; a2 += wv * T[64 + k]; a3 += wv * T[96 + k]; a4 += wv * T[128 + k]; }
            float* o = (float*)(ws + WS_MODP) + ((size_t)((ks * 2 + l) * 5)) * 6144 + col;
            *(f32x4*)o = a0; *(f32x4*)(o + 6144) = a1; *(f32x4*)(o + 2 * 6144) = a2; *(f32x4*)(o + 3 * 6144) = a3; *(f32x4*)(o + 4 * 6144) = a4;
            continue;
        }
        int r = it - NA;
        if (r < I0) { p0_transpose_tile(a.in[I_WINAB], 1024, 3600, 3840, (bf16*)(ws + WS_WAB), T, r, tid); continue; } r -= I0;
        p0_transpose_tile(a.in[I_WOUTAB], 1024, 1024, 1024, (bf16*)(ws + WS_WOAB), T, r, tid);
    }
    __syncthreads();
    { const int gt = bid * NTHR + tid, NGT = G * NTHR;
      for (int i = gt; i < 2 * 262144; i += NGT) { const int which = i >= 262144, j = which ? i - 262144 : i;
        const float* src = a.in[which ? I_CV : I_CK] + (size_t)j * 8; bf16* dst = (bf16*)(ws + (which ? WS_CV : WS_CK)) + (size_t)j * 8;
        const f32x4 x0 = *(const f32x4*)src, x1 = *(const f32x4*)(src + 4);
        u32x4 o; o.x = pk2(x0[0], x0[1]); o.y = pk2(x0[2], x0[3]); o.z = pk2(x1[0], x1[1]); o.w = pk2(x1[2], x1[3]); *(u32x4*)dst = o; } }
}
DI void ph_modf_norm0(const Args& a, LAS unsigned char* lds, int tid, int lane, int wave, int bid, int G) {
    const float* modP = (const float*)(a.ws + WS_MODP); float* modF = (float*)(a.ws + WS_MODF); const float* bada = a.in[I_BADA];
    for (int i = bid * NTHR + tid; i < 2 * 5 * 6144; i += G * NTHR) { const int l = i / 30720, rem = i % 30720, v = rem / 6144, col = rem % 6144;
        float s = bada[l * 6144 + col];
#pragma unroll 8
        for (int ks = 0; ks < 32; ++ks) s += modP[((size_t)((ks * 2 + l) * 5 + v)) * 6144 + col];
        modF[i] = s; }
    const int rpw = (M + G - 1) / G, r0 = rpw * bid, r1 = (r0 + rpw < M) ? r0 + rpw : M;
    LAS float* shs = (LAS float*)lds;
    for (int v = 0; v < 5; ++v) {
        const bool need = r0 < r1 && (v == 4 ? (r0 < MPR) : (r1 > MPR && ((r0 > MPR ? r0 : MPR) - MPR) >> 11 <= v && v <= ((r1 - 1 - MPR) >> 11)));
        if (!need) continue;
        { const int i = tid; const int ch = i >> 8, c4 = (i & 255) * 4;
            f32x4 s = *(const f32x4*)(bada + ch * 1024 + c4);
#pragma unroll 8
            for (int ks = 0; ks < 32; ++ks) s += *(const f32x4*)(modP + ((size_t)((ks * 2 + 0) * 5 + v)) * 6144 + ch * 1024 + c4);
            *(LAS f32x4*)(shs + (v * 2 + ch) * 1024 + c4) = s; }
    }
    const int NGW = G * NWAVES;
    for (int it = wave * G + bid; it < 2304; it += NGW) { const int pg = it >> 6, cb = it & 63;
        p1_filter_stage2(a, pg < 32 ? 2048 : 256, pg < 32 ? 64 * pg : 64 * (pg - 32), 64 * pg, cb, (const float*)(a.ws + WS_H2), (bf16*)(a.ws + (pg < 32 ? WS_R2048 : WS_R256)), (LAS float*)(lds + 65536 + wave * 4096), lane); }
    __syncthreads();
    { const float* xsB = a.in[I_XS] - (size_t)MPR * D; const float* gvec = a.in[I_GMIX]; bf16* hbuf = (bf16*)(a.ws + WS_H);
        for (int row = r0 + wave; row < r1; row += NWAVES) {
            const float* xr = (row < MPR ? a.in[I_XP] : xsB) + (size_t)row * D; const int slot = row_vec(row);
            f32x4 x[4]; float ss = 0.f;
#pragma unroll
            for (int j = 0; j < 4; ++j) { x[j] = *(const f32x4*)(xr + 4 * lane + 256 * j); ss += (x[j][0] * x[j][0] + x[j][1] * x[j][1]) + (x[j][2] * x[j][2] + x[j][3] * x[j][3]); }
            const float rstd = rsqrtf(wave_sum(ss) * (1.f / D) + EPS);
#pragma unroll
            for (int j = 0; j < 4; ++j) { const int col = 4 * lane + 256 * j; const f32x4 g = *(const f32x4*)(gvec + col), sh = *(const LAS f32x4*)(shs + (slot * 2 + 0) * 1024 + col), sc = *(const LAS f32x4*)(shs + (slot * 2 + 1) * 1024 + col);
                const f32x4 y = x[j] * rstd * g * (sc + 1.f) + sh; u32x2 o; o.x = pk2(y[0], y[1]); o.y = pk2(y[2], y[3]); *(u32x2*)(hbuf + (size_t)row * D + col) = o; }
        }
    }
}
DI void ph_norm(const float* xA, const float* xB, const bf16* delta, float* xout, const float* gvec, const float* mod5  , int chS, int chC, bf16* hbuf, int gw, int NGW, int lane) {
    for (int row0 = gw; row0 < M; row0 += 2 * NGW) {
        f32x4 x[2][4]; u32x2 dq[2][4];
#pragma unroll
        for (int r = 0; r < 2; ++r) { const int row = row0 + r * NGW; if (row < M) { const float* xr = (row < MPR ? xA : xB) + (size_t)row * D;
#pragma unroll
            for (int j = 0; j < 4; ++j) { x[r][j] = *(const f32x4*)(xr + 4 * lane + 256 * j); if (delta) dq[r][j] = *(const u32x2*)(delta + (size_t)row * D + 4 * lane + 256 * j); } } }
#pragma unroll
        for (int r = 0; r < 2; ++r) { const int row = row0 + r * NGW; if (row < M) { const int v = row_vec(row);
            const float* shp = mod5 + (size_t)v * 6144 + chS * 1024; const float* scp = mod5 + (size_t)v * 6144 + chC * 1024; float ss = 0.f;
            if (delta) {
#pragma unroll
                for (int j = 0; j < 4; ++j) { x[r][j][0] += __uint_as_float(dq[r][j].x << 16); x[r][j][1] += __uint_as_float(dq[r][j].x & 0xffff0000u); x[r][j][2] += __uint_as_float(dq[r][j].y << 16); x[r][j][3] += __uint_as_float(dq[r][j].y & 0xffff0000u);
                    *(f32x4*)(xout + (size_t)row * D + 4 * lane + 256 * j) = x[r][j]; } }
#pragma unroll
            for (int j = 0; j < 4; ++j) ss += (x[r][j][0] * x[r][j][0] + x[r][j][1] * x[r][j][1]) + (x[r][j][2] * x[r][j][2] + x[r][j][3] * x[r][j][3]);
            const float rstd = rsqrtf(wave_sum(ss) * (1.f / D) + EPS);
#pragma unroll
            for (int j = 0; j < 4; ++j) { const int col = 4 * lane + 256 * j; const f32x4 g = *(const f32x4*)(gvec + col), sh = *(const f32x4*)(shp + col), sc = *(const f32x4*)(scp + col);
                const f32x4 y = x[r][j] * rstd * g * (sc + 1.f) + sh; u32x2 o; o.x = pk2(y[0], y[1]); o.y = pk2(y[2], y[3]); *(u32x2*)(hbuf + (size_t)row * D + col) = o; } } }
    }
}
DI void ph_final_norm(float* out, const bf16* delta, const float* gvec, int gw, int NGW, int lane) {
    for (int row0 = gw; row0 < M; row0 += 2 * NGW) {
        f32x4 x[2][4]; u32x2 dq[2][4];
#pragma unroll
        for (int r = 0; r < 2; ++r) { const int row = row0 + r * NGW; if (row < M) {
#pragma unroll
            for (int j = 0; j < 4; ++j) { x[r][j] = *(const f32x4*)(out + (size_t)row * D + 4 * lane + 256 * j); dq[r][j] = *(const u32x2*)(delta + (size_t)row * D + 4 * lane + 256 * j); } } }
#pragma unroll
        for (int r = 0; r < 2; ++r) { const int row = row0 + r * NGW; if (row < M) { float ss = 0.f;
#pragma unroll
            for (int j = 0; j < 4; ++j) { x[r][j][0] += __uint_as_float(dq[r][j].x << 16); x[r][j][1] += __uint_as_float(dq[r][j].x & 0xffff0000u); x[r][j][2] += __uint_as_float(dq[r][j].y << 16); x[r][j][3] += __uint_as_float(dq[r][j].y & 0xffff0000u);
                ss += (x[r][j][0] * x[r][j][0] + x[r][j][1] * x[r][j][1]) + (x[r][j][2] * x[r][j][2] + x[r][j][3] * x[r][j][3]); }
            const float rstd = rsqrtf(wave_sum(ss) * (1.f / D) + EPS);
#pragma unroll
            for (int j = 0; j < 4; ++j) { const int col = 4 * lane + 256 * j; const f32x4 g = *(const f32x4*)(gvec + col); *(f32x4*)(out + (size_t)row * D + col) = x[r][j] * rstd * g; } } }
    }
}
DI void conv3_8(const bf16* p0, const bf16* p1, const bf16* p2, bool hp, bool hn, const float* w, int wstride, float (&o)[8]) {
    float c[8], pv[8], nx[8];
    unpack8(*(const u32x4*)p1, c);
    if (hp) unpack8(*(const u32x4*)p0, pv); else {
#pragma unroll
        for (int j = 0; j < 8; ++j) pv[j] = 0.f; }
    if (hn) unpack8(*(const u32x4*)p2, nx); else {
#pragma unroll
        for (int j = 0; j < 8; ++j) nx[j] = 0.f; }
#pragma unroll
    for (int j = 0; j < 8; ++j) o[j] = w[j] * pv[j] + w[wstride + j] * c[j] + w[2 * wstride + j] * nx[j];
}
DI void ph_e1(const Args& a, LAS unsigned char* lds, int tid, int gw, int NGW, int lane, int wave, int bid, int G) {
    unsigned char* ws = a.ws;
    const bf16* proj = (const bf16*)(ws + WS_PROJ); bf16* QB = (bf16*)(ws + WS_QB); bf16* KB = (bf16*)(ws + WS_KB); bf16* UT = (bf16*)(ws + WS_UT); bf16* X2T = (bf16*)(ws + WS_X2T);
    const float* wqk = a.in[I_WCQK]; const float* why = a.in[I_WCHY];
    LAS bf16* Ust = (LAS bf16*)lds; LAS bf16* Xst = (LAS bf16*)(lds + 65536);
    for (int it = bid; it < M / 64; it += G) {
        __syncthreads();
        int sbase, L; row_seq(it * 64, sbase, L);
#pragma unroll 1
        for (int half = 0; half < 2; ++half) {
            const int r0 = it * 64 + 8 * wave + 4 * half;
#define E1_LOAD(rawv, coff_) _Pragma("unroll") for (int j = 0; j < 6; ++j) { const int row = r0 - 1 + j; const bool ok = row >= sbase && row < sbase + L; \
                rawv[j] = ok ? *(const u32x4*)(proj + (size_t)row * NPROJ + (coff_)) : (u32x4){0u, 0u, 0u, 0u}; }
#define E1_CONV(rawv, wp_, wst_, outv) do { float w0_[8], w1_[8], w2_[8]; \
                { const f32x4 a_ = *(const f32x4*)(wp_), b_ = *(const f32x4*)((wp_) + 4), c_ = *(const f32x4*)((wp_) + (wst_)), d_ = *(const f32x4*)((wp_) + (wst_) + 4), e_ = *(const f32x4*)((wp_) + 2 * (wst_)), f_ = *(const f32x4*)((wp_) + 2 * (wst_) + 4); \
                  _Pragma("unroll") for (int j = 0; j < 4; ++j) { w0_[j] = a_[j]; w0_[4 + j] = b_[j]; w1_[j] = c_[j]; w1_[4 + j] = d_[j]; w2_[j] = e_[j]; w2_[4 + j] = f_[j]; } } \
                _Pragma("unroll") for (int o = 0; o < 4; ++o) { float p0[8], p1[8], p2[8]; unpack8(rawv[o], p0); unpack8(rawv[o + 1], p1); unpack8(rawv[o + 2], p2); \
                  _Pragma("unroll") for (int j = 0; j < 8; ++j) outv[o][j] = w0_[j] * p0[j] + w1_[j] * p1[j] + w2_[j] * p2[j]; } } while (0)
            { u32x4 rq[6], rk[6]; E1_LOAD(rq, 8 * lane); E1_LOAD(rk, 512 + 8 * lane);
              float oq[4][8], ok_[4][8]; E1_CONV(rq, wqk + 8 * lane, 1024, oq); E1_CONV(rk, wqk + 512 + 8 * lane, 1024, ok_);
#pragma unroll
              for (int o = 0; o < 4; ++o) {
#pragma unroll
                  for (int j = 0; j < 8; ++j) { oq[o][j] = silu_f(oq[o][j]); ok_[o][j] = silu_f(ok_[o][j]) * 0.08838834764831845f; }
                  *(u32x4*)(QB + (size_t)(r0 + o) * 512 + 8 * lane) = pack8(oq[o]); *(u32x4*)(KB + (size_t)(r0 + o) * 512 + 8 * lane) = pack8(ok_[o]); } }
            { u32x4 rv[6], r1[6], r2[6]; E1_LOAD(rv, 2064 + 8 * lane); E1_LOAD(r1, 2576 + 8 * lane); E1_LOAD(r2, 3088 + 8 * lane);
              float ov[4][8], o1[4][8], o2[4][8]; E1_CONV(rv, why + 8 * lane, 1536, ov); E1_CONV(r1, why + 512 + 8 * lane, 1536, o1); E1_CONV(r2, why + 1024 + 8 * lane, 1536, o2);
#pragma unroll
              for (int o = 0; o < 4; ++o) { const int rl = 8 * wave + 4 * half + o;
#pragma unroll
                  for (int j = 0; j < 8; ++j) ov[o][j] *= o1[o][j];
                  *(LAS u32x4*)(Ust + rl * 512 + 8 * lane) = pack8(ov[o]); *(LAS u32x4*)(Xst + rl * 512 + 8 * lane) = pack8(o2[o]); } }
#undef E1_LOAD
#undef E1_CONV
        }
        __syncthreads();
        for (int idx = tid; idx < 8192; idx += NTHR) { const int c = idx & 511, g = (idx >> 9) & 7, ten = idx >> 12;
            const LAS bf16* src = (ten ? Xst : Ust) + (8 * g) * 512 + c;
            u32x4 o; o.x = (unsigned)src[0] | ((unsigned)src[512] << 16); o.y = (unsigned)src[1024] | ((unsigned)src[1536] << 16);
            o.z = (unsigned)src[2048] | ((unsigned)src[2560] << 16); o.w = (unsigned)src[3072] | ((unsigned)src[3584] << 16);
            *(u32x4*)((ten ? X2T : UT) + (size_t)c * M + it * 64 + 8 * g) = o; }
    }
    const float* gates = (const float*)(ws + WS_GATES); const float* bg = a.in[I_BGATES];
    float* aS = (float*)(ws + WS_AS); float* MSv = (float*)(ws + WS_MS); float* bS = (float*)(ws + WS_BS);
    if (G > M / 64) { if (bid >= M / 64) bg_convert(a, lds, 0, bid - M / 64, G - M / 64, tid); } else bg_convert(a, lds, 0, bid, G, tid);
    const int sw0 = (G > M / 64) ? (bid - M / 64) * NWAVES + wave : gw, sws = (G > M / 64) ? (G - M / 64) * NWAVES : NGW;
    for (int it = sw0; it < 160 && it >= 0; it += sws) {
        const int seq = it >> 3, h = (it >> 1) & 3, dir = it & 1;
        const int L = seq < 16 ? 256 : 2048, base = seq < 16 ? seq * 256 : MPR + (seq - 16) * 2048, per = L / 64;
        const float m0 = seq < 16 ? 0.f : a.in[I_STM][((seq - 16) * 2 + dir) * 4 + h];
        const int gi = dir * 8 + h, gf = dir * 8 + 4 + h; const float bi = bg[gi], bf_ = bg[gf];
        float lf[32], iv[32];
#pragma unroll
        for (int k = 0; k < 32; ++k) if (k < per) { const int p = 64 * k + lane, t = dir ? L - 1 - p : p; const size_t gr = (size_t)(base + t) * 16; lf[k] = gates[gr + gf]; iv[k] = gates[gr + gi]; }
        float cb_ = 0.f, cM = m0;
#pragma unroll
        for (int k = 0; k < 32; ++k) if (k < per) {
            float x = logsig_f(lf[k] + bf_);
#pragma unroll
            for (int o = 1; o < 64; o <<= 1) { const float n = __shfl_up(x, o); if (lane >= o) x += n; }
            const float b = cb_ + x, av = (iv[k] + bi) - b;
            float y = av;
#pragma unroll
            for (int o = 1; o < 64; o <<= 1) { const float n = __shfl_up(y, o); if (lane >= o) y = fmaxf(y, n); }
            const float Mv = fmaxf(cM, y);
            const int p = 64 * k + lane, t = dir ? L - 1 - p : p; const size_t o_ = (size_t)(base + t) * 8 + dir * 4 + h;
            aS[o_] = av; MSv[o_] = Mv; bS[o_] = b;
            cb_ = __shfl(b, 63); cM = __shfl(Mv, 63); }
    }
}
DI void ph_ffn_fix(const Args& a, int layer, int tid, int bid, int G) {
    const float* abnd = (const float*)(a.ws + WS_ABND); const float* gbnd = (const float*)(a.ws + WS_GBND); bf16* act = (bf16*)(a.ws + WS_FG); const float* w = a.in[I_WCFFN] + (size_t)layer * 3 * FF;
    for (int i = bid * NTHR + tid; i < 96 * FF; i += G * NTHR) { const int c = i % FF, rr = i / FF, pm = rr >> 1, which = rr & 1, row = pm * 256 + (which ? 255 : 0);
        int sbase, L; row_seq(row, sbase, L);
        float prev, cur, next;
        if (which == 0) { cur = abnd[(size_t)(pm * 4 + 0) * FF + c]; next = abnd[(size_t)(pm * 4 + 1) * FF + c]; prev = row > sbase ? abnd[(size_t)((pm - 1) * 4 + 3) * FF + c] : 0.f; }
        else { cur = abnd[(size_t)(pm * 4 + 3) * FF + c]; prev = abnd[(size_t)(pm * 4 + 2) * FF + c]; next = row < sbase + L - 1 ? abnd[(size_t)((pm + 1) * 4 + 0) * FF + c] : 0.f; }
        const float v = w[c] * prev + w[FF + c] * cur + w[2 * FF + c] * next;
        act[(size_t)row * FF + c] = (bf16)(pk2(gelu_tanh_f(v) * gbnd[(size_t)(pm * 2 + which) * FF + c], 0.f) & 0xffffu); }
}
template <int DK> DI void stage_k_rows(LAS bf16* Kst, const bf16* src, size_t ld, int tid) {
    constexpr int CPR = DK / 8;
#pragma unroll
    for (int c = tid; c < 64 * CPR; c += NTHR) { const int key = c / CPR, ch = c % CPR;
        const u32x4 v = *(const u32x4*)(src + (size_t)key * ld + ch * 8); *(LAS u32x4*)(Kst + key * (DK + 8) + ch * 8) = v; }
}
template <int DV> DI void stage_v_transposed(LAS bf16* Vst, const bf16* src, size_t ld, int tid) {
    constexpr int NCH = DV / 8;
#pragma unroll
    for (int c = tid; c < 64 * NCH; c += NTHR) { const int key = c & 63, ch = c >> 6;
        const u32x4 v = *(const u32x4*)(src + (size_t)key * ld + ch * 8); LAS bf16* d = Vst + (ch * 8) * 72 + key;
        d[0] = (bf16)(v.x & 0xffffu); d[72] = (bf16)(v.x >> 16); d[144] = (bf16)(v.y & 0xffffu); d[216] = (bf16)(v.y >> 16);
        d[288] = (bf16)(v.z & 0xffffu); d[360] = (bf16)(v.z >> 16); d[432] = (bf16)(v.w & 0xffffu); d[504] = (bf16)(v.w >> 16); }
}
DI bf16x8 pack_frag(const f32x16& x, int s) {
    u32x4 p; p.x = pk2(x[8 * s], x[8 * s + 1]); p.y = pk2(x[8 * s + 2], x[8 * s + 3]); p.z = pk2(x[8 * s + 4], x[8 * s + 5]); p.w = pk2(x[8 * s + 6], x[8 * s + 7]);
    return __builtin_bit_cast(bf16x8, p); }
DI bf16x8 ld_vfrag(const LAS bf16* Vst, int e, int s) {
    const u32x2 lo = *(const LAS u32x2*)(Vst + e * 72 + s), hi = *(const LAS u32x2*)(Vst + e * 72 + s + 8);
    u32x4 r; r.x = lo.x; r.y = lo.y; r.z = hi.x; r.w = hi.y; return __builtin_bit_cast(bf16x8, r); }

DI void mlstm_unit(const Args& a, LAS unsigned char* lds, int seq, int h, int qt, int tid, int lane, int wave) {
    unsigned char* ws = a.ws;
    const bf16* QB = (const bf16*)(ws + WS_QB); const bf16* KB = (const bf16*)(ws + WS_KB); const bf16* proj = (const bf16*)(ws + WS_PROJ);
    const float* aS = (const float*)(ws + WS_AS); const float* MSv = (const float*)(ws + WS_MS); const float* bS = (const float*)(ws + WS_BS);
    float* hscr = a.out + OFF_K;
    bf16* ycat = (bf16*)(ws + WS_H);
    const bool isS = seq >= 16; const int L = isS ? 2048 : 256, base = isS ? MPR + (seq - 16) * 2048 : seq * 256, bs = seq - 16;
    LAS bf16* Kst = (LAS bf16*)lds;
    LAS bf16* Vst = (LAS bf16*)(lds + 17408);
    LAS bf16* C0t = (LAS bf16*)lds;
    LAS float* aT = (LAS float*)(lds + 35840);
    LAS float* n0s = (LAS float*)(lds + 36864);
    LAS bf16* Qw = (LAS bf16*)(lds + 37888 + wave * 8704);
    const bf16* GS = (const bf16*)(a.out + OFF_K + (size_t)M * 512);
    const float* NS = (const float*)(ws + WS_NS);
    asm volatile("" : "+v"(lane), "+v"(tid));
    const int lt = lane & 31, hh = lane >> 5, q0 = qt * 256 + 32 * wave, trow = base + q0 + lt;
    { u32x4 qv[8];
#pragma unroll
      for (int i = 0; i < 8; ++i) qv[i] = *(const u32x4*)(QB + (size_t)trow * 512 + h * 128 + 16 * i + 8 * hh);
#pragma unroll
      for (int i = 0; i < 8; ++i) *(LAS u32x4*)(Qw + lt * 136 + 16 * i + 8 * hh) = qv[i]; }
    LDS_WAIT(); asm volatile("" ::: "memory");
#define QF(i) (*(const LAS bf16x8*)(Qw + lt * 136 + 16 * (i) + 8 * hh))
    f32x16 O[4];
#pragma unroll 1
    for (int dir = 0; dir < 2; ++dir) {
#pragma unroll
        for (int eb = 0; eb < 4; ++eb)
#pragma unroll
            for (int r = 0; r < 16; ++r) O[eb][r] = 0.f;
        float den = 0.f;
        const float Mt = MSv[(size_t)trow * 8 + dir * 4 + h], bt = bS[(size_t)trow * 8 + dir * 4 + h];
        if (isS) {
            __syncthreads();
            const int sidx = (bs * 2 + dir) * 4 + h;
            const float m0 = a.in[I_STM][sidx];
            float cf[8]; float Mref = m0;
#pragma unroll
            for (int i = 0; i < 8; ++i) cf[i] = MSv[(size_t)(base + 256 * i + (dir ? 0 : 255)) * 8 + dir * 4 + h];
            if (dir == 0) { if (qt > 0) Mref = cf[0];
#pragma unroll
                for (int i = 1; i < 8; ++i) if (i < qt) Mref = cf[i]; }
            else { if (qt < 7) Mref = cf[7];
#pragma unroll
                for (int i = 6; i >= 0; --i) if (i > qt) Mref = cf[i]; }
            const float c0f = __expf(m0 - Mref);
#pragma unroll
            for (int i = 0; i < 8; ++i) { const bool inc = dir ? (i > qt) : (i < qt); cf[i] = inc ? __expf(cf[i] - Mref) : 0.f; }
            const float* C0 = a.in[I_STC] + (size_t)sidx * 16384; const bf16* Gb = GS + (size_t)sidx * 8 * 16384;
            for (int c = tid; c < 2048; c += NTHR) { const int d = c >> 4, e8 = (c & 15) * 8;
                const f32x4 c0a = *(const f32x4*)(C0 + d * 128 + e8), c0b = *(const f32x4*)(C0 + d * 128 + e8 + 4);
                u32x4 gq[8];
#pragma unroll
                for (int i = 0; i < 8; ++i) gq[i] = *(const u32x4*)(Gb + (size_t)i * 16384 + d * 128 + e8);
                float v[8];
#pragma unroll
                for (int j = 0; j < 4; ++j) { v[j] = c0a[j] * c0f; v[4 + j] = c0b[j] * c0f; }
#pragma unroll
                for (int i = 0; i < 8; ++i) { float g[8]; unpack8(gq[i], g);
#pragma unroll
                    for (int j = 0; j < 8; ++j) v[j] += cf[i] * g[j]; }
                const u32x4 pk = pack8(v);
                C0t[(e8 + 0) * 136 + d] = (bf16)(pk.x & 0xffffu); C0t[(e8 + 1) * 136 + d] = (bf16)(pk.x >> 16); C0t[(e8 + 2) * 136 + d] = (bf16)(pk.y & 0xffffu); C0t[(e8 + 3) * 136 + d] = (bf16)(pk.y >> 16);
                C0t[(e8 + 4) * 136 + d] = (bf16)(pk.z & 0xffffu); C0t[(e8 + 5) * 136 + d] = (bf16)(pk.z >> 16); C0t[(e8 + 6) * 136 + d] = (bf16)(pk.w & 0xffffu); C0t[(e8 + 7) * 136 + d] = (bf16)(pk.w >> 16); }
            if (tid < 128) { float nsv[8];
#pragma unroll
                for (int i = 0; i < 8; ++i) nsv[i] = NS[((size_t)sidx * 8 + i) * 128 + tid];
                float nv = a.in[I_STN][sidx * 128 + tid] * c0f;
#pragma unroll
                for (int i = 0; i < 8; ++i) nv += cf[i] * nsv[i];
                n0s[tid] = nv; }
            __syncthreads();
            const float sc = __expf(Mref - Mt);
            float dq = 0.f;
#pragma unroll
            for (int i = 0; i < 8; ++i) { float q[8]; const u32x4 qq = __builtin_bit_cast(u32x4, QF(i));
                unpack8(qq, q);
#pragma unroll
                for (int j = 0; j < 8; ++j) { dq += q[j] * n0s[16 * i + 8 * hh + j]; q[j] *= sc; }
                const bf16x8 Qs = __builtin_bit_cast(bf16x8, pack8(q));
#pragma unroll
                for (int eb = 0; eb < 4; ++eb) { const bf16x8 cf = *(const LAS bf16x8*)(C0t + (32 * eb + lt) * 136 + 16 * i + 8 * hh); O[eb] = MFMA32(cf, Qs, O[eb]); }
                asm volatile("" ::: "memory"); }
            den += sc * dq;
        }
        const int kt_lo = 4 * qt, kt_hi = 4 * qt + 3;
        u32x4 kreg[2], vreg[2];
#define ML_LOAD(kt_) do { const int kr0_ = base + 64 * (kt_); _Pragma("unroll") for (int i_ = 0; i_ < 2; ++i_) { const int c_ = tid + NTHR * i_; \
            kreg[i_] = *(const u32x4*)(KB + (size_t)(kr0_ + (c_ >> 4)) * 512 + h * 128 + (c_ & 15) * 8); \
            vreg[i_] = *(const u32x4*)(proj + (size_t)(kr0_ + (c_ & 63)) * NPROJ + 1024 + h * 128 + (c_ >> 6) * 8); } \
            } while (0)
        ML_LOAD(kt_lo);
#pragma unroll 1
        for (int kt = kt_lo; kt <= kt_hi; ++kt) {
            __syncthreads();
#pragma unroll
            for (int i_ = 0; i_ < 2; ++i_) { const int c_ = tid + NTHR * i_;
                *(LAS u32x4*)(Kst + (c_ >> 4) * 136 + (c_ & 15) * 8) = kreg[i_];
                LAS bf16* d = Vst + ((c_ >> 6) * 8) * 72 + (c_ & 63); const u32x4 v = vreg[i_];
                d[0] = (bf16)(v.x & 0xffffu); d[72] = (bf16)(v.x >> 16); d[144] = (bf16)(v.y & 0xffffu); d[216] = (bf16)(v.y >> 16);
                d[288] = (bf16)(v.z & 0xffffu); d[360] = (bf16)(v.z >> 16); d[432] = (bf16)(v.w & 0xffffu); d[504] = (bf16)(v.w >> 16); }
            if (tid < 64) aT[tid] = aS[(size_t)(base + 64 * kt + tid) * 8 + dir * 4 + h];
            if (kt < kt_hi) ML_LOAD(kt + 1);
            __syncthreads();
#pragma unroll 1
            for (int sub = 0; sub < 2; ++sub) {
                const int s0 = 64 * kt + 32 * sub;
                const bool skip = dir ? (s0 + 31 < q0) : (s0 > q0 + 31);
                if (!skip) {
                    f32x16 S;
#pragma unroll
                    for (int r = 0; r < 16; ++r) S[r] = 0.f;
#pragma unroll
                    for (int i = 0; i < 8; ++i) { const bf16x8 kf = *(const LAS bf16x8*)(Kst + (32 * sub + lt) * 136 + 16 * i + 8 * hh); S = MFMA32(kf, QF(i), S); }
                    const bool diag = (s0 == q0);
                    const int vlo = (diag && dir) ? lt : 0, vhi = (diag && !dir) ? lt : 31;
#pragma unroll
                    for (int r = 0; r < 16; ++r) { const int sl = (r & 3) + 8 * (r >> 2) + 4 * hh; const float av = aT[32 * sub + sl];
                        float wgt = __expf(av - Mt);
                        wgt = (sl >= vlo && sl <= vhi) ? wgt : 0.f;
                        const float p = S[r] * wgt; den += p; S[r] = p; }
                    const bf16x8 P0 = pack_frag(S, 0), P1 = pack_frag(S, 1);
#pragma unroll
                    for (int eb = 0; eb < 4; ++eb) {
                        O[eb] = MFMA32(ld_vfrag(Vst, 32 * eb + lt, 32 * sub + 4 * hh), P0, O[eb]);
                        O[eb] = MFMA32(ld_vfrag(Vst, 32 * eb + lt, 32 * sub + 16 + 4 * hh), P1, O[eb]); }
                }
            }
        }
#undef ML_LOAD
        const float dent = den + __shfl_xor(den, 32);
        const float inv = 1.f / fmaxf(fabsf(dent), __expf(-(bt + Mt)));
        int trow2 = trow; asm volatile("" : "+v"(trow2));
        float* hp = hscr + (size_t)trow2 * 512 + h * 128 + 4 * hh;
        if (dir == 0) {
#pragma unroll
            for (int eb = 0; eb < 4; ++eb)
#pragma unroll
                for (int g = 0; g < 4; ++g) { f32x4 v; v[0] = O[eb][4 * g] * inv; v[1] = O[eb][4 * g + 1] * inv; v[2] = O[eb][4 * g + 2] * inv; v[3] = O[eb][4 * g + 3] * inv;
                    *(f32x4*)(hp + 32 * eb + 8 * g) = v; }
        } else {
            float ss = 0.f;
#pragma unroll
            for (int eb = 0; eb < 4; ++eb)
#pragma unroll
                for (int g = 0; g < 4; ++g) { const f32x4 v = *(const f32x4*)(hp + 32 * eb + 8 * g);
#pragma unroll
                    for (int j = 0; j < 4; ++j) { const float x = __builtin_fmaf(O[eb][4 * g + j], inv, v[j]); O[eb][4 * g + j] = x; ss = __builtin_fmaf(x, x, ss); }
                    asm volatile("" ::: "memory"); }
            ss += __shfl_xor(ss, 32);
            const float rs = rsqrtf(ss * (1.f / 128.f) + EPS);
            const float* gh = a.in[I_GMLSTM] + h * 128 + 4 * hh; const bf16* op = proj + (size_t)trow2 * NPROJ + 1536 + h * 128 + 4 * hh; bf16* yp = ycat + (size_t)trow2 * 1024 + h * 128 + 4 * hh;
#pragma unroll
            for (int eb = 0; eb < 4; ++eb)
#pragma unroll
                for (int g = 0; g < 4; ++g) { const int e = 32 * eb + 8 * g; const u32x2 ov = *(const u32x2*)(op + e); const f32x4 gv = *(const f32x4*)(gh + e);
                    const float o0 = __uint_as_float(ov.x << 16), o1 = __uint_as_float(ov.x & 0xffff0000u), o2 = __uint_as_float(ov.y << 16), o3 = __uint_as_float(ov.y & 0xffff0000u);
                    u32x2 w; w.x = pk2(O[eb][4 * g] * rs * gv[0] * sigm_f(o0), O[eb][4 * g + 1] * rs * gv[1] * sigm_f(o1));
                    w.y = pk2(O[eb][4 * g + 2] * rs * gv[2] * sigm_f(o2), O[eb][4 * g + 3] * rs * gv[3] * sigm_f(o3)); *(u32x2*)(yp + e) = w;
                    if (g & 1) asm volatile("" ::: "memory"); }
        }
    }
    __syncthreads();
#undef QF
}
DI void mlstm_state_unit(const Args& a, LAS unsigned char* lds, int seq, int h, int dir, int blk, int tid, int lane, int wave) {
    unsigned char* ws = a.ws;
    const bf16* KB = (const bf16*)(ws + WS_KB); const bf16* proj = (const bf16*)(ws + WS_PROJ);
    const float* aS = (const float*)(ws + WS_AS); const float* MSv = (const float*)(ws + WS_MS); const float* bS = (const float*)(ws + WS_BS);
    asm volatile("" : "+v"(lane), "+v"(tid));
    const bool isS = seq >= 16; const int base = (isS ? MPR + (seq - 16) * 2048 : seq * 256) + 256 * blk, lastrow = base + (dir ? 0 : 255);
    const float ML = MSv[(size_t)lastrow * 8 + dir * 4 + h], bL = bS[(size_t)lastrow * 8 + dir * 4 + h];
    LAS bf16* Kt = (LAS bf16*)lds;
    LAS bf16* Vst = (LAS bf16*)(lds + 18432);
    const int lt = lane & 31, hh = lane >> 5, db = wave >> 1, eb0 = 2 * (wave & 1);
    f32x16 C[2];
#pragma unroll
    for (int j = 0; j < 2; ++j)
#pragma unroll
        for (int r = 0; r < 16; ++r) C[j][r] = 0.f;
    float nacc = 0.f;
    u32x4 kreg[2], vreg[2]; float wreg[2];
#define ST_LOAD(kt_) do { const int kr0_ = base + 64 * (kt_); _Pragma("unroll") for (int i_ = 0; i_ < 2; ++i_) { const int c_ = tid + NTHR * i_, key_ = c_ & 63, ch_ = c_ >> 6; \
        kreg[i_] = *(const u32x4*)(KB + (size_t)(kr0_ + key_) * 512 + h * 128 + ch_ * 8); vreg[i_] = *(const u32x4*)(proj + (size_t)(kr0_ + key_) * NPROJ + 1024 + h * 128 + ch_ * 8); \
        wreg[i_] = aS[(size_t)(kr0_ + key_) * 8 + dir * 4 + h]; } } while (0)
    ST_LOAD(0);
#pragma unroll 1
    for (int kt = 0; kt < 4; ++kt) {
        __syncthreads();
#pragma unroll
        for (int i_ = 0; i_ < 2; ++i_) { const int c_ = tid + NTHR * i_, key = c_ & 63, ch = c_ >> 6; float k[8]; unpack8(kreg[i_], k);
            const float w = __expf(wreg[i_] - ML);
#pragma unroll
            for (int j = 0; j < 8; j += 2) { const unsigned p = pk2(k[j] * w, k[j + 1] * w); Kt[(ch * 8 + j) * 72 + key] = (bf16)(p & 0xffffu); Kt[(ch * 8 + j + 1) * 72 + key] = (bf16)(p >> 16); }
            LAS bf16* d = Vst + (ch * 8) * 72 + key; const u32x4 v = vreg[i_];
            d[0] = (bf16)(v.x & 0xffffu); d[72] = (bf16)(v.x >> 16); d[144] = (bf16)(v.y & 0xffffu); d[216] = (bf16)(v.y >> 16);
            d[288] = (bf16)(v.z & 0xffffu); d[360] = (bf16)(v.z >> 16); d[432] = (bf16)(v.w & 0xffffu); d[504] = (bf16)(v.w >> 16); }
        if (kt < 3) ST_LOAD(kt + 1);
        __syncthreads();
#pragma unroll
        for (int i = 0; i < 4; ++i) { const bf16x8 kf = *(const LAS bf16x8*)(Kt + (32 * db + lt) * 72 + 16 * i + 8 * hh);
#pragma unroll
            for (int j = 0; j < 2; ++j) { const bf16x8 vf = *(const LAS bf16x8*)(Vst + (32 * (eb0 + j) + lt) * 72 + 16 * i + 8 * hh); C[j] = MFMA32(kf, vf, C[j]); } }
        if (tid < 128) { float s = 0.f;
#pragma unroll 8
            for (int k = 0; k < 64; ++k) s += bf2f(Kt[tid * 72 + k]);
            nacc += s; }
    }
#undef ST_LOAD
    if (!isS) {
        float* oc = a.out + OFF_C + ((size_t)((seq * 2 + dir) * 4 + h)) * 16384;
#pragma unroll
        for (int j = 0; j < 2; ++j)
#pragma unroll
            for (int r = 0; r < 16; ++r) { const int d = 32 * db + (r & 3) + 8 * (r >> 2) + 4 * hh, e = 32 * (eb0 + j) + lt; oc[d * 128 + e] = C[j][r]; }
        if (tid < 128) a.out[OFF_N + ((size_t)((seq * 2 + dir) * 4 + h)) * 128 + tid] = nacc;
        if (tid == 0) a.out[OFF_MM + (seq * 2 + dir) * 4 + h] = bL + ML;
    } else {
        const size_t u = ((size_t)(((seq - 16) * 2 + dir) * 4 + h)) * 8 + blk;
        bf16* og = (bf16*)(a.out + OFF_K + (size_t)M * 512) + u * 16384;
#pragma unroll
        for (int j = 0; j < 2; ++j)
#pragma unroll
            for (int r = 0; r < 16; ++r) { const int d = 32 * db + (r & 3) + 8 * (r >> 2) + 4 * hh, e = 32 * (eb0 + j) + lt; og[d * 128 + e] = (bf16)(pk2(C[j][r], 0.f) & 0xffffu); }
        if (tid < 128) ((float*)(ws + WS_NS))[u * 128 + tid] = nacc;
    }
    __syncthreads();
}
constexpr int HY_CP = 8224;
constexpr int HY_UB = 65792, HY_XB = 90624;
DI u32x4 ld16_or0(const bf16* p, bool ok) { u32x4 z = {0u, 0u, 0u, 0u}; return ok ? *(const u32x4*)p : z; }
DI void hy_build_copies(LAS unsigned char* lds, const bf16* R, int RL, int tid) {
    const int nch = RL / 8;
    for (int mch = tid; mch <= nch; mch += NTHR) {
        const u32x4 lo = ld16_or0(R + 8 * (mch - 1), mch >= 1), hi = ld16_or0(R + 8 * mch, mch < nch);
        const unsigned W[8] = {lo.x, lo.y, lo.z, lo.w, hi.x, hi.y, hi.z, hi.w};
#pragma unroll
        for (int sg = 0; sg < 8; ++sg) { u32x4 o;
            if ((sg & 1) == 0) { o.x = W[sg / 2]; o.y = W[sg / 2 + 1]; o.z = W[sg / 2 + 2]; o.w = W[sg / 2 + 3]; }
            else { const int q = (sg - 1) / 2; o.x = __builtin_amdgcn_alignbit(W[q + 1], W[q], 16); o.y = __builtin_amdgcn_alignbit(W[q + 2], W[q + 1], 16);
                   o.z = __builtin_amdgcn_alignbit(W[q + 3], W[q + 2], 16); o.w = __builtin_amdgcn_alignbit(W[q + 4], W[q + 3], 16); }
            *(LAS u32x4*)(lds + sg * HY_CP + 16 * mch) = o; }
    }
}
DI f32x16 hy_mfma_loop(LAS unsigned char* lds, unsigned abase, unsigned bbase, int dlo, int dhi) {
    f32x16 acc;
#pragma unroll
    for (int r = 0; r < 16; ++r) acc[r] = 0.f;
#pragma unroll 2
    for (int dl = dlo; dl <= dhi; ++dl) { const int off = -64 * dl;
        const bf16x8 a0 = *(const LAS bf16x8*)(lds + abase + off), b0 = *(const LAS bf16x8*)(lds + bbase + off);
        const bf16x8 a1 = *(const LAS bf16x8*)(lds + abase + off + 32), b1 = *(const LAS bf16x8*)(lds + bbase + off + 32);
        acc = MFMA32(a0, b0, acc); acc = MFMA32(a1, b1, acc); }
    return acc;
}
DI void hyena_channel(const Args& a, LAS unsigned char* lds, int c, int tid, int lane, int wave) {
    unsigned char* ws = a.ws;
    const bf16* UT = (const bf16*)(ws + WS_UT) + (size_t)c * M; const bf16* X2T = (const bf16*)(ws + WS_X2T) + (size_t)c * M;
    bf16* ycat = (bf16*)(ws + WS_H) + 512 + c; const float hb = a.in[I_HYB][c];
    const int lt = lane & 31, hh = lane >> 5, sg = (8 - (lt & 7)) & 7, i8 = (lt + 7) & ~7;
    LAS bf16* Ub = (LAS bf16*)(lds + HY_UB); LAS bf16* Xb = (LAS bf16*)(lds + HY_XB);
    __syncthreads();
    for (int i = tid; i < 24832 / 16; i += NTHR) *(LAS u32x4*)(lds + HY_UB + 16 * i) = (u32x4){0u, 0u, 0u, 0u};
    hy_build_copies(lds, (const bf16*)(ws + WS_R2048) + (size_t)c * 4096, 4096, tid);
    __syncthreads();
    for (int i = tid; i < 1024; i += NTHR) { const int b = i >> 8, mch = i & 255; const size_t g = (size_t)MPR + b * 2048 + 8 * mch;
        *(LAS u32x4*)(Ub + b * 2568 + 256 + 8 * mch) = *(const u32x4*)(UT + g); *(LAS u32x4*)(Xb + b * 2568 + 256 + 8 * mch) = *(const u32x4*)(X2T + g); }
    __syncthreads();
    { const int bq = lt & 3, Ib = 8 * wave + (lt >> 2);
      const unsigned abase = sg * HY_CP + 2 * (2048 + 8 + 8 * hh - i8), bbase = HY_UB + 2 * (bq * 2568 + 256 + 32 * Ib + 8 * hh);
      const f32x16 acc = hy_mfma_loop(lds, abase, bbase, 8 * wave - 63, 8 * wave + 7);
#pragma unroll
      for (int r = 0; r < 16; ++r) { int t = 32 * Ib + (r & 3) + 8 * (r >> 2) + 4 * hh; asm volatile("" : "+v"(t));
          const float u = bf2f(Ub[bq * 2568 + 256 + t]), x2 = bf2f(Xb[bq * 2568 + 256 + t]);
          const float y = x2 * (acc[r] + hb * u); ycat[(size_t)(MPR + bq * 2048 + t) * 1024] = (bf16)(pk2(y, 0.f) & 0xffffu); } }
    __syncthreads();
    for (int i = tid; i < 24832 / 16; i += NTHR) *(LAS u32x4*)(lds + HY_UB + 16 * i) = (u32x4){0u, 0u, 0u, 0u};
    hy_build_copies(lds, (const bf16*)(ws + WS_R256) + (size_t)c * 512, 512, tid);
    __syncthreads();
    { const int sq = tid >> 5, mch = tid & 31; const size_t g = (size_t)sq * 256 + 8 * mch;
      *(LAS u32x4*)(Ub + sq * 776 + 256 + 8 * mch) = *(const u32x4*)(UT + g); *(LAS u32x4*)(Xb + sq * 776 + 256 + 8 * mch) = *(const u32x4*)(X2T + g); }
    __syncthreads();
    if (wave < 4) { const int bq = 4 * wave + (lt & 3), Ib = lt >> 2;
      const unsigned abase = sg * HY_CP + 2 * (256 + 8 + 8 * hh - i8), bbase = HY_UB + 2 * (bq * 776 + 256 + 32 * Ib + 8 * hh);
      const f32x16 acc = hy_mfma_loop(lds, abase, bbase, -7, 7);
#pragma unroll
      for (int r = 0; r < 16; ++r) { int t = 32 * Ib + (r & 3) + 8 * (r >> 2) + 4 * hh; asm volatile("" : "+v"(t));
          const float u = bf2f(Ub[bq * 776 + 256 + t]), x2 = bf2f(Xb[bq * 776 + 256 + t]);
          const float y = x2 * (acc[r] + hb * u); ycat[(size_t)(bq * 256 + t) * 1024] = (bf16)(pk2(y, 0.f) & 0xffffu); } }
    __syncthreads();
}
#ifndef MK_MB_S
#define MK_MB_S 1
#define MK_MB_P 1
#define MK_MA_H 1
#define MK_MA_S 1
#endif
DI void ph_mixers_a(const Args& a, LAS unsigned char* lds, int tid, int lane, int wave, int bid, int G) {
    if (G == 256) { const int c0 = 64 * (bid & 7) + 2 * (bid >> 3); for (int rp = 0; rp < MK_MA_H; ++rp) { hyena_channel(a, lds, c0, tid, lane, wave); hyena_channel(a, lds, c0 + 1, tid, lane, wave); } }
    else for (int c = bid; c < 512; c += G) hyena_channel(a, lds, c, tid, lane, wave);
    for (int it = bid; it < 384; it += G) { const bool smp = it < 256; const int rr = smp ? it : it - 256;
        for (int rp = 0; rp < MK_MA_S; ++rp)
        mlstm_state_unit(a, lds, smp ? 16 + (rr >> 6) : (rr >> 3), smp ? (rr >> 4) & 3 : (rr >> 1) & 3, smp ? (rr >> 3) & 1 : rr & 1, smp ? rr & 7 : 0, tid, lane, wave); }
}
DI void ph_mixers_b(const Args& a, LAS unsigned char* lds, int tid, int lane, int wave, int bid, int G) {
    if (G > 192) { if (bid >= 192) bg_convert(a, lds, 1, bid - 192, G - 192, tid); } else bg_convert(a, lds, 1, bid, G, tid);
    for (int it = bid; it < 192; it += G) { const bool smp = it < 128; const int rr = smp ? it : it - 128;
        for (int rp = 0; rp < (smp ? MK_MB_S : MK_MB_P); ++rp)
        mlstm_unit(a, lds, smp ? 16 + (rr >> 5) : (rr >> 2), smp ? (rr >> 3) & 3 : rr & 3, smp ? rr & 7 : 0, tid, lane, wave); }
}
DI void attn_unit(const Args& a, LAS unsigned char* lds, int kind, int b, int h, int blk, int tid, int lane, int wave) {
    unsigned char* ws = a.ws;
    const bf16* Q1 = (const bf16*)(ws + WS_Q1); const bf16* K1 = (const bf16*)(ws + WS_K1); const bf16* V1 = (const bf16*)(ws + WS_V1);
    const bf16* CK = (const bf16*)(ws + WS_CK); const bf16* CV = (const bf16*)(ws + WS_CV);
    bf16* obuf = (bf16*)(ws + WS_H);
    LAS bf16* Kst = (LAS bf16*)lds;
    LAS bf16* Vst = (LAS bf16*)(lds + 9216);
    LAS float* rpbs = (LAS float*)(lds + 18432);
    asm volatile("" : "+v"(lane), "+v"(tid));
    const int lt = lane & 31, hh = lane >> 5;
    int qrow, r = 0, qc = 0, nctx, nloc, kr_lo = 0, rs = 0, cs = 0;
    if (kind == 0) { qrow = b * 256 + 32 * wave + lt; nctx = 0; nloc = 4; }
    else { const int r0 = 4 * blk; r = r0 + (wave >> 1); qc = 32 * (wave & 1) + lt; qrow = MPR + b * 2048 + r * 64 + qc; nctx = 8;
        const int lo = r0 - 4 < 0 ? 0 : (r0 - 4 > 24 ? 24 : r0 - 4); const int r3 = r0 + 3 - 4; const int hi = (r3 < 0 ? 0 : (r3 > 24 ? 24 : r3)) + 7;
        kr_lo = lo; nloc = hi - lo + 1; rs = r - 4 < 0 ? 0 : (r - 4 > 24 ? 24 : r - 4); cs = qc - 8 < 0 ? 0 : (qc - 8 > 48 ? 48 : qc - 8);
        __syncthreads();
        if (tid < 465) rpbs[tid] = a.in[I_RPB][h * 465 + tid] * 1.4426950408889634f;
    }
    int icol[2][16]; unsigned okm[2] = {0u, 0u};
#pragma unroll
    for (int sub = 0; sub < 2; ++sub)
#pragma unroll
        for (int q = 0; q < 16; ++q) { const int kc = 32 * sub + (q & 3) + 8 * (q >> 2) + 4 * hh; int ic = kc - qc + 15; ic = ic < 0 ? 0 : (ic > 30 ? 30 : ic);
            icol[sub][q] = ic; okm[sub] |= ((kc >= cs) && (kc < cs + 16)) ? (1u << q) : 0u; }
    bf16x8 Qf[4];
#pragma unroll
    for (int i = 0; i < 4; ++i) Qf[i] = *(const bf16x8*)(Q1 + (size_t)qrow * 1024 + h * 64 + 16 * i + 8 * hh);
    f32x16 O[2];
#pragma unroll
    for (int eb = 0; eb < 2; ++eb)
#pragma unroll
        for (int q = 0; q < 16; ++q) O[eb][q] = 0.f;
    float mrun = -INFINITY, lrun = 0.f;
    const int kkey = tid >> 3, kch = tid & 7, vkey = tid & 63, vch = tid >> 6;
    u32x4 kreg, vreg;
#define ATT_SRC(st_, ksrc_, vsrc_, ld_) do { const bool ic_ = (st_) < nctx; const int kr_ = kr_lo + ((st_) - nctx); \
        if (ic_) { ksrc_ = CK + ((size_t)((b * 16 + h) * 512 + 64 * (st_))) * 64; vsrc_ = CV + ((size_t)((b * 16 + h) * 512 + 64 * (st_))) * 64; ld_ = 64; } \
        else if (kind == 0) { const size_t row0 = (size_t)b * 256 + 64 * (st_); ksrc_ = K1 + row0 * 1024 + h * 64; vsrc_ = V1 + row0 * 1024 + h * 64; ld_ = 1024; } \
        else { const size_t row0 = (size_t)MPR + b * 2048 + kr_ * 64; ksrc_ = K1 + row0 * 1024 + h * 64; vsrc_ = V1 + row0 * 1024 + h * 64; ld_ = 1024; } } while (0)
    { const bf16* ksrc; const bf16* vsrc; size_t ld; ATT_SRC(0, ksrc, vsrc, ld);
      kreg = *(const u32x4*)(ksrc + (size_t)kkey * ld + kch * 8); vreg = *(const u32x4*)(vsrc + (size_t)vkey * ld + vch * 8); }
#pragma unroll 1
    for (int st = 0; st < nctx + nloc; ++st) {
        const bool isctx = st < nctx; const int kr = kr_lo + (st - nctx);
        __syncthreads();
        *(LAS u32x4*)(Kst + kkey * 72 + kch * 8) = kreg;
        { LAS bf16* d = Vst + (vch * 8) * 72 + vkey;
          d[0] = (bf16)(vreg.x & 0xffffu); d[72] = (bf16)(vreg.x >> 16); d[144] = (bf16)(vreg.y & 0xffffu); d[216] = (bf16)(vreg.y >> 16);
          d[288] = (bf16)(vreg.z & 0xffffu); d[360] = (bf16)(vreg.z >> 16); d[432] = (bf16)(vreg.w & 0xffffu); d[504] = (bf16)(vreg.w >> 16); }
        if (st + 1 < nctx + nloc) { const bf16* ksrc; const bf16* vsrc; size_t ld; ATT_SRC(st + 1, ksrc, vsrc, ld);
            kreg = *(const u32x4*)(ksrc + (size_t)kkey * ld + kch * 8); vreg = *(const u32x4*)(vsrc + (size_t)vkey * ld + vch * 8); }
        __syncthreads();
        const bool active = (kind == 0) || isctx || (kr >= rs && kr < rs + 8);
        if (active) {
#pragma unroll
            for (int sub = 0; sub < 2; ++sub) {
                f32x16 S;
#pragma unroll
                for (int q = 0; q < 16; ++q) S[q] = 0.f;
#pragma unroll
                for (int i = 0; i < 4; ++i) { const bf16x8 kf = *(const LAS bf16x8*)(Kst + (32 * sub + lt) * 72 + 16 * i + 8 * hh); S = MFMA32(kf, Qf[i], S); }
                if (kind == 1 && !isctx) {
                    const LAS float* rb = rpbs + (kr - r + 7) * 31;
                    float bv[16];
#pragma unroll
                    for (int q = 0; q < 16; ++q) bv[q] = rb[icol[sub][q]];
#pragma unroll
                    for (int q = 0; q < 16; ++q) S[q] = ((okm[sub] >> q) & 1u) ? S[q] + bv[q] : -INFINITY;
                }
                float mx = fmaxf(fmaxf(fmaxf(S[0], S[1]), fmaxf(S[2], S[3])), fmaxf(fmaxf(S[4], S[5]), fmaxf(S[6], S[7])));
                mx = fmaxf(mx, fmaxf(fmaxf(fmaxf(S[8], S[9]), fmaxf(S[10], S[11])), fmaxf(fmaxf(S[12], S[13]), fmaxf(S[14], S[15]))));
                mx = fmaxf(mx, __shfl_xor(mx, 32));
                if (!__all(mx <= mrun + 8.f)) { const float mnew = fmaxf(mrun, mx); const float alpha = exp2_f(mrun - mnew);
                    lrun *= alpha; mrun = mnew;
#pragma unroll
                    for (int eb = 0; eb < 2; ++eb)
#pragma unroll
                        for (int q = 0; q < 16; ++q) O[eb][q] *= alpha; }
                float ps = 0.f;
#pragma unroll
                for (int q = 0; q < 16; ++q) { const float p = exp2_f(S[q] - mrun); S[q] = p; ps += p; }
                lrun += ps;
                const bf16x8 P0 = pack_frag(S, 0), P1 = pack_frag(S, 1);
#pragma unroll
                for (int eb = 0; eb < 2; ++eb) {
                    O[eb] = MFMA32(ld_vfrag(Vst, 32 * eb + lt, 32 * sub + 4 * hh), P0, O[eb]);
                    O[eb] = MFMA32(ld_vfrag(Vst, 32 * eb + lt, 32 * sub + 16 + 4 * hh), P1, O[eb]); }
            }
        }
    }
    const float inv = 1.f / (lrun + __shfl_xor(lrun, 32));
    bf16* op = obuf + (size_t)qrow * 1024 + h * 64;
#pragma unroll
    for (int eb = 0; eb < 2; ++eb)
#pragma unroll
        for (int g = 0; g < 4; ++g) { u32x2 w; w.x = pk2(O[eb][4 * g] * inv, O[eb][4 * g + 1] * inv); w.y = pk2(O[eb][4 * g + 2] * inv, O[eb][4 * g + 3] * inv);
            *(u32x2*)(op + 32 * eb + 8 * g + 4 * hh) = w; }
    __syncthreads();
#undef ATT_SRC
}
#ifndef MK_AT_N
#define MK_AT_N 1
#define MK_AT_C 1
#endif
DI void ph_attention(const Args& a, LAS unsigned char* lds, int tid, int lane, int wave, int bid, int G) {
    for (int it = bid; it < 768; it += G) {
        if (it < 512) { for (int rp = 0; rp < MK_AT_N; ++rp) attn_unit(a, lds, 1, it >> 7, (it >> 3) & 15, it & 7, tid, lane, wave); }
        else { const int r = it - 512; for (int rp = 0; rp < MK_AT_C; ++rp) attn_unit(a, lds, 0, r >> 4, r & 15, 0, tid, lane, wave); }
    }
}
__global__ void __launch_bounds__(NTHR, 2) mk_fwd(Args a) {
    extern __shared__ __attribute__((aligned(16))) unsigned char lds_raw[];
    LAS unsigned char* lds = (LAS unsigned char*)lds_raw;
    const int tid = threadIdx.x, lane = tid & 63, wave = __builtin_amdgcn_readfirstlane(tid >> 6), bid = blockIdx.x, G = gridDim.x;
    const int gw = bid * NWAVES + wave, NGW = G * NWAVES;
    unsigned char* ws = a.ws;
    for (int u = tid; u < (LDS_BYTES - LDSCTL_OFF) / 4; u += NTHR) ((LAS unsigned*)(lds + LDSCTL_OFF))[u] = 0u;
    __syncthreads();
    XcdBarrier bar; bar.bar = (unsigned*)(ws + WS_CTL) + CW_BAR; bar.x = 0; bar.st = nullptr;
    const bool multi = (a.ph_hi - a.ph_lo) > 1;
    if (multi) bar = xcd_barrier_post((unsigned*)(ws + WS_CTL) + CW_BAR, (volatile LAS unsigned*)(lds + MISC_OFF) + 8);
    float* out = a.out;
    float* modF = (float*)(ws + WS_MODF);
    bf16* hbuf = (bf16*)(ws + WS_H);
    bf16* dlt = (bf16*)(ws + WS_DL);
    const float* xsB = a.in[I_XS] - (size_t)MPR * D;
    const int lo = a.ph_lo, hi = a.ph_hi;
#ifndef MK_ONLY
#define MK_ONLY -1
#endif
#define IN(k) ((MK_ONLY < 0 || MK_ONLY == (k)) && lo <= (k) && (k) < hi)
#define SEAM(k) do { if ((k) + 1 < hi) xcd_barrier(bar); } while (0)
#ifndef MK_REPMASK
#define MK_REPMASK 0u
#endif
#define MK_REP(k) (((MK_REPMASK >> (k)) & 1u) ? 2 : 1)
#define PH(k, ...) if (IN(k)) { if (MK_REP(k) == 2) { __VA_ARGS__ xcd_barrier(bar); } { __VA_ARGS__ } SEAM(k); }
#define GEMM_UP(l) do { pg8::Gemm g{hbuf, (const bf16*)(ws + WS_WUP) + (size_t)(l) * 5632 * 1024, M, 2 * FF, D}; pg8::StaticOrder S; S.init(M, 2 * FF, G, bid); \
            pg8::EpiFfn E{(bf16*)(ws + WS_FG), a.in[I_WCFFN] + (size_t)(l) * 3 * FF, (float*)(ws + WS_ABND), (float*)(ws + WS_GBND), (LAS float*)(lds + XCH_OFF)}; \
            pg8::gemm_phase<pg8::EpiFfn, pg8::StaticOrder, true, true>(lds, g, S, E); } while (0)
#define GEMM_DOWN(l) do { pg8::Gemm g{(const bf16*)(ws + WS_FG), (const bf16*)(ws + WS_WDN) + (size_t)(l) * 1024 * FF, M, D, FF}; pg8::StaticOrder S; S.init(M, D, G, bid); \
            pg8::EpiDelta E{dlt, modF + (size_t)(l) * 5 * 6144 + 5 * 1024}; \
            pg8::gemm_phase<pg8::EpiDelta, pg8::StaticOrder, true, true>(lds, g, S, E); } while (0)
    PH(0, ph_prologue(a, lds, tid, lane, wave, bid, G);)
    PH(1, ph_modf_norm0(a, lds, tid, lane, wave, bid, G);)
    PH(2, pg8::Gemm g{hbuf, (const bf16*)(ws + WS_WAB), M, NPROJ, D}; pg8::StaticOrder S; S.init(M, NPROJ, G, bid);
            pg8::EpiProj E{(bf16*)(ws + WS_PROJ), NPROJ, (float*)(ws + WS_GATES), 8};
            pg8::gemm_phase<pg8::EpiProj, pg8::StaticOrder, true, true>(lds, g, S, E);)
    PH(3, ph_e1(a, lds, tid, gw, NGW, lane, wave, bid, G);)
    PH(4, ph_mixers_a(a, lds, tid, lane, wave, bid, G);)
    PH(5, ph_mixers_b(a, lds, tid, lane, wave, bid, G);)
    PH(6, pg8::Gemm g{hbuf, (const bf16*)(ws + WS_WOAB), M, D, D}; pg8::StaticOrder S; S.init(M, D, G, bid);
            pg8::EpiDelta E{dlt, modF + 2 * 1024};
            pg8::gemm_phase<pg8::EpiDelta, pg8::StaticOrder, true, true>(lds, g, S, E);)
    PH(7, ph_norm(a.in[I_XP], xsB, dlt, out, a.in[I_GFFN], modF, 3, 4, hbuf, gw, NGW, lane);)
    PH(8, GEMM_UP(0);)
    PH(9, ph_ffn_fix(a, 0, tid, bid, G);)
    PH(10, GEMM_DOWN(0);)
    PH(11, ph_norm(out, out, dlt, out, a.in[I_GMIX] + D, modF + 5 * 6144, 0, 1, hbuf, gw, NGW, lane);)
    PH(12, pg8::Gemm g{hbuf, (const bf16*)(ws + WS_WC), M, 3 * D, D}; pg8::StaticOrder S; S.init(M, 3 * D, G, bid);
            pg8::EpiQKV E{(bf16*)(ws + WS_Q1), (size_t)(WS_K1 - WS_Q1) / 2, out + OFF_K, (size_t)(OFF_V - OFF_K)};
            pg8::gemm_phase<pg8::EpiQKV, pg8::StaticOrder, true, true>(lds, g, S, E);)
    PH(13, ph_attention(a, lds, tid, lane, wave, bid, G);)
    PH(14, pg8::Gemm g{hbuf, (const bf16*)(ws + WS_WOC), M, D, D}; pg8::StaticOrder S; S.init(M, D, G, bid);
            pg8::EpiDelta E{dlt, modF + 5 * 6144 + 2 * 1024};
            pg8::gemm_phase<pg8::EpiDelta, pg8::StaticOrder, true, true>(lds, g, S, E);)
    PH(15, ph_norm(out, out, dlt, out, a.in[I_GFFN] + D, modF + 5 * 6144, 3, 4, hbuf, gw, NGW, lane);)
    PH(16, GEMM_UP(1);)
    PH(17, ph_ffn_fix(a, 1, tid, bid, G);)
    PH(18, GEMM_DOWN(1);)
    PH(19, ph_final_norm(out, dlt, a.in[I_GFIN], gw, NGW, lane);)
#undef IN
#undef SEAM
}
}

extern "C" void kernel_launch(void* const* d_in, const int* in_sizes, int n_in, void* d_out, int out_size, void* d_ws, size_t ws_size, hipStream_t stream) {
    using namespace mk;
    static int grid = 0;
    if (grid == 0) {
        if (n_in != 33 || out_size != 23085184 || ws_size < WS_END) { fprintf(stderr, "kernel_launch: unexpected shapes: n_in %d out %d ws %zu\n", n_in, out_size, ws_size); grid = -1; return; }
        int dev = 0, cus = 0, per_cu = 0;
        if (hipGetDevice(&dev) != hipSuccess || hipDeviceGetAttribute(&cus, hipDeviceAttributeMultiprocessorCount, dev) != hipSuccess) { grid = -1; return; }
        if (hipFuncSetAttribute((const void*)mk_fwd, hipFuncAttributeMaxDynamicSharedMemorySize, LDS_BYTES) != hipSuccess) { fprintf(stderr, "kernel_launch: hipFuncSetAttribute failed\n"); grid = -1; return; }
        if (hipOccupancyMaxActiveBlocksPerMultiprocessor(&per_cu, (const void*)mk_fwd, NTHR, LDS_BYTES) != hipSuccess || per_cu < 1) { fprintf(stderr, "kernel_launch: occupancy query says %d\n", per_cu); per_cu = 1; }
        (void)hipGetLastError();
        grid = cus;
    }
    if (grid < 0) return;
    if (hipMemsetAsync((char*)d_ws + WS_CTL, 0, CTL_ZERO_BYTES, stream) != hipSuccess) return;
    Args a{};
    for (int i = 0; i < 33; ++i) a.in[i] = (const float*)d_in[i];
    a.out = (float*)d_out; a.ws = (unsigned char*)d_ws;
#if MK_ONE_LAUNCH
    a.ph_lo = 0; a.ph_hi = NPHASES;
    { void* args[] = {&a};
      hipError_t e = hipLaunchCooperativeKernel((const void*)mk_fwd, dim3(grid), dim3(NTHR), args, LDS_BYTES, stream);
      if (e != hipSuccess) fprintf(stderr, "kernel_launch: cooperative launch failed: %s (grid %d)\n", hipGetErrorString(e), grid); }
#else
    for (int ph = 0; ph < NPHASES; ++ph) { a.ph_lo = ph; a.ph_hi = ph + 1; hipLaunchKernelGGL(mk_fwd, dim3(grid), dim3(NTHR), LDS_BYTES, stream, a); }
#endif
}
```

```cpp
#include <hip/hip_runtime.h>
#include <cstdio>
#include <cstdint>
namespace pg8 {
#define PG8_LAS __attribute__((address_space(3)))
typedef unsigned short bf16_t;
typedef short bf16x8 __attribute__((ext_vector_type(8)));
typedef float f32x4 __attribute__((ext_vector_type(4)));
typedef unsigned u32x4 __attribute__((ext_vector_type(4)));
constexpr int BM = 256, BK = 64, HALF = 128, HTB = HALF * BK * 2  , STAGE_BYTES = 8 * HTB, NXCD = 8, WGM = 8;

__host__ __device__ __forceinline__ int lds_byte(int r, int c) { const int st = (r >> 4) * 2 + (c >> 5), rr = r & 15, cc = c & 31, ob = rr * 64 + cc * 2; return st * 1024 + (ob ^ (((ob >> 9) & 1) << 5)); }
__host__ __device__ __forceinline__ void stage_rc(int b, int& R, int& C) { const int st = b / 1024, sb = b % 1024, swz = sb ^ (((sb >> 9) & 1) << 5); R = (st >> 1) * 16 + swz / 64; C = (st & 1) * 32 + (swz % 64) / 2; }
__host__ __device__ __forceinline__ int perm32(int rho) { const int n = rho >> 4, i = rho & 15; return 8 * (i >> 2) + 4 * n + (i & 3); }

struct Unit { int pm, pn; };
struct Gemm { const bf16_t* A; const bf16_t* Bt; int M, N, K; };

struct StaticOrder {
    int nM, nN, nwg, G, c;
    __host__ __device__ void init(int M, int N, int G_, int c_) { nM = M / BM; nN = N / BM; nwg = nM * nN; G = G_; c = c_; }
    __host__ __device__ bool next(int i, Unit& u) const {
        const long L = (long)i * G + c; if (L >= nwg) return false;
        int wgid = (int)L; { const int q = nwg / NXCD, r = nwg % NXCD, xcd = wgid % NXCD, off = wgid / NXCD; wgid = (xcd < r ? xcd * (q + 1) : r * (q + 1) + (xcd - r) * q) + off; }
        const int nig = WGM * nN, gid = wgid / nig, fm = gid * WGM, gsz = (nM - fm) < WGM ? (nM - fm) : WGM;
        u.pm = fm + ((wgid % nig) % gsz); u.pn = (wgid % nig) / gsz; return true;
    }
    __device__ __forceinline__ void a_ready(const Unit&) const {}
    __device__ __forceinline__ void done(const Unit&) const {}
};

__device__ __forceinline__ unsigned cvt_pk_bf16(float lo, float hi) { unsigned r; asm volatile("v_cvt_pk_bf16_f32 %0, %1, %2" : "=v"(r) : "v"(lo), "v"(hi)); return r; }
typedef float f32x2 __attribute__((ext_vector_type(2)));
__device__ __forceinline__ f32x2 gelu_pk(f32x2 v) {
    const f32x2 av = __builtin_elementwise_abs(v), d = av * 0.2316418882f + 1.0f;
    f32x2 t; t.x = __builtin_amdgcn_rcpf(d.x); t.y = __builtin_amdgcn_rcpf(d.y);
    f32x2 q = t * 0.5307027145f + (-0.7265760135f); q = q * t + 0.7107068705f; q = q * t + (-0.142248368f); q = q * t + 0.127414796f; q = q * t;
    const f32x2 s = (v * v) * (-0.72134752044f);
    f32x2 e; e.x = __builtin_amdgcn_exp2f(s.x); e.y = __builtin_amdgcn_exp2f(s.y);
    const f32x2 m = v * (q * e), r = v - m;
    f32x2 o; o.x = v.x < 0.f ? m.x : r.x; o.y = v.y < 0.f ? m.y : r.y; return o;
}

template <int ACT  > struct EpiBf16 {
    static constexpr bool PERM = true, AFTER_DRAIN = false; static_assert(ACT == 0 || ACT == 1, "EpiBf16: ACT is 0 (none) or 1 (gelu_pk)");
    bf16_t* O; int ldc; const float* bias; int split_cols; size_t split_stride; float scale0;
    __device__ __forceinline__ void operator()(const f32x4 (&acc)[2][2][4][2], const Unit& u, int wr, int wc, int fr, int fq) const {
        const int row0 = u.pm * BM + wr * 64 + fr; int colt = u.pn * BM; bf16_t* base = O;
        float sc = 1.f; if (split_cols) { const int t = colt / split_cols; base += (size_t)t * split_stride; colt -= t * split_cols; if (t == 0) sc = scale0; }
        const int col0 = colt + wc * 32 + 8 * fq, bcol0 = u.pn * BM + wc * 32 + 8 * fq;
        f32x4 bv[2][2];
#pragma unroll
        for (int bj = 0; bj < 2; ++bj)
#pragma unroll
            for (int n = 0; n < 2; ++n) bv[bj][n] = bias ? *(const f32x4*)(bias + bcol0 + bj * HALF + 4 * n) : (f32x4){0.f, 0.f, 0.f, 0.f};
#pragma unroll
        for (int ai = 0; ai < 2; ++ai)
#pragma unroll
            for (int m = 0; m < 4; ++m) { bf16_t* rowp = base + (size_t)(row0 + ai * HALF + m * 16) * ldc + col0;
#pragma unroll
                for (int bj = 0; bj < 2; ++bj) { f32x4 v0 = acc[ai][bj][m][0] + bv[bj][0], v1 = acc[ai][bj][m][1] + bv[bj][1];
                    if (ACT == 1) { f32x2 a = gelu_pk((f32x2){v0[0], v0[1]}), b = gelu_pk((f32x2){v0[2], v0[3]}), c = gelu_pk((f32x2){v1[0], v1[1]}), d = gelu_pk((f32x2){v1[2], v1[3]});
                        v0 = (f32x4){a.x, a.y, b.x, b.y}; v1 = (f32x4){c.x, c.y, d.x, d.y}; }
                    v0 = v0 * sc; v1 = v1 * sc; u32x4 w; w.x = cvt_pk_bf16(v0[0], v0[1]); w.y = cvt_pk_bf16(v0[2], v0[3]); w.z = cvt_pk_bf16(v1[0], v1[1]); w.w = cvt_pk_bf16(v1[2], v1[3]);
                    *(u32x4*)(rowp + bj * HALF) = w; } }
    }
};
typedef float f32x2e __attribute__((ext_vector_type(2)));
typedef __bf16 bf2e __attribute__((ext_vector_type(2)));
__device__ __forceinline__ unsigned pkbf(float lo, float hi) { f32x2e v = {lo, hi}; bf2e b = __builtin_convertvector(v, bf2e); return __builtin_bit_cast(unsigned, b); }
struct EpiProj {
    static constexpr bool PERM = true, AFTER_DRAIN = false;
    bf16_t* O; int ldc; float* gates; int gate_pn;
    __device__ __forceinline__ void operator()(const f32x4 (&acc)[2][2][4][2], const Unit& u, int wr, int wc, int fr, int fq) const {
        const int row0 = u.pm * BM + wr * 64 + fr, col0 = u.pn * BM + wc * 32 + 8 * fq;
        const bool gt = (u.pn == gate_pn) && (wc == 0) && (fq < 2);
#pragma unroll
        for (int ai = 0; ai < 2; ++ai)
#pragma unroll
            for (int m = 0; m < 4; ++m) { const int row = row0 + ai * HALF + m * 16; bf16_t* rowp = O + (size_t)row * ldc + col0;
#pragma unroll
                for (int bj = 0; bj < 2; ++bj) { const f32x4 v0 = acc[ai][bj][m][0], v1 = acc[ai][bj][m][1];
                    u32x4 w; w.x = pkbf(v0[0], v0[1]); w.y = pkbf(v0[2], v0[3]); w.z = pkbf(v1[0], v1[1]); w.w = pkbf(v1[2], v1[3]);
                    *(u32x4*)(rowp + bj * HALF) = w;
                    if (bj == 0 && gt) { *(f32x4*)(gates + (size_t)row * 16 + 8 * fq) = v0; *(f32x4*)(gates + (size_t)row * 16 + 8 * fq + 4) = v1; } } }
    }
};
struct EpiDelta {
    static constexpr bool PERM = true, AFTER_DRAIN = false;
    bf16_t* Dl; const float* gate5;
    __device__ __forceinline__ void operator()(const f32x4 (&acc)[2][2][4][2], const Unit& u, int wr, int wc, int fr, int fq) const {
        const int row0 = u.pm * BM + wr * 64 + fr, col0 = u.pn * BM + wc * 32 + 8 * fq;
        const int v = u.pm < 16 ? 4 : ((u.pm - 16) >> 3);
        const float* g = gate5 + (size_t)v * 6144;
        f32x4 gv[2][2];
#pragma unroll
        for (int bj = 0; bj < 2; ++bj)
#pragma unroll
            for (int n = 0; n < 2; ++n) gv[bj][n] = *(const f32x4*)(g + col0 + bj * HALF + 4 * n);
#pragma unroll
        for (int ai = 0; ai < 2; ++ai)
#pragma unroll
            for (int m = 0; m < 4; ++m) { bf16_t* rowp = Dl + (size_t)(row0 + ai * HALF + m * 16) * 1024 + col0;
#pragma unroll
                for (int bj = 0; bj < 2; ++bj) { const f32x4 v0 = acc[ai][bj][m][0] * gv[bj][0], v1 = acc[ai][bj][m][1] * gv[bj][1];
                    u32x4 w; w.x = pkbf(v0[0], v0[1]); w.y = pkbf(v0[2], v0[3]); w.z = pkbf(v1[0], v1[1]); w.w = pkbf(v1[2], v1[3]);
                    *(u32x4*)(rowp + bj * HALF) = w; } }
    }
};
struct EpiQKV {
    static constexpr bool PERM = true, AFTER_DRAIN = false;
    bf16_t* Q; size_t qkv_stride; float* outk; size_t kv_stride;
    __device__ __forceinline__ void operator()(const f32x4 (&acc)[2][2][4][2], const Unit& u, int wr, int wc, int fr, int fq) const {
        const int t = u.pn >> 2; const int colt = (u.pn & 3) * BM;
        bf16_t* base = Q + (size_t)t * qkv_stride; float* fo = outk + (size_t)(t == 2 ? 1 : 0) * kv_stride; const float sc = t == 0 ? 0.18033688011112042f : 1.0f;
        const int row0 = u.pm * BM + wr * 64 + fr, col0 = colt + wc * 32 + 8 * fq;
        const bool cache = (t != 0) && (u.pm < 16);
#pragma unroll
        for (int ai = 0; ai < 2; ++ai)
#pragma unroll
            for (int m = 0; m < 4; ++m) { const int row = row0 + ai * HALF + m * 16; bf16_t* rowp = base + (size_t)row * 1024 + col0;
#pragma unroll
                for (int bj = 0; bj < 2; ++bj) { const f32x4 v0 = acc[ai][bj][m][0] * sc, v1 = acc[ai][bj][m][1] * sc;
                    u32x4 w; w.x = pkbf(v0[0], v0[1]); w.y = pkbf(v0[2], v0[3]); w.z = pkbf(v1[0], v1[1]); w.w = pkbf(v1[2], v1[3]);
                    *(u32x4*)(rowp + bj * HALF) = w;
                    if (cache) { const int col = col0 + bj * HALF, hh = col >> 6, d = col & 63, b = row >> 8, tt = row & 255;
                        float* p = fo + ((size_t)((b * 16 + hh) * 256 + tt)) * 64 + d; *(f32x4*)p = v0; *(f32x4*)(p + 4) = v1; } } }
    }
};
template <int CTRL> __device__ __forceinline__ float dpp_mov(float old, float src) {
    return __builtin_bit_cast(float, __builtin_amdgcn_update_dpp(__builtin_bit_cast(int, old), __builtin_bit_cast(int, src), CTRL, 0xF, 0xF, false)); }
struct EpiFfn {
    static constexpr bool PERM = true, AFTER_DRAIN = false;
    bf16_t* act; const float* wconv; float* abnd; float* gbnd; PG8_LAS float* xch;
    __device__ __forceinline__ void operator()(const f32x4 (&acc)[2][2][4][2], const Unit& u, int wr, int wc, int fr, int fq) const {
        constexpr int FFW = 2816;
        const int cl = 32 * wc + 8 * fq, col8 = 128 * u.pn + cl;
        float w0[8], w1[8], w2[8];
        { const f32x4 a0 = *(const f32x4*)(wconv + col8), a1 = *(const f32x4*)(wconv + col8 + 4), b0 = *(const f32x4*)(wconv + FFW + col8), b1 = *(const f32x4*)(wconv + FFW + col8 + 4),
                      c0 = *(const f32x4*)(wconv + 2 * FFW + col8), c1 = *(const f32x4*)(wconv + 2 * FFW + col8 + 4);
#pragma unroll
          for (int i = 0; i < 4; ++i) { w0[i] = a0[i]; w0[4 + i] = a1[i]; w1[i] = b0[i]; w1[4 + i] = b1[i]; w2[i] = c0[i]; w2[4 + i] = c1[i]; } }
#pragma unroll
        for (int ai = 0; ai < 2; ++ai) { const int s = ai * 2 + wr;
            if (fr == 0) { *(PG8_LAS f32x4*)(xch + (s * 2 + 0) * 128 + cl) = acc[ai][0][0][0]; *(PG8_LAS f32x4*)(xch + (s * 2 + 0) * 128 + cl + 4) = acc[ai][0][0][1]; }
            if (fr == 15) { *(PG8_LAS f32x4*)(xch + (s * 2 + 1) * 128 + cl) = acc[ai][0][3][0]; *(PG8_LAS f32x4*)(xch + (s * 2 + 1) * 128 + cl + 4) = acc[ai][0][3][1]; } }
        asm volatile("s_waitcnt lgkmcnt(0)" ::: "memory"); __builtin_amdgcn_s_barrier(); asm volatile("" ::: "memory");
#pragma unroll
        for (int ai = 0; ai < 2; ++ai) { const int s = ai * 2 + wr;
            f32x4 up[2], dn[2];
#pragma unroll
            for (int n = 0; n < 2; ++n) { up[n] = s > 0 ? *(const PG8_LAS f32x4*)(xch + ((s - 1) * 2 + 1) * 128 + cl + 4 * n) : (f32x4){0.f, 0.f, 0.f, 0.f};
                                          dn[n] = s < 3 ? *(const PG8_LAS f32x4*)(xch + ((s + 1) * 2 + 0) * 128 + cl + 4 * n) : (f32x4){0.f, 0.f, 0.f, 0.f}; }
#pragma unroll
            for (int m = 0; m < 4; ++m) { const int row = u.pm * BM + ai * HALF + wr * 64 + m * 16 + fr; float o[8];
#pragma unroll
                for (int n = 0; n < 2; ++n)
#pragma unroll
                    for (int i = 0; i < 4; ++i) { const float cur = acc[ai][0][m][n][i];
                        const float pold = m > 0 ? dpp_mov<0x121>(0.f, acc[ai][0][m > 0 ? m - 1 : 0][n][i]) : up[n][i];
                        const float prev = dpp_mov<0x111>(pold, cur);
                        const float nold = m < 3 ? dpp_mov<0x12F>(0.f, acc[ai][0][m < 3 ? m + 1 : 3][n][i]) : dn[n][i];
                        const float next = dpp_mov<0x101>(nold, cur);
                        const float v = w0[4 * n + i] * prev + w1[4 * n + i] * cur + w2[4 * n + i] * next;
                        const float u2 = v * (-2.3022081981f + -0.1029432396f * v * v);
                        o[4 * n + i] = v * __builtin_amdgcn_rcpf(1.f + __builtin_amdgcn_exp2f(u2)) * acc[ai][1][m][n][i]; }
                const bool edge = (s == 0 && m == 0 && fr == 0) || (s == 3 && m == 3 && fr == 15);
                if (!edge) { u32x4 w; w.x = pkbf(o[0], o[1]); w.y = pkbf(o[2], o[3]); w.z = pkbf(o[4], o[5]); w.w = pkbf(o[6], o[7]); *(u32x4*)(act + (size_t)row * FFW + col8) = w; }
                if (s == 0 && m == 0 && fr < 2) { float* p = abnd + ((size_t)(u.pm * 4 + fr)) * FFW + col8; *(f32x4*)p = acc[ai][0][m][0]; *(f32x4*)(p + 4) = acc[ai][0][m][1];
                    if (fr == 0) { float* q = gbnd + ((size_t)(u.pm * 2 + 0)) * FFW + col8; *(f32x4*)q = acc[ai][1][m][0]; *(f32x4*)(q + 4) = acc[ai][1][m][1]; } }
                if (s == 3 && m == 3 && fr >= 14) { float* p = abnd + ((size_t)(u.pm * 4 + 2 + (fr - 14))) * FFW + col8; *(f32x4*)p = acc[ai][0][m][0]; *(f32x4*)(p + 4) = acc[ai][0][m][1];
                    if (fr == 15) { float* q = gbnd + ((size_t)(u.pm * 2 + 1)) * FFW + col8; *(f32x4*)q = acc[ai][1][m][0]; *(f32x4*)(q + 4) = acc[ai][1][m][1]; } }
            }
        }
    }
};
template <class Epi, class Sched, bool ALIGN_EPI = false, bool SP2 = false>
__device__ __forceinline__ void gemm_phase(PG8_LAS unsigned char* lds, const Gemm g, const Sched& S, const Epi& E) {
    const int tid = threadIdx.x, wid = __builtin_amdgcn_readfirstlane(tid >> 6), lane = tid & 63, wr = wid >> 2, wc = wid & 3, fr = lane & 15, fq = lane >> 4;
    const int K = g.K, nt = K / BK;
    unsigned voffA[2], voffB[2];
#pragma unroll
    for (int i = 0; i < 2; ++i) { int R, C; stage_rc(tid * 16 + i * 8192, R, C); const int Rb = Epi::PERM ? ((R & ~31) + perm32(R & 31)) : R;
        voffA[i] = (unsigned)(R * K + C) * 2u; voffB[i] = (unsigned)(Rb * K + C) * 2u; }
    const size_t kstep = (size_t)(BK * 2);
    const size_t hstep = (size_t)HALF * K * 2;
    const size_t tstep = 2 * hstep;
    const unsigned ldsw = (unsigned)wid * 1024u;
    const int aoff = lds_byte(wr * 64 + fr, fq * 8), boff = lds_byte(wc * 32 + fr, fq * 8);
#define PG8_SA(b, h) (((b) * 2 + (h)) * HTB)
#define PG8_SB(b, h) ((4 + (b) * 2 + (h)) * HTB)
#define PG8_STAGE(bufoff, gbase, voff) do { _Pragma("unroll") for (int _i = 0; _i < 2; ++_i) \
        __builtin_amdgcn_global_load_lds((const unsigned*)((const char*)(gbase) + (voff)[_i]), (PG8_LAS unsigned*)(lds + (bufoff) + ldsw + _i * 8192), 16, 0, 0); } while (0)
#define PG8_LDA(dst, b, h) do { _Pragma("unroll") for (int m = 0; m < 4; ++m) _Pragma("unroll") for (int k = 0; k < 2; ++k) dst[m][k] = *(const PG8_LAS bf16x8*)(lds + PG8_SA(b, h) + aoff + m * 2048 + k * 1024); } while (0)
#define PG8_LDB(dst, b, h) do { _Pragma("unroll") for (int n = 0; n < 2; ++n) _Pragma("unroll") for (int k = 0; k < 2; ++k) dst[n][k] = *(const PG8_LAS bf16x8*)(lds + PG8_SB(b, h) + boff + n * 2048 + k * 1024); } while (0)
#define PG8_MMA(ai, bj, At, Bt) do { __builtin_amdgcn_s_setprio(1); _Pragma("unroll") for (int m = 0; m < 4; ++m) _Pragma("unroll") for (int n = 0; n < 2; ++n) _Pragma("unroll") for (int k = 0; k < 2; ++k) \
        acc[ai][bj][m][n] = __builtin_amdgcn_mfma_f32_16x16x32_bf16(Bt[n][k], At[m][k], acc[ai][bj][m][n], 0, 0, 0); __builtin_amdgcn_s_setprio(0); } while (0)
#define PG8_WAIT_V(n) asm volatile("s_waitcnt vmcnt(" #n ")" ::: "memory")
#define PG8_WAIT_L(n) asm volatile("s_waitcnt lgkmcnt(" #n ")" ::: "memory")
#define PG8_BAR __builtin_amdgcn_s_barrier()
#define PG8_SCHED __builtin_amdgcn_sched_barrier(0)
    Unit cur, nxt; int ui = 0;
    if (!S.next(0, cur)) return;
    f32x4 acc[2][2][4][2];
#pragma unroll
    for (int a = 0; a < 2; ++a)
#pragma unroll
        for (int b = 0; b < 2; ++b)
#pragma unroll
            for (int m = 0; m < 4; ++m)
#pragma unroll
                for (int n = 0; n < 2; ++n) acc[a][b][m][n] = (f32x4){0.f, 0.f, 0.f, 0.f};
    bf16x8 At[4][2], B0[2][2], B1[2][2];
    const char* cA = (const char*)g.A + (size_t)cur.pm * tstep; const char* cB = (const char*)g.Bt + (size_t)cur.pn * tstep;
    S.a_ready(cur);
    if constexpr (SP2) {
        PG8_STAGE(PG8_SB(0, 0), cB, voffB); PG8_STAGE(PG8_SB(0, 1), cB + hstep, voffB); PG8_STAGE(PG8_SA(0, 0), cA, voffA); PG8_STAGE(PG8_SA(0, 1), cA + hstep, voffA);
        if (wr == 1) PG8_BAR;
        PG8_WAIT_V(2); PG8_BAR;
        PG8_STAGE(PG8_SB(1, 0), cB + kstep, voffB); PG8_STAGE(PG8_SA(1, 0), cA + kstep, voffA); PG8_STAGE(PG8_SB(1, 1), cB + hstep + kstep, voffB);
        PG8_WAIT_V(6); PG8_BAR;
    } else {
        PG8_STAGE(PG8_SB(0, 0), cB, voffB); PG8_STAGE(PG8_SA(0, 0), cA, voffA); PG8_STAGE(PG8_SB(0, 1), cB + hstep, voffB); PG8_STAGE(PG8_SA(0, 1), cA + hstep, voffA);
        if (wr == 1) PG8_BAR;
        PG8_WAIT_V(4); PG8_BAR;
        PG8_STAGE(PG8_SB(1, 0), cB + kstep, voffB); PG8_STAGE(PG8_SA(1, 0), cA + kstep, voffA); PG8_STAGE(PG8_SB(1, 1), cB + hstep + kstep, voffB);
        PG8_WAIT_V(6); PG8_BAR;
    }
    for (;;) {
        const bool has_next = S.next(ui + 1, nxt);
        const char* nA = has_next ? (const char*)g.A + (size_t)nxt.pm * tstep : cA; const char* nB = has_next ? (const char*)g.Bt + (size_t)nxt.pn * tstep : cB;
        for (int t = 0; t < nt; t += 2) {
            const bool last = (t == nt - 2);
            const char* a1 = cA + (size_t)(t + 1) * kstep;
            const char* a2 = last ? nA : cA + (size_t)(t + 2) * kstep; const char* b2 = last ? nB : cB + (size_t)(t + 2) * kstep;
            const char* a3 = a2 + kstep; const char* b3 = b2 + kstep;
            if (last && has_next) S.a_ready(nxt);
            if constexpr (SP2) {
            PG8_LDB(B0, 0, 0); PG8_LDB(B1, 0, 1); PG8_SCHED; PG8_LDA(At, 0, 0); PG8_STAGE(PG8_SA(1, 1), a1 + hstep, voffA);
            PG8_WAIT_V(8); PG8_WAIT_L(0); PG8_BAR; PG8_MMA(0, 0, At, B0); PG8_MMA(0, 1, At, B1); PG8_BAR; PG8_SCHED;
            PG8_LDA(At, 0, 1); PG8_STAGE(PG8_SB(0, 0), b2, voffB); PG8_STAGE(PG8_SB(0, 1), b2 + hstep, voffB); PG8_STAGE(PG8_SA(0, 0), a2, voffA);
            PG8_WAIT_V(8); PG8_WAIT_L(0); PG8_BAR; PG8_MMA(1, 0, At, B0); PG8_MMA(1, 1, At, B1); PG8_BAR; PG8_SCHED;
            PG8_LDB(B0, 1, 0); PG8_LDB(B1, 1, 1); PG8_SCHED; PG8_LDA(At, 1, 0); PG8_STAGE(PG8_SA(0, 1), a2 + hstep, voffA);
            PG8_WAIT_V(8); PG8_WAIT_L(0); PG8_BAR; PG8_MMA(0, 0, At, B0); PG8_MMA(0, 1, At, B1); PG8_BAR; PG8_SCHED;
            PG8_LDA(At, 1, 1); PG8_STAGE(PG8_SB(1, 0), b3, voffB); PG8_STAGE(PG8_SB(1, 1), b3 + hstep, voffB); PG8_STAGE(PG8_SA(1, 0), a3, voffA);
            PG8_WAIT_V(8); PG8_WAIT_L(0); PG8_BAR; PG8_MMA(1, 0, At, B0); PG8_MMA(1, 1, At, B1); PG8_BAR; PG8_SCHED;
            } else {
            PG8_LDB(B0, 0, 0); PG8_SCHED; PG8_LDA(At, 0, 0); PG8_STAGE(PG8_SA(1, 1), a1 + hstep, voffA);
            PG8_WAIT_L(8); PG8_BAR; PG8_WAIT_L(0); PG8_MMA(0, 0, At, B0); PG8_BAR; PG8_SCHED;
            PG8_LDB(B1, 0, 1); PG8_STAGE(PG8_SB(0, 0), b2, voffB);
            PG8_BAR; PG8_WAIT_L(0); PG8_MMA(0, 1, At, B1); PG8_BAR;
            PG8_LDA(At, 0, 1); PG8_STAGE(PG8_SA(0, 0), a2, voffA);
            PG8_BAR; PG8_WAIT_L(0); PG8_MMA(1, 0, At, B0); PG8_BAR; PG8_SCHED;
            PG8_STAGE(PG8_SB(0, 1), b2 + hstep, voffB);
            PG8_WAIT_V(6); PG8_BAR; PG8_MMA(1, 1, At, B1); PG8_BAR;
            PG8_LDB(B0, 1, 0); PG8_SCHED; PG8_LDA(At, 1, 0); PG8_STAGE(PG8_SA(0, 1), a2 + hstep, voffA);
            PG8_WAIT_L(8); PG8_BAR; PG8_WAIT_L(0); PG8_MMA(0, 0, At, B0); PG8_BAR; PG8_SCHED;
            PG8_LDB(B1, 1, 1); PG8_STAGE(PG8_SB(1, 0), b3, voffB);
            PG8_BAR; PG8_WAIT_L(0); PG8_MMA(0, 1, At, B1); PG8_BAR;
            PG8_LDA(At, 1, 1); PG8_STAGE(PG8_SA(1, 0), a3, voffA);
            PG8_BAR; PG8_WAIT_L(0); PG8_MMA(1, 0, At, B0); PG8_BAR; PG8_SCHED;
            PG8_STAGE(PG8_SB(1, 1), b3 + hstep, voffB);
            PG8_WAIT_V(6); PG8_BAR; PG8_MMA(1, 1, At, B1); PG8_BAR;
            }
        }
        if constexpr (ALIGN_EPI) { if (wr == 0) PG8_BAR; }
        if constexpr (!Epi::AFTER_DRAIN) { E(acc, cur, wr, wc, fr, fq); S.done(cur); }
        if (!has_next) break;
#pragma unroll
        for (int a = 0; a < 2; ++a)
#pragma unroll
            for (int b = 0; b < 2; ++b)
#pragma unroll
                for (int m = 0; m < 4; ++m)
#pragma unroll
                    for (int n = 0; n < 2; ++n) acc[a][b][m][n] = (f32x4){0.f, 0.f, 0.f, 0.f};
        cur = nxt; cA = nA; cB = nB; ++ui;
        if constexpr (ALIGN_EPI) { if (wr == 1) PG8_BAR; }
    }
    PG8_WAIT_V(0);
    if constexpr (!ALIGN_EPI) { if (wr == 0) PG8_BAR; }
    PG8_BAR;
    if constexpr (Epi::AFTER_DRAIN) { E.fused(acc, cur, wr, wc, fr, fq, lds, wid, lane); S.done(cur); }
#undef PG8_SA
#undef PG8_SB
#undef PG8_STAGE
#undef PG8_LDA
#undef PG8_LDB
#undef PG8_MMA
#undef PG8_WAIT_V
#undef PG8_WAIT_L
#undef PG8_BAR
#undef PG8_SCHED
}
}
#define GAS __attribute__((address_space(1)))
#define LAS __attribute__((address_space(3)))
#define DI __device__ __forceinline__
typedef unsigned short bf16;
typedef float f32x2 __attribute__((ext_vector_type(2)));
typedef float f32x4 __attribute__((ext_vector_type(4)));
typedef float f32x16 __attribute__((ext_vector_type(16)));
typedef short bf16x8 __attribute__((ext_vector_type(8)));
typedef unsigned u32x2 __attribute__((ext_vector_type(2)));
typedef unsigned u32x4 __attribute__((ext_vector_type(4)));
#define MFMA32(a, b, c) __builtin_amdgcn_mfma_f32_32x32x16_bf16((a), (b), (c), 0, 0, 0)

#ifndef MK_ONE_LAUNCH
#define MK_ONE_LAUNCH 1
#endif
namespace mk {
constexpr int NWAVES = 8, NTHR = 512;
constexpr int D = 1024, M = 12288, MPR = 4096;
constexpr int NPROJ = 3840, FF = 2816;
constexpr float EPS = 1e-6f;
constexpr int NPHASES = 20;
constexpr size_t OFF_C = 12582912, OFF_N = 14680064, OFF_MM = 14696448, OFF_K = 14696576, OFF_V = 18890880;
constexpr size_t MiB = 1u << 20;
constexpr size_t WS_CTL = 0, CTL_ZERO_BYTES = 1 * MiB;
constexpr size_t WS_MODP = 105 * MiB;
constexpr size_t WS_MODF = 5 * MiB;
constexpr size_t WS_GATES = 6 * MiB;
constexpr size_t WS_AS = 7 * MiB, WS_MS = 7 * MiB + 512 * 1024, WS_BS = 8 * MiB;
constexpr size_t WS_H2 = 10 * MiB;
constexpr size_t WS_NS = 9 * MiB;
constexpr size_t WS_R2048 = 12 * MiB;
constexpr size_t WS_R256 = 16 * MiB;
constexpr size_t WS_CK = 22 * MiB, WS_CV = 26 * MiB;
constexpr size_t WS_WAB = 30 * MiB, WS_WOAB = 38 * MiB, WS_WC = 40 * MiB, WS_WOC = 46 * MiB, WS_WUP = 48 * MiB, WS_WDN = 70 * MiB;
constexpr size_t WS_H = 81 * MiB;
constexpr size_t WS_BIG = 105 * MiB;
constexpr size_t WS_PROJ = WS_BIG;
constexpr size_t WS_QB = 195 * MiB, WS_KB = 207 * MiB;
constexpr size_t WS_UT = 219 * MiB;
constexpr size_t WS_X2T = 231 * MiB;
constexpr size_t WS_FG = 171 * MiB;
constexpr size_t WS_ABND = 140 * MiB, WS_GBND = 144 * MiB;
constexpr size_t WS_Q1 = WS_BIG, WS_K1 = 129 * MiB, WS_V1 = 153 * MiB;
constexpr size_t WS_DL = WS_BIG;
constexpr size_t WS_END = 256 * MiB;
constexpr int CW_BAR = 4096;
constexpr int RING_BYTES = 131072, LDSCTL_OFF = RING_BYTES, MISC_OFF = LDSCTL_OFF + 320, XCH_OFF = RING_BYTES + 1024, LDS_BYTES = 147456;

DI float bf2f(unsigned short b) { return __uint_as_float((unsigned)b << 16); }
DI unsigned pk2(float lo, float hi) { return pg8::pkbf(lo, hi); }
DI void unpack8(const u32x4 v, float (&f)[8]) {
    f[0] = __uint_as_float(v.x << 16); f[1] = __uint_as_float(v.x & 0xffff0000u); f[2] = __uint_as_float(v.y << 16); f[3] = __uint_as_float(v.y & 0xffff0000u);
    f[4] = __uint_as_float(v.z << 16); f[5] = __uint_as_float(v.z & 0xffff0000u); f[6] = __uint_as_float(v.w << 16); f[7] = __uint_as_float(v.w & 0xffff0000u); }
DI u32x4 pack8(const float (&f)[8]) { u32x4 w; w.x = pk2(f[0], f[1]); w.y = pk2(f[2], f[3]); w.z = pk2(f[4], f[5]); w.w = pk2(f[6], f[7]); return w; }
DI float rcp_f(float x) { return __builtin_amdgcn_rcpf(x); }
DI float exp2_f(float x) { return __builtin_amdgcn_exp2f(x); }
DI float silu_f(float x) { return x * rcp_f(1.f + exp2_f(-1.4426950408889634f * x)); }
DI float sigm_f(float x) { return rcp_f(1.f + exp2_f(-1.4426950408889634f * x)); }
DI float gelu_tanh_f(float x) { const float u2 = x * (-2.3022081986f + -0.1029432396f * x * x); return x * rcp_f(1.f + exp2_f(u2)); }
DI float logsig_f(float x) { return fminf(x, 0.f) - log1pf(__expf(-fabsf(x))); }
DI float wave_sum(float v) {
#pragma unroll
    for (int o = 1; o < 64; o <<= 1) v += __shfl_xor(v, o);
    return v; }
#define LDS_WAIT() asm volatile("s_waitcnt lgkmcnt(0)" ::: "memory")

#define XB_TMO      128
#define XB_XCNT(j)  (256  + 64 * (j))
#define XB_XSUB(j)  (1280 + 64 * (j))
#define XB_XGEN(j)  (2304 + 64 * (j))
#define XB_TOP      3328
#define XB_TOPGEN   3392
#define XCD_BAR_WORDS 3456
#define XB_SPIN_CAP (1u << 20)
DI unsigned xb_ld(unsigned* p)              { return __hip_atomic_load(p, __ATOMIC_RELAXED, __HIP_MEMORY_SCOPE_AGENT); }
DI unsigned xb_add(unsigned* p, unsigned v) { return __hip_atomic_fetch_add(p, v, __ATOMIC_RELAXED, __HIP_MEMORY_SCOPE_AGENT); }
DI unsigned xb_xcc_id() { return (unsigned)__builtin_amdgcn_s_getreg((3 << 11) | 20) & 0xFu; }
#define XB_SPIN(cond, bar) do { unsigned _sp = 0; while (cond) { __builtin_amdgcn_s_sleep(1); \
    if ((++_sp & 255u) == 0u) { if (xb_ld(&(bar)[XB_TMO])) break; if (_sp > XB_SPIN_CAP) { atomicAdd(&(bar)[XB_TMO], 1u); break; } } } } while (0)
struct XcdBarrier { unsigned* bar; unsigned x; volatile LAS unsigned* st; };
DI XcdBarrier xcd_barrier_post(unsigned* bar, volatile LAS unsigned* st) {
    XcdBarrier b; b.bar = bar; b.x = xb_xcc_id(); b.st = st;
    if (threadIdx.x == 0) (void)xb_add(&bar[XB_XCNT(b.x)], 1u);
    return b;
}
DI void xcd_barrier_complete(unsigned* bar, unsigned x, unsigned& nloc, unsigned& nx) {
    const unsigned G = gridDim.x * gridDim.y * gridDim.z;
    unsigned sum, cnt, mine, sp = 0u;
    for (;;) {
        sum = 0u; cnt = 0u; mine = 0u;
#pragma unroll
        for (unsigned j = 0; j < 16; ++j) { const unsigned c = xb_ld(&bar[XB_XCNT(j)]); sum += c; cnt += (c > 0u) ? 1u : 0u; mine = (j == x) ? c : mine; }
        if (sum == G) break;
        __builtin_amdgcn_s_sleep(1);
        if ((++sp & 255u) == 0u) { if (xb_ld(&bar[XB_TMO])) break; if (sp > XB_SPIN_CAP) { atomicAdd(&bar[XB_TMO], 1u); break; } }
    }
    nloc = mine > 0u ? mine : 1u; nx = cnt > 0u ? cnt : 1u;
}
DI void xcd_barrier(const XcdBarrier& b) {
    asm volatile("s_waitcnt vmcnt(0)" ::: "memory");
    __syncthreads();
    if (threadIdx.x == 0) {
        unsigned* bar = b.bar;
        __builtin_amdgcn_s_waitcnt(0);
        unsigned nloc = b.st[0], nx = b.st[1];
        if (nloc == 0u) { xcd_barrier_complete(bar, b.x, nloc, nx); b.st[0] = nloc; b.st[1] = nx; }
        const unsigned old = xb_add(&bar[XB_XSUB(b.x)], 1u);
        const unsigned gen = old / nloc;
        if (old + 1u == (gen + 1u) * nloc) {
            __builtin_amdgcn_fence(__ATOMIC_RELEASE, "agent");
            asm volatile("s_waitcnt vmcnt(0)" ::: "memory");
            const unsigned og = xb_add(&bar[XB_TOP], 1u);
            const unsigned tg = og / nx;
            if (og + 1u == (tg + 1u) * nx) xb_add(&bar[XB_TOPGEN], 1u);
            else XB_SPIN(xb_ld(&bar[XB_TOPGEN]) == tg, bar);
            __builtin_amdgcn_fence(__ATOMIC_ACQUIRE, "agent");
            xb_add(&bar[XB_XGEN(b.x)], 1u);
            asm volatile("s_waitcnt vmcnt(0)" ::: "memory");
        } else {
            XB_SPIN(xb_ld(&bar[XB_XGEN(b.x)]) == gen, bar);
            __builtin_amdgcn_fence(__ATOMIC_ACQUIRE, "agent");
            asm volatile("s_waitcnt vmcnt(0)" ::: "memory");
        }
    }
    __syncthreads();
}

struct Args { const float* in[33]; float* out; unsigned char* ws; int ph_lo, ph_hi; };
enum { I_XP = 0, I_XS, I_STC, I_STN, I_STM, I_CK, I_CV, I_C, I_CCTX, I_WADA, I_BADA, I_GMIX, I_GFFN, I_GFIN, I_WINAB, I_BGATES, I_WCQK, I_GMLSTM, I_WCHY,
       I_WF1, I_BF1, I_WF2, I_BF2, I_WF3, I_FREQ, I_HYB, I_WOUTAB, I_WINC, I_RPB, I_WOUTC, I_WUP, I_WCFFN, I_WDOWN };

DI void row_seq(int row, int& base, int& L) { if (row < MPR) { base = row & ~255; L = 256; } else { base = MPR + ((row - MPR) & ~2047); L = 2048; } }
DI int row_vec(int row) { return row < MPR ? 4 : ((row - MPR) >> 11); }
template <bool FFN_PERM = false> DI void p0_transpose_tile(const float* W, int K, int N, int Npad, bf16* WT, LAS float* T, int item, int tid) {
    const int nblk = Npad / 256, kb = item / nblk, nb = item % nblk, k0 = 64 * kb, n0 = 256 * nb;
    __syncthreads();
    { const int col = n0 + (tid & 63) * 4; const bool ok = col < N; const float* src = W + (size_t)k0 * N + col;
      f32x4 v[8];
#pragma unroll
      for (int i = 0; i < 8; ++i) { const int kk = i * 8 + (tid >> 6); v[i] = ok ? *(const f32x4*)(src + (size_t)kk * N) : (f32x4){0.f, 0.f, 0.f, 0.f}; }
#pragma unroll
      for (int i = 0; i < 8; ++i) { const int kk = i * 8 + (tid >> 6); *(LAS f32x4*)(T + kk * 260 + (tid & 63) * 4) = v[i]; } }
    __syncthreads();
#pragma unroll
    for (int j = 0; j < 4; ++j) { const int n = tid & 255, kg = (tid >> 8) + 2 * j; const LAS float* p = T + (8 * kg) * 260 + n;
        u32x4 o; o.x = pk2(p[0], p[260]); o.y = pk2(p[520], p[780]); o.z = pk2(p[1040], p[1300]); o.w = pk2(p[1560], p[1820]);
        int dr = n0 + n;
        if (FFN_PERM) { const int gsel = dr >= 2816, c = gsel ? dr - 2816 : dr; dr = (c >> 7) * 256 + gsel * 128 + (c & 127); }
        *(u32x4*)(WT + (size_t)dr * K + k0 + 8 * kg) = o; }
}
DI void p0_filter_stage1(const Args& a, int L, int p0, int gcol0, float* H2, LAS float* T, int tid, int lane, int wave) {
    const float* b1 = a.in[I_BF1]; const float* b2 = a.in[I_BF2]; const float* fr = a.in[I_FREQ];
    LAS float* w1s = T; LAS float* w2s = T + 2112; LAS float* hs = T + 2112 + 4096;
    __syncthreads();
    for (int i = tid; i < 2112; i += NTHR) w1s[i] = a.in[I_WF1][i];
    for (int i = tid; i < 4096; i += NTHR) w2s[i] = a.in[I_WF2][i];
    __syncthreads();
    const int p = p0 + lane; const float tpos = (float)p / (float)(L - 1), wrev = (float)p / (float)L;
    float z[33]; z[0] = tpos;
#pragma unroll
    for (int k = 0; k < 16; ++k) { const float band = 1e-4f + (float)k * ((15.0f - 1e-4f) / 15.0f); const float rv = band * wrev; const float ph = 6.283185307179586f * (rv - floorf(rv));
        z[1 + k] = __cosf(ph); z[17 + k] = -__sinf(ph); }
#pragma unroll
    for (int jj = 0; jj < 8; ++jj) { const int j = 8 * wave + jj; float t = b1[j];
#pragma unroll
        for (int i = 0; i < 33; ++i) t += z[i] * w1s[i * 64 + j];
        hs[j * 64 + lane] = sinf(fr[j] * t); }
    __syncthreads();
    float acc[8];
#pragma unroll
    for (int jj = 0; jj < 8; ++jj) acc[jj] = b2[8 * wave + jj];
#pragma unroll 8
    for (int i = 0; i < 64; ++i) { const float hv = hs[i * 64 + lane]; const LAS float* wr = w2s + i * 64 + 8 * wave;
#pragma unroll
        for (int jj = 0; jj < 8; ++jj) acc[jj] += hv * wr[jj]; }
#pragma unroll
    for (int jj = 0; jj < 8; ++jj) { const int j = 8 * wave + jj; H2[(size_t)j * 2304 + gcol0 + lane] = sinf(fr[j] * acc[jj]); }
}
DI void p1_filter_stage2(const Args& a, int L, int p0, int gcol0, int cb, const float* H2, bf16* R, LAS float* w3t, int lane) {
    const float* w3 = a.in[I_WF3];
    const int p = p0 + lane; const float tpos = (float)p / (float)(L - 1);
    float h2[64];
#pragma unroll
    for (int i = 0; i < 64; ++i) h2[i] = H2[(size_t)i * 2304 + gcol0 + lane];
#pragma unroll
    for (int r = 0; r < 16; ++r) { const int i = (lane >> 4) + 4 * r; w3t[(lane & 15) * 64 + i] = w3[i * 1024 + cb * 16 + (lane & 15)]; }
    LDS_WAIT(); asm volatile("" ::: "memory");
    const float mind = -3.0701134573f, maxd = -15.3505672866f;
#pragma unroll 2
    for (int cc = 0; cc < 16; ++cc) { const int c = cb * 16 + cc, c5 = c & 511; float t0 = 0.f, t1 = 0.f, t2 = 0.f, t3 = 0.f;
#pragma unroll
        for (int q = 0; q < 16; ++q) { const f32x4 w = *(const LAS f32x4*)(w3t + cc * 64 + 4 * q); t0 += h2[4 * q] * w[0]; t1 += h2[4 * q + 1] * w[1]; t2 += h2[4 * q + 2] * w[2]; t3 += h2[4 * q + 3] * w[3]; }
        const float delta = fabsf(mind + (float)c5 * ((maxd - mind) / 511.0f)); const float v = ((t0 + t1) + (t2 + t3)) * __expf(-tpos * delta);
        const bf16 vb = (bf16)(pk2(v, 0.f) & 0xffffu);
        if (c < 512) { R[(size_t)c * (2 * L) + (L - p)] = vb; if (p == 0) R[(size_t)c * (2 * L)] = 0; }
        else if (p >= 1) R[(size_t)c5 * (2 * L) + (L + p)] = vb; }
    LDS_WAIT(); asm volatile("" ::: "memory");
}
DI void bg_convert(const Args& a, LAS unsigned char* lds, int set, int widx, int nw, int tid) {
    unsigned char* ws = a.ws; LAS float* T = (LAS float*)lds;
    constexpr int I2 = 16 * 12, I3 = 16 * 4, I4 = 16 * 22, I5 = 44 * 4;
    if (set == 0) { for (int r = widx; r < I4; r += nw) p0_transpose_tile<true>(a.in[I_WUP], 1024, 5632, 5632, (bf16*)(ws + WS_WUP), T, r, tid); }
    else if (set == 1) { for (int r = widx; r < I5; r += nw) p0_transpose_tile(a.in[I_WDOWN], 2816, 1024, 1024, (bf16*)(ws + WS_WDN), T, r, tid); }
    else if (set == 2) { for (int r = widx; r < I2 + I3; r += nw) {
            if (r < I2) p0_transpose_tile(a.in[I_WINC], 1024, 3072, 3072, (bf16*)(ws + WS_WC), T, r, tid);
            else p0_transpose_tile(a.in[I_WOUTC], 1024, 1024, 1024, (bf16*)(ws + WS_WOC), T, r - I2, tid); } }
    else { for (int r = widx; r < I4 + I5; r += nw) {
            if (r < I4) p0_transpose_tile<true>(a.in[I_WUP] + (size_t)1024 * 5632, 1024, 5632, 5632, (bf16*)(ws + WS_WUP) + (size_t)5632 * 1024, T, r, tid);
            else p0_transpose_tile(a.in[I_WDOWN] + (size_t)2816 * 1024, 2816, 1024, 1024, (bf16*)(ws + WS_WDN) + (size_t)1024 * 2816, T, r - I4, tid); } }
    __syncthreads();
}
DI void ph_prologue(const Args& a, LAS unsigned char* lds, int tid, int lane, int wave, int bid, int G) {
    unsigned char* ws = a.ws;
    constexpr int NF1 = 36, NA = 192, I0 = 16 * 15, I1 = 16 * 4, NT = I0 + I1;
    LAS float* T = (LAS float*)lds;
#ifndef MK_P0A
#define MK_P0A 1
#define MK_P0T 1
#define MK_P0F 1
#endif
    for (int rep_ = 0; rep_ < (MK_P0A > MK_P0T ? (MK_P0A > MK_P0F ? MK_P0A : MK_P0F) : (MK_P0T > MK_P0F ? MK_P0T : MK_P0F)); ++rep_)
    for (int it0 = bid; it0 < NF1 + NA + NT; it0 += G) {
        if (it0 < NF1) { if (rep_ < MK_P0F) p0_filter_stage1(a, it0 < 32 ? 2048 : 256, it0 < 32 ? 64 * it0 : 64 * (it0 - 32), 64 * it0, (float*)(ws + WS_H2), T, tid, lane, wave); continue; }
        const int it = it0 - NF1;
        if (it < NA ? rep_ >= MK_P0A : rep_ >= MK_P0T) continue;
        if (it < NA) {
            const int l = it / 96, rem = it % 96, cb = rem >> 5, ks = rem & 31;
            __syncthreads();
            if (tid < 160) { const int v = tid >> 5, k = tid & 31; const float cv = v < 4 ? a.in[I_C][v * 1024 + ks * 32 + k] : a.in[I_CCTX][ks * 32 + k]; T[tid] = silu_f(cv); }
            __syncthreads();
            const int col = cb * 2048 + tid * 4; const float* w = a.in[I_WADA] + ((size_t)(l * 1024 + ks * 32)) * 6144 + col;
            f32x4 a0 = {0.f, 0.f, 0.f, 0.f}, a1 = a0, a2 = a0, a3 = a0, a4 = a0;
#pragma unroll
            for (int kb = 0; kb < 2; ++kb) { f32x4 wv[16];
#pragma unroll
                for (int k = 0; k < 16; ++k) wv[k] = *(const f32x4*)(w + (size_t)(16 * kb + k) * 6144);
#pragma unroll
                for (int k = 0; k < 16; ++k) { const int kk = 16 * kb + k; a0 += wv[k] * T[kk]; a1 += wv[k] * T[32 + kk]; a2 += wv[k] * T[64 + kk]; a3 += wv[k] * T[96 + kk]; a4 += wv[k] * T[128 + kk]; } }
            float* o = (float*)(ws + WS_MODP) + ((size_t)((ks * 2 + l) * 5)) * 6144 + col;
            *(f32x4*)o = a0; *(f32x4*)(o + 6144) = a1; *(f32x4*)(o + 2 * 6144) = a2; *(f32x4*)(o + 3 * 6144) = a3; *(f32x4*)(o + 4 * 6144) = a4;
            continue;
        }
        int r = it - NA;
        if (r < I0) { p0_transpose_tile(a.in[I_WINAB], 1024, 3600, 3840, (bf16*)(ws + WS_WAB), T, r, tid); continue; } r -= I0;
        p0_transpose_tile(a.in[I_WOUTAB], 1024, 1024, 1024, (bf16*)(ws + WS_WOAB), T, r, tid);
    }
    __syncthreads();
    { const int gt = bid * NTHR + tid, NGT = G * NTHR;
      for (int i = gt; i < 2 * 262144; i += NGT) { const int which = i >= 262144, j = which ? i - 262144 : i;
        const float* src = a.in[which ? I_CV : I_CK] + (size_t)j * 8; bf16* dst = (bf16*)(ws + (which ? WS_CV : WS_CK)) + (size_t)j * 8;
        const f32x4 x0 = *(const f32x4*)src, x1 = *(const f32x4*)(src + 4);
        u32x4 o; o.x = pk2(x0[0], x0[1]); o.y = pk2(x0[2], x0[3]); o.z = pk2(x1[0], x1[1]); o.w = pk2(x1[2], x1[3]); *(u32x4*)dst = o; } }
}
DI void ph_modf_norm0(const Args& a, LAS unsigned char* lds, int tid, int lane, int wave, int bid, int G) {
    const float* modP = (const float*)(a.ws + WS_MODP); float* modF = (float*)(a.ws + WS_MODF); const float* bada = a.in[I_BADA];
    for (int i = bid * NTHR + tid; i < 2 * 5 * 6144; i += G * NTHR) { const int l = i / 30720, rem = i % 30720, v = rem / 6144, col = rem % 6144;
        float s = bada[l * 6144 + col];
#pragma unroll 8
        for (int ks = 0; ks < 32; ++ks) s += modP[((size_t)((ks * 2 + l) * 5 + v)) * 6144 + col];
        modF[i] = s; }
    const int rpw = (M + G - 1) / G, r0 = rpw * bid, r1 = (r0 + rpw < M) ? r0 + rpw : M;
    LAS float* shs = (LAS float*)lds;
    for (int v = 0; v < 5; ++v) {
        const bool need = r0 < r1 && (v == 4 ? (r0 < MPR) : (r1 > MPR && ((r0 > MPR ? r0 : MPR) - MPR) >> 11 <= v && v <= ((r1 - 1 - MPR) >> 11)));
        if (!need) continue;
        { const int i = tid; const int ch = i >> 8, c4 = (i & 255) * 4;
            f32x4 s = *(const f32x4*)(bada + ch * 1024 + c4);
#pragma unroll 8
            for (int ks = 0; ks < 32; ++ks) s += *(const f32x4*)(modP + ((size_t)((ks * 2 + 0) * 5 + v)) * 6144 + ch * 1024 + c4);
            *(LAS f32x4*)(shs + (v * 2 + ch) * 1024 + c4) = s; }
    }
    const int NGW = G * NWAVES;
    for (int it = wave * G + bid; it < 2304; it += NGW) { const int pg = it >> 6, cb = it & 63;
        p1_filter_stage2(a, pg < 32 ? 2048 : 256, pg < 32 ? 64 * pg : 64 * (pg - 32), 64 * pg, cb, (const float*)(a.ws + WS_H2), (bf16*)(a.ws + (pg < 32 ? WS_R2048 : WS_R256)), (LAS float*)(lds + 65536 + wave * 4096), lane); }
    __syncthreads();
    { const float* xsB = a.in[I_XS] - (size_t)MPR * D; const float* gvec = a.in[I_GMIX]; bf16* hbuf = (bf16*)(a.ws + WS_H);
        for (int row = r0 + wave; row < r1; row += NWAVES) {
            const float* xr = (row < MPR ? a.in[I_XP] : xsB) + (size_t)row * D; const int slot = row_vec(row);
            f32x4 x[4]; float ss = 0.f;
#pragma unroll
            for (int j = 0; j < 4; ++j) { x[j] = *(const f32x4*)(xr + 4 * lane + 256 * j); ss += (x[j][0] * x[j][0] + x[j][1] * x[j][1]) + (x[j][2] * x[j][2] + x[j][3] * x[j][3]); }
            const float rstd = rsqrtf(wave_sum(ss) * (1.f / D) + EPS);
#pragma unroll
            for (int j = 0; j < 4; ++j) { const int col = 4 * lane + 256 * j; const f32x4 g = *(const f32x4*)(gvec + col), sh = *(const LAS f32x4*)(shs + (slot * 2 + 0) * 1024 + col), sc = *(const LAS f32x4*)(shs + (slot * 2 + 1) * 1024 + col);
                const f32x4 y = x[j] * rstd * g * (sc + 1.f) + sh; u32x2 o; o.x = pk2(y[0], y[1]); o.y = pk2(y[2], y[3]); *(u32x2*)(hbuf + (size_t)row * D + col) = o; }
        }
    }
}
DI void ph_norm(const float* xA, const float* xB, const bf16* delta, float* xout, const float* gvec, const float* mod5  , int chS, int chC, bf16* hbuf, int gw, int NGW, int lane) {
    for (int row0 = gw; row0 < M; row0 += 2 * NGW) {
        f32x4 x[2][4]; u32x2 dq[2][4];
#pragma unroll
        for (int r = 0; r < 2; ++r) { const int row = row0 + r * NGW; if (row < M) { const float* xr = (row < MPR ? xA : xB) + (size_t)row * D;
#pragma unroll
            for (int j = 0; j < 4; ++j) { x[r][j] = *(const f32x4*)(xr + 4 * lane + 256 * j); if (delta) dq[r][j] = *(const u32x2*)(delta + (size_t)row * D + 4 * lane + 256 * j); } } }
#pragma unroll
        for (int r = 0; r < 2; ++r) { const int row = row0 + r * NGW; if (row < M) { const int v = row_vec(row);
            const float* shp = mod5 + (size_t)v * 6144 + chS * 1024; const float* scp = mod5 + (size_t)v * 6144 + chC * 1024; float ss = 0.f;
            if (delta) {
#pragma unroll
                for (int j = 0; j < 4; ++j) { x[r][j][0] += __uint_as_float(dq[r][j].x << 16); x[r][j][1] += __uint_as_float(dq[r][j].x & 0xffff0000u); x[r][j][2] += __uint_as_float(dq[r][j].y << 16); x[r][j][3] += __uint_as_float(dq[r][j].y & 0xffff0000u);
                    *(f32x4*)(xout + (size_t)row * D + 4 * lane + 256 * j) = x[r][j]; } }
#pragma unroll
            for (int j = 0; j < 4; ++j) ss += (x[r][j][0] * x[r][j][0] + x[r][j][1] * x[r][j][1]) + (x[r][j][2] * x[r][j][2] + x[r][j][3] * x[r][j][3]);
            const float rstd = rsqrtf(wave_sum(ss) * (1.f / D) + EPS);
#pragma unroll
            for (int j = 0; j < 4; ++j) { const int col = 4 * lane + 256 * j; const f32x4 g = *(const f32x4*)(gvec + col), sh = *(const f32x4*)(shp + col), sc = *(const f32x4*)(scp + col);
                const f32x4 y = x[r][j] * rstd * g * (sc + 1.f) + sh; u32x2 o; o.x = pk2(y[0], y[1]); o.y = pk2(y[2], y[3]); *(u32x2*)(hbuf + (size_t)row * D + col) = o; } } }
    }
}
DI void ph_final_norm(float* out, const bf16* delta, const float* gvec, int gw, int NGW, int lane) {
    for (int row0 = gw; row0 < M; row0 += 2 * NGW) {
        f32x4 x[2][4]; u32x2 dq[2][4];
#pragma unroll
        for (int r = 0; r < 2; ++r) { const int row = row0 + r * NGW; if (row < M) {
#pragma unroll
            for (int j = 0; j < 4; ++j) { x[r][j] = *(const f32x4*)(out + (size_t)row * D + 4 * lane + 256 * j); dq[r][j] = *(const u32x2*)(delta + (size_t)row * D + 4 * lane + 256 * j); } } }
#pragma unroll
        for (int r = 0; r < 2; ++r) { const int row = row0 + r * NGW; if (row < M) { float ss = 0.f;
#pragma unroll
            for (int j = 0; j < 4; ++j) { x[r][j][0] += __uint_as_float(dq[r][j].x << 16); x[r][j][1] += __uint_as_float(dq[r][j].x & 0xffff0000u); x[r][j][2] += __uint_as_float(dq[r][j].y << 16); x[r][j][3] += __uint_as_float(dq[r][j].y & 0xffff0000u);
                ss += (x[r][j][0] * x[r][j][0] + x[r][j][1] * x[r][j][1]) + (x[r][j][2] * x[r][j][2] + x[r][j][3] * x[r][j][3]); }
            const float rstd = rsqrtf(wave_sum(ss) * (1.f / D) + EPS);
#pragma unroll
            for (int j = 0; j < 4; ++j) { const int col = 4 * lane + 256 * j; const f32x4 g = *(const f32x4*)(gvec + col); *(f32x4*)(out + (size_t)row * D + col) = x[r][j] * rstd * g; } } }
    }
}
DI void conv3_8(const bf16* p0, const bf16* p1, const bf16* p2, bool hp, bool hn, const float* w, int wstride, float (&o)[8]) {
    float c[8], pv[8], nx[8];
    unpack8(*(const u32x4*)p1, c);
    if (hp) unpack8(*(const u32x4*)p0, pv); else {
#pragma unroll
        for (int j = 0; j < 8; ++j) pv[j] = 0.f; }
    if (hn) unpack8(*(const u32x4*)p2, nx); else {
#pragma unroll
        for (int j = 0; j < 8; ++j) nx[j] = 0.f; }
#pragma unroll
    for (int j = 0; j < 8; ++j) o[j] = w[j] * pv[j] + w[wstride + j] * c[j] + w[2 * wstride + j] * nx[j];
}
DI void ph_e1(const Args& a, LAS unsigned char* lds, int tid, int gw, int NGW, int lane, int wave, int bid, int G) {
    unsigned char* ws = a.ws;
    const bf16* proj = (const bf16*)(ws + WS_PROJ); bf16* QB = (bf16*)(ws + WS_QB); bf16* KB = (bf16*)(ws + WS_KB); bf16* UT = (bf16*)(ws + WS_UT); bf16* X2T = (bf16*)(ws + WS_X2T);
    const float* wqk = a.in[I_WCQK]; const float* why = a.in[I_WCHY];
    LAS bf16* Ust = (LAS bf16*)lds; LAS bf16* Xst = (LAS bf16*)(lds + 65536);
    for (int it = bid; it < M / 64; it += G) {
        __syncthreads();
        int sbase, L; row_seq(it * 64, sbase, L);
#pragma unroll 1
        for (int half = 0; half < 2; ++half) {
            const int r0 = it * 64 + 8 * wave + 4 * half;
#define E1_LOAD(rawv, coff_) _Pragma("unroll") for (int j = 0; j < 6; ++j) { const int row = r0 - 1 + j; const bool ok = row >= sbase && row < sbase + L; \
                rawv[j] = ok ? *(const u32x4*)(proj + (size_t)row * NPROJ + (coff_)) : (u32x4){0u, 0u, 0u, 0u}; }
#define E1_CONV(rawv, wp_, wst_, outv) do { float w0_[8], w1_[8], w2_[8]; \
                { const f32x4 a_ = *(const f32x4*)(wp_), b_ = *(const f32x4*)((wp_) + 4), c_ = *(const f32x4*)((wp_) + (wst_)), d_ = *(const f32x4*)((wp_) + (wst_) + 4), e_ = *(const f32x4*)((wp_) + 2 * (wst_)), f_ = *(const f32x4*)((wp_) + 2 * (wst_) + 4); \
                  _Pragma("unroll") for (int j = 0; j < 4; ++j) { w0_[j] = a_[j]; w0_[4 + j] = b_[j]; w1_[j] = c_[j]; w1_[4 + j] = d_[j]; w2_[j] = e_[j]; w2_[4 + j] = f_[j]; } } \
                _Pragma("unroll") for (int o = 0; o < 4; ++o) { float p0[8], p1[8], p2[8]; unpack8(rawv[o], p0); unpack8(rawv[o + 1], p1); unpack8(rawv[o + 2], p2); \
                  _Pragma("unroll") for (int j = 0; j < 8; ++j) outv[o][j] = w0_[j] * p0[j] + w1_[j] * p1[j] + w2_[j] * p2[j]; } } while (0)
            { u32x4 rq[6], rk[6]; E1_LOAD(rq, 8 * lane); E1_LOAD(rk, 512 + 8 * lane);
              float oq[4][8], ok_[4][8]; E1_CONV(rq, wqk + 8 * lane, 1024, oq); E1_CONV(rk, wqk + 512 + 8 * lane, 1024, ok_);
#pragma unroll
              for (int o = 0; o < 4; ++o) {
#pragma unroll
                  for (int j = 0; j < 8; ++j) { oq[o][j] = silu_f(oq[o][j]); ok_[o][j] = silu_f(ok_[o][j]) * 0.08838834764831845f; }
                  *(u32x4*)(QB + (size_t)(r0 + o) * 512 + 8 * lane) = pack8(oq[o]); *(u32x4*)(KB + (size_t)(r0 + o) * 512 + 8 * lane) = pack8(ok_[o]); } }
            { u32x4 rv[6], r1[6], r2[6]; E1_LOAD(rv, 2064 + 8 * lane); E1_LOAD(r1, 2576 + 8 * lane); E1_LOAD(r2, 3088 + 8 * lane);
              float ov[4][8], o1[4][8], o2[4][8]; E1_CONV(rv, why + 8 * lane, 1536, ov); E1_CONV(r1, why + 512 + 8 * lane, 1536, o1); E1_CONV(r2, why + 1024 + 8 * lane, 1536, o2);
#pragma unroll
              for (int o = 0; o < 4; ++o) { const int rl = 8 * wave + 4 * half + o;
#pragma unroll
                  for (int j = 0; j < 8; ++j) ov[o][j] *= o1[o][j];
                  *(LAS u32x4*)(Ust + rl * 512 + 8 * lane) = pack8(ov[o]); *(LAS u32x4*)(Xst + rl * 512 + 8 * lane) = pack8(o2[o]); } }
#undef E1_LOAD
#undef E1_CONV
        }
        __syncthreads();
        for (int idx = tid; idx < 8192; idx += NTHR) { const int c = idx & 511, g = (idx >> 9) & 7, ten = idx >> 12;
            const LAS bf16* src = (ten ? Xst : Ust) + (8 * g) * 512 + c;
            u32x4 o; o.x = (unsigned)src[0] | ((unsigned)src[512] << 16); o.y = (unsigned)src[1024] | ((unsigned)src[1536] << 16);
            o.z = (unsigned)src[2048] | ((unsigned)src[2560] << 16); o.w = (unsigned)src[3072] | ((unsigned)src[3584] << 16);
            *(u32x4*)((ten ? X2T : UT) + (size_t)c * M + it * 64 + 8 * g) = o; }
    }
    const float* gates = (const float*)(ws + WS_GATES); const float* bg = a.in[I_BGATES];
    float* aS = (float*)(ws + WS_AS); float* MSv = (float*)(ws + WS_MS); float* bS = (float*)(ws + WS_BS);
    if (G > M / 64) { if (bid >= M / 64) bg_convert(a, lds, 0, bid - M / 64, G - M / 64, tid); } else bg_convert(a, lds, 0, bid, G, tid);
    const int sw0 = (G > M / 64) ? (bid - M / 64) * NWAVES + wave : gw, sws = (G > M / 64) ? (G - M / 64) * NWAVES : NGW;
    for (int it = sw0; it < 160 && it >= 0; it += sws) {
        const int seq = it >> 3, h = (it >> 1) & 3, dir = it & 1;
        const int L = seq < 16 ? 256 : 2048, base = seq < 16 ? seq * 256 : MPR + (seq - 16) * 2048, per = L / 64;
        const float m0 = seq < 16 ? 0.f : a.in[I_STM][((seq - 16) * 2 + dir) * 4 + h];
        const int gi = dir * 8 + h, gf = dir * 8 + 4 + h; const float bi = bg[gi], bf_ = bg[gf];
        float lf[32], iv[32];
#pragma unroll
        for (int k = 0; k < 32; ++k) if (k < per) { const int p = 64 * k + lane, t = dir ? L - 1 - p : p; const size_t gr = (size_t)(base + t) * 16; lf[k] = gates[gr + gf]; iv[k] = gates[gr + gi]; }
        float cb_ = 0.f, cM = m0;
#pragma unroll
        for (int k = 0; k < 32; ++k) if (k < per) {
            float x = logsig_f(lf[k] + bf_);
#pragma unroll
            for (int o = 1; o < 64; o <<= 1) { const float n = __shfl_up(x, o); if (lane >= o) x += n; }
            const float b = cb_ + x, av = (iv[k] + bi) - b;
            float y = av;
#pragma unroll
            for (int o = 1; o < 64; o <<= 1) { const float n = __shfl_up(y, o); if (lane >= o) y = fmaxf(y, n); }
            const float Mv = fmaxf(cM, y);
            const int p = 64 * k + lane, t = dir ? L - 1 - p : p; const size_t o_ = (size_t)(base + t) * 8 + dir * 4 + h;
            aS[o_] = av; MSv[o_] = Mv; bS[o_] = b;
            cb_ = __shfl(b, 63); cM = __shfl(Mv, 63); }
    }
}
DI void ph_ffn_fix(const Args& a, int layer, int tid, int bid, int G) {
    const float* abnd = (const float*)(a.ws + WS_ABND); const float* gbnd = (const float*)(a.ws + WS_GBND); bf16* act = (bf16*)(a.ws + WS_FG); const float* w = a.in[I_WCFFN] + (size_t)layer * 3 * FF;
    for (int i = bid * NTHR + tid; i < 96 * FF; i += G * NTHR) { const int c = i % FF, rr = i / FF, pm = rr >> 1, which = rr & 1, row = pm * 256 + (which ? 255 : 0);
        int sbase, L; row_seq(row, sbase, L);
        float prev, cur, next;
        if (which == 0) { cur = abnd[(size_t)(pm * 4 + 0) * FF + c]; next = abnd[(size_t)(pm * 4 + 1) * FF + c]; prev = row > sbase ? abnd[(size_t)((pm - 1) * 4 + 3) * FF + c] : 0.f; }
        else { cur = abnd[(size_t)(pm * 4 + 3) * FF + c]; prev = abnd[(size_t)(pm * 4 + 2) * FF + c]; next = row < sbase + L - 1 ? abnd[(size_t)((pm + 1) * 4 + 0) * FF + c] : 0.f; }
        const float v = w[c] * prev + w[FF + c] * cur + w[2 * FF + c] * next;
        act[(size_t)row * FF + c] = (bf16)(pk2(gelu_tanh_f(v) * gbnd[(size_t)(pm * 2 + which) * FF + c], 0.f) & 0xffffu); }
}
template <int DK> DI void stage_k_rows(LAS bf16* Kst, const bf16* src, size_t ld, int tid) {
    constexpr int CPR = DK / 8;
#pragma unroll
    for (int c = tid; c < 64 * CPR; c += NTHR) { const int key = c / CPR, ch = c % CPR;
        const u32x4 v = *(const u32x4*)(src + (size_t)key * ld + ch * 8); *(LAS u32x4*)(Kst + key * (DK + 8) + ch * 8) = v; }
}
template <int DV> DI void stage_v_transposed(LAS bf16* Vst, const bf16* src, size_t ld, int tid) {
    constexpr int NCH = DV / 8;
#pragma unroll
    for (int c = tid; c < 64 * NCH; c += NTHR) { const int key = c & 63, ch = c >> 6;
        const u32x4 v = *(const u32x4*)(src + (size_t)key * ld + ch * 8); LAS bf16* d = Vst + (ch * 8) * 72 + key;
        d[0] = (bf16)(v.x & 0xffffu); d[72] = (bf16)(v.x >> 16); d[144] = (bf16)(v.y & 0xffffu); d[216] = (bf16)(v.y >> 16);
        d[288] = (bf16)(v.z & 0xffffu); d[360] = (bf16)(v.z >> 16); d[432] = (bf16)(v.w & 0xffffu); d[504] = (bf16)(v.w >> 16); }
}
DI bf16x8 pack_frag(const f32x16& x, int s) {
    u32x4 p; p.x = pk2(x[8 * s], x[8 * s + 1]); p.y = pk2(x[8 * s + 2], x[8 * s + 3]); p.z = pk2(x[8 * s + 4], x[8 * s + 5]); p.w = pk2(x[8 * s + 6], x[8 * s + 7]);
    return __builtin_bit_cast(bf16x8, p); }
DI bf16x8 ld_vfrag(const LAS bf16* Vst, int e, int s) {
    const u32x2 lo = *(const LAS u32x2*)(Vst + e * 72 + s), hi = *(const LAS u32x2*)(Vst + e * 72 + s + 8);
    u32x4 r; r.x = lo.x; r.y = lo.y; r.z = hi.x; r.w = hi.y; return __builtin_bit_cast(bf16x8, r); }

DI void mlstm_unit(const Args& a, LAS unsigned char* lds, int seq, int h, int qt, int tid, int lane, int wave) {
    unsigned char* ws = a.ws;
    const bf16* QB = (const bf16*)(ws + WS_QB); const bf16* KB = (const bf16*)(ws + WS_KB); const bf16* proj = (const bf16*)(ws + WS_PROJ);
    const float* aS = (const float*)(ws + WS_AS); const float* MSv = (const float*)(ws + WS_MS); const float* bS = (const float*)(ws + WS_BS);
    float* hscr = a.out + OFF_K;
    bf16* ycat = (bf16*)(ws + WS_H);
    const bool isS = seq >= 16; const int L = isS ? 2048 : 256, base = isS ? MPR + (seq - 16) * 2048 : seq * 256, bs = seq - 16;
    LAS bf16* Kst = (LAS bf16*)lds;
    LAS bf16* Vst = (LAS bf16*)(lds + 17408);
    LAS bf16* C0t = (LAS bf16*)lds;
    LAS float* aT = (LAS float*)(lds + 35840);
    LAS float* n0s = (LAS float*)(lds + 36864);
    LAS bf16* Qw = (LAS bf16*)(lds + 37888 + wave * 8704);
    const bf16* GS = (const bf16*)(a.out + OFF_K + (size_t)M * 512);
    const float* NS = (const float*)(ws + WS_NS);
    asm volatile("" : "+v"(lane), "+v"(tid));
    const int lt = lane & 31, hh = lane >> 5, q0 = qt * 256 + 32 * wave, trow = base + q0 + lt;
    { u32x4 qv[8];
#pragma unroll
      for (int i = 0; i < 8; ++i) qv[i] = *(const u32x4*)(QB + (size_t)trow * 512 + h * 128 + 16 * i + 8 * hh);
#pragma unroll
      for (int i = 0; i < 8; ++i) *(LAS u32x4*)(Qw + lt * 136 + 16 * i + 8 * hh) = qv[i]; }
    LDS_WAIT(); asm volatile("" ::: "memory");
#define QF(i) (*(const LAS bf16x8*)(Qw + lt * 136 + 16 * (i) + 8 * hh))
    f32x16 O[4];
#pragma unroll 1
    for (int dir = 0; dir < 2; ++dir) {
#pragma unroll
        for (int eb = 0; eb < 4; ++eb)
#pragma unroll
            for (int r = 0; r < 16; ++r) O[eb][r] = 0.f;
        float den = 0.f;
        const float Mt = MSv[(size_t)trow * 8 + dir * 4 + h], bt = bS[(size_t)trow * 8 + dir * 4 + h];
        if (isS) {
            __syncthreads();
            const int sidx = (bs * 2 + dir) * 4 + h;
            const float m0 = a.in[I_STM][sidx];
            float cf[8]; float Mref = m0;
#pragma unroll
            for (int i = 0; i < 8; ++i) cf[i] = MSv[(size_t)(base + 256 * i + (dir ? 0 : 255)) * 8 + dir * 4 + h];
            if (dir == 0) { if (qt > 0) Mref = cf[0];
#pragma unroll
                for (int i = 1; i < 8; ++i) if (i < qt) Mref = cf[i]; }
            else { if (qt < 7) Mref = cf[7];
#pragma unroll
                for (int i = 6; i >= 0; --i) if (i > qt) Mref = cf[i]; }
            const float c0f = __expf(m0 - Mref);
#pragma unroll
            for (int i = 0; i < 8; ++i) { const bool inc = dir ? (i > qt) : (i < qt); cf[i] = inc ? __expf(cf[i] - Mref) : 0.f; }
            const float* C0 = a.in[I_STC] + (size_t)sidx * 16384; const bf16* Gb = GS + (size_t)sidx * 8 * 16384;
            for (int c = tid; c < 2048; c += NTHR) { const int d = c >> 4, e8 = (c & 15) * 8;
                const f32x4 c0a = *(const f32x4*)(C0 + d * 128 + e8), c0b = *(const f32x4*)(C0 + d * 128 + e8 + 4);
                u32x4 gq[8];
#pragma unroll
                for (int i = 0; i < 8; ++i) gq[i] = *(const u32x4*)(Gb + (size_t)i * 16384 + d * 128 + e8);
                float v[8];
#pragma unroll
                for (int j = 0; j < 4; ++j) { v[j] = c0a[j] * c0f; v[4 + j] = c0b[j] * c0f; }
#pragma unroll
                for (int i = 0; i < 8; ++i) { float g[8]; unpack8(gq[i], g);
#pragma unroll
                    for (int j = 0; j < 8; ++j) v[j] += cf[i] * g[j]; }
                const u32x4 pk = pack8(v);
                C0t[(e8 + 0) * 136 + d] = (bf16)(pk.x & 0xffffu); C0t[(e8 + 1) * 136 + d] = (bf16)(pk.x >> 16); C0t[(e8 + 2) * 136 + d] = (bf16)(pk.y & 0xffffu); C0t[(e8 + 3) * 136 + d] = (bf16)(pk.y >> 16);
                C0t[(e8 + 4) * 136 + d] = (bf16)(pk.z & 0xffffu); C0t[(e8 + 5) * 136 + d] = (bf16)(pk.z >> 16); C0t[(e8 + 6) * 136 + d] = (bf16)(pk.w & 0xffffu); C0t[(e8 + 7) * 136 + d] = (bf16)(pk.w >> 16); }
            if (tid < 128) { float nsv[8];
#pragma unroll
                for (int i = 0; i < 8; ++i) nsv[i] = NS[((size_t)sidx * 8 + i) * 128 + tid];
                float nv = a.in[I_STN][sidx * 128 + tid] * c0f;
#pragma unroll
                for (int i = 0; i < 8; ++i) nv += cf[i] * nsv[i];
                n0s[tid] = nv; }
            __syncthreads();
            const float sc = __expf(Mref - Mt);
            float dq = 0.f;
#pragma unroll
            for (int i = 0; i < 8; ++i) { float q[8]; const u32x4 qq = __builtin_bit_cast(u32x4, QF(i));
                unpack8(qq, q);
#pragma unroll
                for (int j = 0; j < 8; ++j) { dq += q[j] * n0s[16 * i + 8 * hh + j]; q[j] *= sc; }
                const bf16x8 Qs = __builtin_bit_cast(bf16x8, pack8(q));
#pragma unroll
                for (int eb = 0; eb < 4; ++eb) { const bf16x8 cf = *(const LAS bf16x8*)(C0t + (32 * eb + lt) * 136 + 16 * i + 8 * hh); O[eb] = MFMA32(cf, Qs, O[eb]); }
                asm volatile("" ::: "memory"); }
            den += sc * dq;
        }
        const int kt_lo = 4 * qt, kt_hi = 4 * qt + 3;
        u32x4 kreg[2], vreg[2];
#define ML_LOAD(kt_) do { const int kr0_ = base + 64 * (kt_); _Pragma("unroll") for (int i_ = 0; i_ < 2; ++i_) { const int c_ = tid + NTHR * i_; \
            kreg[i_] = *(const u32x4*)(KB + (size_t)(kr0_ + (c_ >> 4)) * 512 + h * 128 + (c_ & 15) * 8); \
            vreg[i_] = *(const u32x4*)(proj + (size_t)(kr0_ + (c_ & 63)) * NPROJ + 1024 + h * 128 + (c_ >> 6) * 8); } \
            } while (0)
        ML_LOAD(kt_lo);
#pragma unroll 1
        for (int kt = kt_lo; kt <= kt_hi; ++kt) {
            __syncthreads();
#pragma unroll
            for (int i_ = 0; i_ < 2; ++i_) { const int c_ = tid + NTHR * i_;
                *(LAS u32x4*)(Kst + (c_ >> 4) * 136 + (c_ & 15) * 8) = kreg[i_];
                LAS bf16* d = Vst + ((c_ >> 6) * 8) * 72 + (c_ & 63); const u32x4 v = vreg[i_];
                d[0] = (bf16)(v.x & 0xffffu); d[72] = (bf16)(v.x >> 16); d[144] = (bf16)(v.y & 0xffffu); d[216] = (bf16)(v.y >> 16);
                d[288] = (bf16)(v.z & 0xffffu); d[360] = (bf16)(v.z >> 16); d[432] = (bf16)(v.w & 0xffffu); d[504] = (bf16)(v.w >> 16); }
            if (tid < 64) aT[tid] = aS[(size_t)(base + 64 * kt + tid) * 8 + dir * 4 + h];
            if (kt < kt_hi) ML_LOAD(kt + 1);
            __syncthreads();
#pragma unroll 1
            for (int sub = 0; sub < 2; ++sub) {
                const int s0 = 64 * kt + 32 * sub;
                const bool skip = dir ? (s0 + 31 < q0) : (s0 > q0 + 31);
                if (!skip) {
                    f32x16 S;
#pragma unroll
                    for (int r = 0; r < 16; ++r) S[r] = 0.f;
#pragma unroll
                    for (int i = 0; i < 8; ++i) { const bf16x8 kf = *(const LAS bf16x8*)(Kst + (32 * sub + lt) * 136 + 16 * i + 8 * hh); S = MFMA32(kf, QF(i), S); }
                    const bool diag = (s0 == q0);
                    const int vlo = (diag && dir) ? lt : 0, vhi = (diag && !dir) ? lt : 31;
#pragma unroll
                    for (int r = 0; r < 16; ++r) { const int sl = (r & 3) + 8 * (r >> 2) + 4 * hh; const float av = aT[32 * sub + sl];
                        float wgt = __expf(av - Mt);
                        wgt = (sl >= vlo && sl <= vhi) ? wgt : 0.f;
                        const float p = S[r] * wgt; den += p; S[r] = p; }
                    const bf16x8 P0 = pack_frag(S, 0), P1 = pack_frag(S, 1);
#pragma unroll
                    for (int eb = 0; eb < 4; ++eb) {
                        O[eb] = MFMA32(ld_vfrag(Vst, 32 * eb + lt, 32 * sub + 4 * hh), P0, O[eb]);
                        O[eb] = MFMA32(ld_vfrag(Vst, 32 * eb + lt, 32 * sub + 16 + 4 * hh), P1, O[eb]); }
                }
            }
        }
#undef ML_LOAD
        const float dent = den + __shfl_xor(den, 32);
        const float inv = 1.f / fmaxf(fabsf(dent), __expf(-(bt + Mt)));
        int trow2 = trow; asm volatile("" : "+v"(trow2));
        float* hp = hscr + (size_t)trow2 * 512 + h * 128 + 4 * hh;
        if (dir == 0) {
#pragma unroll
            for (int eb = 0; eb < 4; ++eb)
#pragma unroll
                for (int g = 0; g < 4; ++g) { f32x4 v; v[0] = O[eb][4 * g] * inv; v[1] = O[eb][4 * g + 1] * inv; v[2] = O[eb][4 * g + 2] * inv; v[3] = O[eb][4 * g + 3] * inv;
                    *(f32x4*)(hp + 32 * eb + 8 * g) = v; }
        } else {
            float ss = 0.f;
#pragma unroll
            for (int eb = 0; eb < 4; ++eb)
#pragma unroll
                for (int g = 0; g < 4; ++g) { const f32x4 v = *(const f32x4*)(hp + 32 * eb + 8 * g);
#pragma unroll
                    for (int j = 0; j < 4; ++j) { const float x = __builtin_fmaf(O[eb][4 * g + j], inv, v[j]); O[eb][4 * g + j] = x; ss = __builtin_fmaf(x, x, ss); }
                    asm volatile("" ::: "memory"); }
            ss += __shfl_xor(ss, 32);
            const float rs = rsqrtf(ss * (1.f / 128.f) + EPS);
            const float* gh = a.in[I_GMLSTM] + h * 128 + 4 * hh; const bf16* op = proj + (size_t)trow2 * NPROJ + 1536 + h * 128 + 4 * hh; bf16* yp = ycat + (size_t)trow2 * 1024 + h * 128 + 4 * hh;
#pragma unroll
            for (int eb = 0; eb < 4; ++eb)
#pragma unroll
                for (int g = 0; g < 4; ++g) { const int e = 32 * eb + 8 * g; const u32x2 ov = *(const u32x2*)(op + e); const f32x4 gv = *(const f32x4*)(gh + e);
                    const float o0 = __uint_as_float(ov.x << 16), o1 = __uint_as_float(ov.x & 0xffff0000u), o2 = __uint_as_float(ov.y << 16), o3 = __uint_as_float(ov.y & 0xffff0000u);
                    u32x2 w; w.x = pk2(O[eb][4 * g] * rs * gv[0] * sigm_f(o0), O[eb][4 * g + 1] * rs * gv[1] * sigm_f(o1));
                    w.y = pk2(O[eb][4 * g + 2] * rs * gv[2] * sigm_f(o2), O[eb][4 * g + 3] * rs * gv[3] * sigm_f(o3)); *(u32x2*)(yp + e) = w;
                    if (g & 1) asm volatile("" ::: "memory"); }
        }
    }
    __syncthreads();
#undef QF
}
DI void mlstm_state_unit(const Args& a, LAS unsigned char* lds, int seq, int h, int dir, int blk, int tid, int lane, int wave) {
    unsigned char* ws = a.ws;
    const bf16* KB = (const bf16*)(ws + WS_KB); const bf16* proj = (const bf16*)(ws + WS_PROJ);
    const float* aS = (const float*)(ws + WS_AS); const float* MSv = (const float*)(ws + WS_MS); const float* bS = (const float*)(ws + WS_BS);
    asm volatile("" : "+v"(lane), "+v"(tid));
    const bool isS = seq >= 16; const int base = (isS ? MPR + (seq - 16) * 2048 : seq * 256) + 256 * blk, lastrow = base + (dir ? 0 : 255);
    const float ML = MSv[(size_t)lastrow * 8 + dir * 4 + h], bL = bS[(size_t)lastrow * 8 + dir * 4 + h];
    LAS bf16* Kt = (LAS bf16*)lds;
    LAS bf16* Vst = (LAS bf16*)(lds + 18432);
    const int lt = lane & 31, hh = lane >> 5, db = wave >> 1, eb0 = 2 * (wave & 1);
    f32x16 C[2];
#pragma unroll
    for (int j = 0; j < 2; ++j)
#pragma unroll
        for (int r = 0; r < 16; ++r) C[j][r] = 0.f;
    float nacc = 0.f;
    u32x4 kreg[2], vreg[2]; float wreg[2];
#define ST_LOAD(kt_) do { const int kr0_ = base + 64 * (kt_); _Pragma("unroll") for (int i_ = 0; i_ < 2; ++i_) { const int c_ = tid + NTHR * i_, key_ = c_ & 63, ch_ = c_ >> 6; \
        kreg[i_] = *(const u32x4*)(KB + (size_t)(kr0_ + key_) * 512 + h * 128 + ch_ * 8); vreg[i_] = *(const u32x4*)(proj + (size_t)(kr0_ + key_) * NPROJ + 1024 + h * 128 + ch_ * 8); \
        wreg[i_] = aS[(size_t)(kr0_ + key_) * 8 + dir * 4 + h]; } } while (0)
    ST_LOAD(0);
#pragma unroll 1
    for (int kt = 0; kt < 4; ++kt) {
        __syncthreads();
#pragma unroll
        for (int i_ = 0; i_ < 2; ++i_) { const int c_ = tid + NTHR * i_, key = c_ & 63, ch = c_ >> 6; float k[8]; unpack8(kreg[i_], k);
            const float w = __expf(wreg[i_] - ML);
#pragma unroll
            for (int j = 0; j < 8; j += 2) { const unsigned p = pk2(k[j] * w, k[j + 1] * w); Kt[(ch * 8 + j) * 72 + key] = (bf16)(p & 0xffffu); Kt[(ch * 8 + j + 1) * 72 + key] = (bf16)(p >> 16); }
            LAS bf16* d = Vst + (ch * 8) * 72 + key; const u32x4 v = vreg[i_];
            d[0] = (bf16)(v.x & 0xffffu); d[72] = (bf16)(v.x >> 16); d[144] = (bf16)(v.y & 0xffffu); d[216] = (bf16)(v.y >> 16);
            d[288] = (bf16)(v.z & 0xffffu); d[360] = (bf16)(v.z >> 16); d[432] = (bf16)(v.w & 0xffffu); d[504] = (bf16)(v.w >> 16); }
        if (kt < 3) ST_LOAD(kt + 1);
        __syncthreads();
#pragma unroll
        for (int i = 0; i < 4; ++i) { const bf16x8 kf = *(const LAS bf16x8*)(Kt + (32 * db + lt) * 72 + 16 * i + 8 * hh);
#pragma unroll
            for (int j = 0; j < 2; ++j) { const bf16x8 vf = *(const LAS bf16x8*)(Vst + (32 * (eb0 + j) + lt) * 72 + 16 * i + 8 * hh); C[j] = MFMA32(kf, vf, C[j]); } }
        if (tid < 128) { float s = 0.f;
#pragma unroll 8
            for (int k = 0; k < 64; ++k) s += bf2f(Kt[tid * 72 + k]);
            nacc += s; }
    }
#undef ST_LOAD
    if (!isS) {
        float* oc = a.out + OFF_C + ((size_t)((seq * 2 + dir) * 4 + h)) * 16384;
#pragma unroll
        for (int j = 0; j < 2; ++j)
#pragma unroll
            for (int r = 0; r < 16; ++r) { const int d = 32 * db + (r & 3) + 8 * (r >> 2) + 4 * hh, e = 32 * (eb0 + j) + lt; oc[d * 128 + e] = C[j][r]; }
        if (tid < 128) a.out[OFF_N + ((size_t)((seq * 2 + dir) * 4 + h)) * 128 + tid] = nacc;
        if (tid == 0) a.out[OFF_MM + (seq * 2 + dir) * 4 + h] = bL + ML;
    } else {
        const size_t u = ((size_t)(((seq - 16) * 2 + dir) * 4 + h)) * 8 + blk;
        bf16* og = (bf16*)(a.out + OFF_K + (size_t)M * 512) + u * 16384;
#pragma unroll
        for (int j = 0; j < 2; ++j)
#pragma unroll
            for (int r = 0; r < 16; ++r) { const int d = 32 * db + (r & 3) + 8 * (r >> 2) + 4 * hh, e = 32 * (eb0 + j) + lt; og[d * 128 + e] = (bf16)(pk2(C[j][r], 0.f) & 0xffffu); }
        if (tid < 128) ((float*)(ws + WS_NS))[u * 128 + tid] = nacc;
    }
    __syncthreads();
}
constexpr int HY_CP = 8224;
constexpr int HY_UB = 65792, HY_XB = 90624;
DI u32x4 ld16_or0(const bf16* p, bool ok) { u32x4 z = {0u, 0u, 0u, 0u}; return ok ? *(const u32x4*)p : z; }
DI void hy_build_copies(LAS unsigned char* lds, const bf16* R, int RL, int tid) {
    const int nch = RL / 8;
    for (int mch = tid; mch <= nch; mch += NTHR) {
        const u32x4 lo = ld16_or0(R + 8 * (mch - 1), mch >= 1), hi = ld16_or0(R + 8 * mch, mch < nch);
        const unsigned W[8] = {lo.x, lo.y, lo.z, lo.w, hi.x, hi.y, hi.z, hi.w};
#pragma unroll
        for (int sg = 0; sg < 8; ++sg) { u32x4 o;
            if ((sg & 1) == 0) { o.x = W[sg / 2]; o.y = W[sg / 2 + 1]; o.z = W[sg / 2 + 2]; o.w = W[sg / 2 + 3]; }
            else { const int q = (sg - 1) / 2; o.x = __builtin_amdgcn_alignbit(W[q + 1], W[q], 16); o.y = __builtin_amdgcn_alignbit(W[q + 2], W[q + 1], 16);
                   o.z = __builtin_amdgcn_alignbit(W[q + 3], W[q + 2], 16); o.w = __builtin_amdgcn_alignbit(W[q + 4], W[q + 3], 16); }
            *(LAS u32x4*)(lds + sg * HY_CP + 16 * mch) = o; }
    }
}
DI f32x16 hy_mfma_loop(LAS unsigned char* lds, unsigned abase, unsigned bbase, int dlo, int dhi) {
    f32x16 acc;
#pragma unroll
    for (int r = 0; r < 16; ++r) acc[r] = 0.f;
#pragma unroll 2
    for (int dl = dlo; dl <= dhi; ++dl) { const int off = -64 * dl;
        const bf16x8 a0 = *(const LAS bf16x8*)(lds + abase + off), b0 = *(const LAS bf16x8*)(lds + bbase + off);
        const bf16x8 a1 = *(const LAS bf16x8*)(lds + abase + off + 32), b1 = *(const LAS bf16x8*)(lds + bbase + off + 32);
        acc = MFMA32(a0, b0, acc); acc = MFMA32(a1, b1, acc); }
    return acc;
}
DI void hyena_channel(const Args& a, LAS unsigned char* lds, int c, int tid, int lane, int wave) {
    unsigned char* ws = a.ws;
    const bf16* UT = (const bf16*)(ws + WS_UT) + (size_t)c * M; const bf16* X2T = (const bf16*)(ws + WS_X2T) + (size_t)c * M;
    bf16* ycat = (bf16*)(ws + WS_H) + 512 + c; const float hb = a.in[I_HYB][c];
    const int lt = lane & 31, hh = lane >> 5, sg = (8 - (lt & 7)) & 7, i8 = (lt + 7) & ~7;
    LAS bf16* Ub = (LAS bf16*)(lds + HY_UB); LAS bf16* Xb = (LAS bf16*)(lds + HY_XB);
    __syncthreads();
    for (int i = tid; i < 24832 / 16; i += NTHR) *(LAS u32x4*)(lds + HY_UB + 16 * i) = (u32x4){0u, 0u, 0u, 0u};
    hy_build_copies(lds, (const bf16*)(ws + WS_R2048) + (size_t)c * 4096, 4096, tid);
    __syncthreads();
    for (int i = tid; i < 1024; i += NTHR) { const int b = i >> 8, mch = i & 255; const size_t g = (size_t)MPR + b * 2048 + 8 * mch;
        *(LAS u32x4*)(Ub + b * 2568 + 256 + 8 * mch) = *(const u32x4*)(UT + g); *(LAS u32x4*)(Xb + b * 2568 + 256 + 8 * mch) = *(const u32x4*)(X2T + g); }
    __syncthreads();
    { const int bq = lt & 3, Ib = 8 * wave + (lt >> 2);
      const unsigned abase = sg * HY_CP + 2 * (2048 + 8 + 8 * hh - i8), bbase = HY_UB + 2 * (bq * 2568 + 256 + 32 * Ib + 8 * hh);
      const f32x16 acc = hy_mfma_loop(lds, abase, bbase, 8 * wave - 63, 8 * wave + 7);
#pragma unroll
      for (int r = 0; r < 16; ++r) { int t = 32 * Ib + (r & 3) + 8 * (r >> 2) + 4 * hh; asm volatile("" : "+v"(t));
          const float u = bf2f(Ub[bq * 2568 + 256 + t]), x2 = bf2f(Xb[bq * 2568 + 256 + t]);
          const float y = x2 * (acc[r] + hb * u); ycat[(size_t)(MPR + bq * 2048 + t) * 1024] = (bf16)(pk2(y, 0.f) & 0xffffu); } }
    __syncthreads();
    for (int i = tid; i < 24832 / 16; i += NTHR) *(LAS u32x4*)(lds + HY_UB + 16 * i) = (u32x4){0u, 0u, 0u, 0u};
    hy_build_copies(lds, (const bf16*)(ws + WS_R256) + (size_t)c * 512, 512, tid);
    __syncthreads();
    { const int sq = tid >> 5, mch = tid & 31; const size_t g = (size_t)sq * 256 + 8 * mch;
      *(LAS u32x4*)(Ub + sq * 776 + 256 + 8 * mch) = *(const u32x4*)(UT + g); *(LAS u32x4*)(Xb + sq * 776 + 256 + 8 * mch) = *(const u32x4*)(X2T + g); }
    __syncthreads();
    if (wave < 4) { const int bq = 4 * wave + (lt & 3), Ib = lt >> 2;
      const unsigned abase = sg * HY_CP + 2 * (256 + 8 + 8 * hh - i8), bbase = HY_UB + 2 * (bq * 776 + 256 + 32 * Ib + 8 * hh);
      const f32x16 acc = hy_mfma_loop(lds, abase, bbase, -7, 7);
#pragma unroll
      for (int r = 0; r < 16; ++r) { int t = 32 * Ib + (r & 3) + 8 * (r >> 2) + 4 * hh; asm volatile("" : "+v"(t));
          const float u = bf2f(Ub[bq * 776 + 256 + t]), x2 = bf2f(Xb[bq * 776 + 256 + t]);
          const float y = x2 * (acc[r] + hb * u); ycat[(size_t)(bq * 256 + t) * 1024] = (bf16)(pk2(y, 0.f) & 0xffffu); } }
    __syncthreads();
}
#ifndef MK_MB_S
#define MK_MB_S 1
#define MK_MB_P 1
#define MK_MA_H 1
#define MK_MA_S 1
#endif
constexpr int HY_A = 256;
DI void hyena_range(const Args& a, LAS unsigned char* lds, int c_lo, int c_hi, int widx, int nw, int tid, int lane, int wave) {
    if (c_hi - c_lo == 256 && nw % 64 == 0 && nw <= 256) { const int x = widx & 7, cnt = 256 / nw, c0 = c_lo + 64 * (x >> 1) + 32 * (x & 1) + (widx >> 3) * cnt;
        for (int c = 0; c < cnt; ++c) hyena_channel(a, lds, c0 + c, tid, lane, wave); }
    else for (int c = c_lo + widx; c < c_hi; c += nw) hyena_channel(a, lds, c, tid, lane, wave);
}
DI void ph_mixers_a(const Args& a, LAS unsigned char* lds, int tid, int lane, int wave, int bid, int G) {
    const int hyA = (G > 192) ? HY_A : 512;
    for (int rp = 0; rp < MK_MA_H; ++rp) hyena_range(a, lds, 0, hyA, bid, G, tid, lane, wave);
    for (int it = bid; it < 384; it += G) { const bool smp = it < 256; const int rr = smp ? it : it - 256;
        for (int rp = 0; rp < MK_MA_S; ++rp)
        mlstm_state_unit(a, lds, smp ? 16 + (rr >> 6) : (rr >> 3), smp ? (rr >> 4) & 3 : (rr >> 1) & 3, smp ? (rr >> 3) & 1 : rr & 1, smp ? rr & 7 : 0, tid, lane, wave); }
}
DI void ph_mixers_b(const Args& a, LAS unsigned char* lds, int tid, int lane, int wave, int bid, int G) {
    if (G > 192 && bid >= 192) hyena_range(a, lds, HY_A, 512, bid - 192, G - 192, tid, lane, wave);
    for (int it = bid; it < 192; it += G) { const bool smp = it < 128; const int rr = smp ? it : it - 128;
        for (int rp = 0; rp < (smp ? MK_MB_S : MK_MB_P); ++rp)
        mlstm_unit(a, lds, smp ? 16 + (rr >> 5) : (rr >> 2), smp ? (rr >> 3) & 3 : rr & 3, smp ? rr & 7 : 0, tid, lane, wave); }
}
DI void attn_unit(const Args& a, LAS unsigned char* lds, int kind, int b, int h, int blk, int tid, int lane, int wave) {
    unsigned char* ws = a.ws;
    const bf16* Q1 = (const bf16*)(ws + WS_Q1); const bf16* K1 = (const bf16*)(ws + WS_K1); const bf16* V1 = (const bf16*)(ws + WS_V1);
    const bf16* CK = (const bf16*)(ws + WS_CK); const bf16* CV = (const bf16*)(ws + WS_CV);
    bf16* obuf = (bf16*)(ws + WS_H);
    LAS bf16* Kst = (LAS bf16*)lds;
    LAS bf16* Vst = (LAS bf16*)(lds + 9216);
    LAS float* rpbs = (LAS float*)(lds + 18432);
    asm volatile("" : "+v"(lane), "+v"(tid));
    const int lt = lane & 31, hh = lane >> 5;
    int qrow, r = 0, qc = 0, nctx, nloc, kr_lo = 0, rs = 0, cs = 0;
    if (kind == 0) { qrow = b * 256 + 32 * wave + lt; nctx = 0; nloc = 4; }
    else { const int r0 = 4 * blk; r = r0 + (wave >> 1); qc = 32 * (wave & 1) + lt; qrow = MPR + b * 2048 + r * 64 + qc; nctx = 8;
        const int lo = r0 - 4 < 0 ? 0 : (r0 - 4 > 24 ? 24 : r0 - 4); const int r3 = r0 + 3 - 4; const int hi = (r3 < 0 ? 0 : (r3 > 24 ? 24 : r3)) + 7;
        kr_lo = lo; nloc = hi - lo + 1; rs = r - 4 < 0 ? 0 : (r - 4 > 24 ? 24 : r - 4); cs = qc - 8 < 0 ? 0 : (qc - 8 > 48 ? 48 : qc - 8);
        __syncthreads();
        if (tid < 465) rpbs[tid] = a.in[I_RPB][h * 465 + tid] * 1.4426950408889634f;
    }
    int icol[2][16]; unsigned okm[2] = {0u, 0u};
#pragma unroll
    for (int sub = 0; sub < 2; ++sub)
#pragma unroll
        for (int q = 0; q < 16; ++q) { const int kc = 32 * sub + (q & 3) + 8 * (q >> 2) + 4 * hh; int ic = kc - qc + 15; ic = ic < 0 ? 0 : (ic > 30 ? 30 : ic);
            icol[sub][q] = ic; okm[sub] |= ((kc >= cs) && (kc < cs + 16)) ? (1u << q) : 0u; }
    bf16x8 Qf[4];
#pragma unroll
    for (int i = 0; i < 4; ++i) Qf[i] = *(const bf16x8*)(Q1 + (size_t)qrow * 1024 + h * 64 + 16 * i + 8 * hh);
    f32x16 O[2];
#pragma unroll
    for (int eb = 0; eb < 2; ++eb)
#pragma unroll
        for (int q = 0; q < 16; ++q) O[eb][q] = 0.f;
    float mrun = -INFINITY, lrun = 0.f;
    const int kkey = tid >> 3, kch = tid & 7, vkey = tid & 63, vch = tid >> 6;
    u32x4 kreg, vreg;
#define ATT_SRC(st_, ksrc_, vsrc_, ld_) do { const bool ic_ = (st_) < nctx; const int kr_ = kr_lo + ((st_) - nctx); \
        if (ic_) { ksrc_ = CK + ((size_t)((b * 16 + h) * 512 + 64 * (st_))) * 64; vsrc_ = CV + ((size_t)((b * 16 + h) * 512 + 64 * (st_))) * 64; ld_ = 64; } \
        else if (kind == 0) { const size_t row0 = (size_t)b * 256 + 64 * (st_); ksrc_ = K1 + row0 * 1024 + h * 64; vsrc_ = V1 + row0 * 1024 + h * 64; ld_ = 1024; } \
        else { const size_t row0 = (size_t)MPR + b * 2048 + kr_ * 64; ksrc_ = K1 + row0 * 1024 + h * 64; vsrc_ = V1 + row0 * 1024 + h * 64; ld_ = 1024; } } while (0)
    { const bf16* ksrc; const bf16* vsrc; size_t ld; ATT_SRC(0, ksrc, vsrc, ld);
      kreg = *(const u32x4*)(ksrc + (size_t)kkey * ld + kch * 8); vreg = *(const u32x4*)(vsrc + (size_t)vkey * ld + vch * 8); }
#pragma unroll 1
    for (int st = 0; st < nctx + nloc; ++st) {
        const bool isctx = st < nctx; const int kr = kr_lo + (st - nctx);
        __syncthreads();
        *(LAS u32x4*)(Kst + kkey * 72 + kch * 8) = kreg;
        { LAS bf16* d = Vst + (vch * 8) * 72 + vkey;
          d[0] = (bf16)(vreg.x & 0xffffu); d[72] = (bf16)(vreg.x >> 16); d[144] = (bf16)(vreg.y & 0xffffu); d[216] = (bf16)(vreg.y >> 16);
          d[288] = (bf16)(vreg.z & 0xffffu); d[360] = (bf16)(vreg.z >> 16); d[432] = (bf16)(vreg.w & 0xffffu); d[504] = (bf16)(vreg.w >> 16); }
        if (st + 1 < nctx + nloc) { const bf16* ksrc; const bf16* vsrc; size_t ld; ATT_SRC(st + 1, ksrc, vsrc, ld);
            kreg = *(const u32x4*)(ksrc + (size_t)kkey * ld + kch * 8); vreg = *(const u32x4*)(vsrc + (size_t)vkey * ld + vch * 8); }
        __syncthreads();
        const bool active = (kind == 0) || isctx || (kr >= rs && kr < rs + 8);
        if (active) {
#pragma unroll
            for (int sub = 0; sub < 2; ++sub) {
                f32x16 S;
#pragma unroll
                for (int q = 0; q < 16; ++q) S[q] = 0.f;
#pragma unroll
                for (int i = 0; i < 4; ++i) { const bf16x8 kf = *(const LAS bf16x8*)(Kst + (32 * sub + lt) * 72 + 16 * i + 8 * hh); S = MFMA32(kf, Qf[i], S); }
                if (kind == 1 && !isctx) {
                    const LAS float* rb = rpbs + (kr - r + 7) * 31;
                    float bv[16];
#pragma unroll
                    for (int q = 0; q < 16; ++q) bv[q] = rb[icol[sub][q]];
#pragma unroll
                    for (int q = 0; q < 16; ++q) S[q] = ((okm[sub] >> q) & 1u) ? S[q] + bv[q] : -INFINITY;
                }
                float mx = fmaxf(fmaxf(fmaxf(S[0], S[1]), fmaxf(S[2], S[3])), fmaxf(fmaxf(S[4], S[5]), fmaxf(S[6], S[7])));
                mx = fmaxf(mx, fmaxf(fmaxf(fmaxf(S[8], S[9]), fmaxf(S[10], S[11])), fmaxf(fmaxf(S[12], S[13]), fmaxf(S[14], S[15]))));
                { const auto sw_ = __builtin_amdgcn_permlane32_swap(__float_as_uint(mx), __float_as_uint(mx), false, false); mx = fmaxf(__uint_as_float(sw_[0]), __uint_as_float(sw_[1])); }
                if (!__all(mx <= mrun + 8.f)) { const float mnew = fmaxf(mrun, mx); const float alpha = exp2_f(mrun - mnew);
                    lrun *= alpha; mrun = mnew;
#pragma unroll
                    for (int eb = 0; eb < 2; ++eb)
#pragma unroll
                        for (int q = 0; q < 16; ++q) O[eb][q] *= alpha; }
                float ps = 0.f;
#pragma unroll
                for (int q = 0; q < 16; ++q) { const float p = exp2_f(S[q] - mrun); S[q] = p; ps += p; }
                lrun += ps;
                const bf16x8 P0 = pack_frag(S, 0), P1 = pack_frag(S, 1);
#pragma unroll
                for (int eb = 0; eb < 2; ++eb) {
                    O[eb] = MFMA32(ld_vfrag(Vst, 32 * eb + lt, 32 * sub + 4 * hh), P0, O[eb]);
                    O[eb] = MFMA32(ld_vfrag(Vst, 32 * eb + lt, 32 * sub + 16 + 4 * hh), P1, O[eb]); }
            }
        }
    }
    const float inv = 1.f / (lrun + __shfl_xor(lrun, 32));
    bf16* op = obuf + (size_t)qrow * 1024 + h * 64;
#pragma unroll
    for (int eb = 0; eb < 2; ++eb)
#pragma unroll
        for (int g = 0; g < 4; ++g) { u32x2 w; w.x = pk2(O[eb][4 * g] * inv, O[eb][4 * g + 1] * inv); w.y = pk2(O[eb][4 * g + 2] * inv, O[eb][4 * g + 3] * inv);
            *(u32x2*)(op + 32 * eb + 8 * g + 4 * hh) = w; }
    __syncthreads();
#undef ATT_SRC
}
#ifndef MK_AT_N
#define MK_AT_N 1
#define MK_AT_C 1
#endif
DI void ph_attention(const Args& a, LAS unsigned char* lds, int tid, int lane, int wave, int bid, int G) {
    for (int it = bid; it < 768; it += G) {
        if (it < 512) { for (int rp = 0; rp < MK_AT_N; ++rp) attn_unit(a, lds, 1, it >> 7, (it >> 3) & 15, it & 7, tid, lane, wave); }
        else { const int r = it - 512; for (int rp = 0; rp < MK_AT_C; ++rp) attn_unit(a, lds, 0, r >> 4, r & 15, 0, tid, lane, wave); }
    }
}
__global__ void __launch_bounds__(NTHR, 2) mk_fwd(Args a) {
    extern __shared__ __attribute__((aligned(16))) unsigned char lds_raw[];
    LAS unsigned char* lds = (LAS unsigned char*)lds_raw;
    const int tid = threadIdx.x, lane = tid & 63, wave = __builtin_amdgcn_readfirstlane(tid >> 6), bid = blockIdx.x, G = gridDim.x;
    const int gw = bid * NWAVES + wave, NGW = G * NWAVES;
    unsigned char* ws = a.ws;
    for (int u = tid; u < (LDS_BYTES - LDSCTL_OFF) / 4; u += NTHR) ((LAS unsigned*)(lds + LDSCTL_OFF))[u] = 0u;
    __syncthreads();
    XcdBarrier bar; bar.bar = (unsigned*)(ws + WS_CTL) + CW_BAR; bar.x = 0; bar.st = nullptr;
    const bool multi = (a.ph_hi - a.ph_lo) > 1;
    if (multi) bar = xcd_barrier_post((unsigned*)(ws + WS_CTL) + CW_BAR, (volatile LAS unsigned*)(lds + MISC_OFF) + 8);
    float* out = a.out;
    float* modF = (float*)(ws + WS_MODF);
    bf16* hbuf = (bf16*)(ws + WS_H);
    bf16* dlt = (bf16*)(ws + WS_DL);
    const float* xsB = a.in[I_XS] - (size_t)MPR * D;
    const int lo = a.ph_lo, hi = a.ph_hi;
#ifndef MK_ONLY
#define MK_ONLY -1
#endif
#define IN(k) ((MK_ONLY < 0 || MK_ONLY == (k)) && lo <= (k) && (k) < hi)
#define SEAM(k) do { if ((k) + 1 < hi) xcd_barrier(bar); } while (0)
#ifndef MK_REPMASK
#define MK_REPMASK 0u
#endif
#define MK_REP(k) (((MK_REPMASK >> (k)) & 1u) ? 2 : 1)
#define PH(k, ...) if (IN(k)) { if (MK_REP(k) == 2) { __VA_ARGS__ xcd_barrier(bar); } { __VA_ARGS__ } SEAM(k); }
#define GEMM_UP(l) do { pg8::Gemm g{hbuf, (const bf16*)(ws + WS_WUP) + (size_t)(l) * 5632 * 1024, M, 2 * FF, D}; pg8::StaticOrder S; S.init(M, 2 * FF, G, bid); \
            pg8::EpiFfn E{(bf16*)(ws + WS_FG), a.in[I_WCFFN] + (size_t)(l) * 3 * FF, (float*)(ws + WS_ABND), (float*)(ws + WS_GBND), (LAS float*)(lds + XCH_OFF)}; \
            pg8::gemm_phase<pg8::EpiFfn, pg8::StaticOrder, true, true>(lds, g, S, E); } while (0)
#define GEMM_DOWN(l) do { pg8::Gemm g{(const bf16*)(ws + WS_FG), (const bf16*)(ws + WS_WDN) + (size_t)(l) * 1024 * FF, M, D, FF}; pg8::StaticOrder S; S.init(M, D, G, bid); \
            pg8::EpiDelta E{dlt, modF + (size_t)(l) * 5 * 6144 + 5 * 1024}; \
            pg8::gemm_phase<pg8::EpiDelta, pg8::StaticOrder, true, true>(lds, g, S, E); } while (0)
    PH(0, ph_prologue(a, lds, tid, lane, wave, bid, G);)
    PH(1, ph_modf_norm0(a, lds, tid, lane, wave, bid, G);)
    PH(2, pg8::Gemm g{hbuf, (const bf16*)(ws + WS_WAB), M, NPROJ, D}; pg8::StaticOrder S; S.init(M, NPROJ, G, bid);
            pg8::EpiProj E{(bf16*)(ws + WS_PROJ), NPROJ, (float*)(ws + WS_GATES), 8};
            pg8::gemm_phase<pg8::EpiProj, pg8::StaticOrder, true, true>(lds, g, S, E);)
    PH(3, ph_e1(a, lds, tid, gw, NGW, lane, wave, bid, G);)
    PH(4, ph_mixers_a(a, lds, tid, lane, wave, bid, G);)
    PH(5, ph_mixers_b(a, lds, tid, lane, wave, bid, G);)
    PH(6, pg8::Gemm g{hbuf, (const bf16*)(ws + WS_WOAB), M, D, D}; pg8::StaticOrder S; S.init(M, D, G, bid);
            pg8::EpiDelta E{dlt, modF + 2 * 1024};
            pg8::gemm_phase<pg8::EpiDelta, pg8::StaticOrder, true, true>(lds, g, S, E);
            { const int busy = (M / 256) * (D / 256); if (G > busy) { if (bid >= busy) bg_convert(a, lds, 1, bid - busy, G - busy, tid); } else bg_convert(a, lds, 1, bid, G, tid); })
    PH(7, ph_norm(a.in[I_XP], xsB, dlt, out, a.in[I_GFFN], modF, 3, 4, hbuf, gw, NGW, lane);)
    PH(8, GEMM_UP(0);)
    PH(9, ph_ffn_fix(a, 0, tid, bid, G);)
    PH(10, GEMM_DOWN(0); { const int busy = (M / 256) * (D / 256); if (G > busy) { if (bid >= busy) bg_convert(a, lds, 2, bid - busy, G - busy, tid); } else bg_convert(a, lds, 2, bid, G, tid); })
    PH(11, ph_norm(out, out, dlt, out, a.in[I_GMIX] + D, modF + 5 * 6144, 0, 1, hbuf, gw, NGW, lane);)
    PH(12, pg8::Gemm g{hbuf, (const bf16*)(ws + WS_WC), M, 3 * D, D}; pg8::StaticOrder S; S.init(M, 3 * D, G, bid);
            pg8::EpiQKV E{(bf16*)(ws + WS_Q1), (size_t)(WS_K1 - WS_Q1) / 2, out + OFF_K, (size_t)(OFF_V - OFF_K)};
            pg8::gemm_phase<pg8::EpiQKV, pg8::StaticOrder, true, true>(lds, g, S, E);
            { const int nt_ = (M / 256) * (3 * D / 256), full = nt_ % G; if (full > 0 && full < G) { if (bid >= full) bg_convert(a, lds, 3, bid - full, G - full, tid); } else bg_convert(a, lds, 3, bid, G, tid); })
    PH(13, ph_attention(a, lds, tid, lane, wave, bid, G);)
    PH(14, pg8::Gemm g{hbuf, (const bf16*)(ws + WS_WOC), M, D, D}; pg8::StaticOrder S; S.init(M, D, G, bid);
            pg8::EpiDelta E{dlt, modF + 5 * 6144 + 2 * 1024};
            pg8::gemm_phase<pg8::EpiDelta, pg8::StaticOrder, true, true>(lds, g, S, E);)
    PH(15, ph_norm(out, out, dlt, out, a.in[I_GFFN] + D, modF + 5 * 6144, 3, 4, hbuf, gw, NGW, lane);)
    PH(16, GEMM_UP(1);)
    PH(17, ph_ffn_fix(a, 1, tid, bid, G);)
    PH(18, GEMM_DOWN(1);)
    PH(19, ph_final_norm(out, dlt, a.in[I_GFIN], gw, NGW, lane);)
#undef IN
#undef SEAM
}
}

extern "C" void kernel_launch(void* const* d_in, const int* in_sizes, int n_in, void* d_out, int out_size, void* d_ws, size_t ws_size, hipStream_t stream) {
    using namespace mk;
    static int grid = 0;
    if (grid == 0) {
        if (n_in != 33 || out_size != 23085184 || ws_size < WS_END) { fprintf(stderr, "kernel_launch: unexpected shapes: n_in %d out %d ws %zu\n", n_in, out_size, ws_size); grid = -1; return; }
        int dev = 0, cus = 0, per_cu = 0;
        if (hipGetDevice(&dev) != hipSuccess || hipDeviceGetAttribute(&cus, hipDeviceAttributeMultiprocessorCount, dev) != hipSuccess) { grid = -1; return; }
        if (hipFuncSetAttribute((const void*)mk_fwd, hipFuncAttributeMaxDynamicSharedMemorySize, LDS_BYTES) != hipSuccess) { fprintf(stderr, "kernel_launch: hipFuncSetAttribute failed\n"); grid = -1; return; }
        if (hipOccupancyMaxActiveBlocksPerMultiprocessor(&per_cu, (const void*)mk_fwd, NTHR, LDS_BYTES) != hipSuccess || per_cu < 1) { fprintf(stderr, "kernel_launch: occupancy query says %d\n", per_cu); per_cu = 1; }
        (void)hipGetLastError();
        grid = cus;
    }
    if (grid < 0) return;
    if (hipMemsetAsync((char*)d_ws + WS_CTL, 0, CTL_ZERO_BYTES, stream) != hipSuccess) return;
    Args a{};
    for (int i = 0; i < 33; ++i) a.in[i] = (const float*)d_in[i];
    a.out = (float*)d_out; a.ws = (unsigned char*)d_ws;
#if MK_ONE_LAUNCH
    a.ph_lo = 0; a.ph_hi = NPHASES;
    { void* args[] = {&a};
      hipError_t e = hipLaunchCooperativeKernel((const void*)mk_fwd, dim3(grid), dim3(NTHR), args, LDS_BYTES, stream);
      if (e != hipSuccess) fprintf(stderr, "kernel_launch: cooperative launch failed: %s (grid %d)\n", hipGetErrorString(e), grid); }
#else
    for (int ph = 0; ph < NPHASES; ++ph) { a.ph_lo = ph; a.ph_hi = ph + 1; hipLaunchKernelGGL(mk_fwd, dim3(grid), dim3(NTHR), LDS_BYTES, stream, a); }
#endif
}
```

```cpp
#include <hip/hip_runtime.h>
#include <cstdio>
#include <cstdint>
namespace pg8 {
#define PG8_LAS __attribute__((address_space(3)))
typedef unsigned short bf16_t;
typedef short bf16x8 __attribute__((ext_vector_type(8)));
typedef float f32x4 __attribute__((ext_vector_type(4)));
typedef unsigned u32x4 __attribute__((ext_vector_type(4)));
constexpr int BM = 256, BK = 64, HALF = 128, HTB = HALF * BK * 2  , STAGE_BYTES = 8 * HTB, NXCD = 8, WGM = 8;

__host__ __device__ __forceinline__ int lds_byte(int r, int c) { const int st = (r >> 4) * 2 + (c >> 5), rr = r & 15, cc = c & 31, ob = rr * 64 + cc * 2; return st * 1024 + (ob ^ (((ob >> 9) & 1) << 5)); }
__host__ __device__ __forceinline__ void stage_rc(int b, int& R, int& C) { const int st = b / 1024, sb = b % 1024, swz = sb ^ (((sb >> 9) & 1) << 5); R = (st >> 1) * 16 + swz / 64; C = (st & 1) * 32 + (swz % 64) / 2; }
__host__ __device__ __forceinline__ int perm32(int rho) { const int n = rho >> 4, i = rho & 15; return 8 * (i >> 2) + 4 * n + (i & 3); }

struct Unit { int pm, pn; };
struct Gemm { const bf16_t* A; const bf16_t* Bt; int M, N, K; };

struct StaticOrder {
    int nM, nN, nwg, G, c;
    __host__ __device__ void init(int M, int N, int G_, int c_) { nM = M / BM; nN = N / BM; nwg = nM * nN; G = G_; c = c_; }
    __host__ __device__ __forceinline__ bool next(int i, Unit& u) const {
        const long L = (long)i * G + c; if (L >= nwg) return false;
        int wgid = (int)L; { const int q = nwg / NXCD, r = nwg % NXCD, xcd = wgid % NXCD, off = wgid / NXCD; wgid = (xcd < r ? xcd * (q + 1) : r * (q + 1) + (xcd - r) * q) + off; }
        const int nig = WGM * nN, gid = wgid / nig, fm = gid * WGM, gsz = (nM - fm) < WGM ? (nM - fm) : WGM;
        u.pm = fm + ((wgid % nig) % gsz); u.pn = (wgid % nig) / gsz; return true;
    }
    __device__ __forceinline__ void a_ready(const Unit&) const {}
    __device__ __forceinline__ void done(const Unit&) const {}
};

__device__ __forceinline__ unsigned cvt_pk_bf16(float lo, float hi) { unsigned r; asm volatile("v_cvt_pk_bf16_f32 %0, %1, %2" : "=v"(r) : "v"(lo), "v"(hi)); return r; }
typedef float f32x2 __attribute__((ext_vector_type(2)));
__device__ __forceinline__ f32x2 gelu_pk(f32x2 v) {
    const f32x2 av = __builtin_elementwise_abs(v), d = av * 0.2316418882f + 1.0f;
    f32x2 t; t.x = __builtin_amdgcn_rcpf(d.x); t.y = __builtin_amdgcn_rcpf(d.y);
    f32x2 q = t * 0.5307027145f + (-0.7265760135f); q = q * t + 0.7107068705f; q = q * t + (-0.142248368f); q = q * t + 0.127414796f; q = q * t;
    const f32x2 s = (v * v) * (-0.72134752044f);
    f32x2 e; e.x = __builtin_amdgcn_exp2f(s.x); e.y = __builtin_amdgcn_exp2f(s.y);
    const f32x2 m = v * (q * e), r = v - m;
    f32x2 o; o.x = v.x < 0.f ? m.x : r.x; o.y = v.y < 0.f ? m.y : r.y; return o;
}

template <int ACT  > struct EpiBf16 {
    static constexpr bool PERM = true, AFTER_DRAIN = false; static_assert(ACT == 0 || ACT == 1, "EpiBf16: ACT is 0 (none) or 1 (gelu_pk)");
    bf16_t* O; int ldc; const float* bias; int split_cols; size_t split_stride; float scale0;
    __device__ __forceinline__ void operator()(const f32x4 (&acc)[2][2][4][2], const Unit& u, int wr, int wc, int fr, int fq) const {
        const int row0 = u.pm * BM + wr * 64 + fr; int colt = u.pn * BM; bf16_t* base = O;
        float sc = 1.f; if (split_cols) { const int t = colt / split_cols; base += (size_t)t * split_stride; colt -= t * split_cols; if (t == 0) sc = scale0; }
        const int col0 = colt + wc * 32 + 8 * fq, bcol0 = u.pn * BM + wc * 32 + 8 * fq;
        f32x4 bv[2][2];
#pragma unroll
        for (int bj = 0; bj < 2; ++bj)
#pragma unroll
            for (int n = 0; n < 2; ++n) bv[bj][n] = bias ? *(const f32x4*)(bias + bcol0 + bj * HALF + 4 * n) : (f32x4){0.f, 0.f, 0.f, 0.f};
#pragma unroll
        for (int ai = 0; ai < 2; ++ai)
#pragma unroll
            for (int m = 0; m < 4; ++m) { bf16_t* rowp = base + (size_t)(row0 + ai * HALF + m * 16) * ldc + col0;
#pragma unroll
                for (int bj = 0; bj < 2; ++bj) { f32x4 v0 = acc[ai][bj][m][0] + bv[bj][0], v1 = acc[ai][bj][m][1] + bv[bj][1];
                    if (ACT == 1) { f32x2 a = gelu_pk((f32x2){v0[0], v0[1]}), b = gelu_pk((f32x2){v0[2], v0[3]}), c = gelu_pk((f32x2){v1[0], v1[1]}), d = gelu_pk((f32x2){v1[2], v1[3]});
                        v0 = (f32x4){a.x, a.y, b.x, b.y}; v1 = (f32x4){c.x, c.y, d.x, d.y}; }
                    v0 = v0 * sc; v1 = v1 * sc; u32x4 w; w.x = cvt_pk_bf16(v0[0], v0[1]); w.y = cvt_pk_bf16(v0[2], v0[3]); w.z = cvt_pk_bf16(v1[0], v1[1]); w.w = cvt_pk_bf16(v1[2], v1[3]);
                    *(u32x4*)(rowp + bj * HALF) = w; } }
    }
};
typedef float f32x2e __attribute__((ext_vector_type(2)));
typedef __bf16 bf2e __attribute__((ext_vector_type(2)));
__device__ __forceinline__ unsigned pkbf(float lo, float hi) { f32x2e v = {lo, hi}; bf2e b = __builtin_convertvector(v, bf2e); return __builtin_bit_cast(unsigned, b); }
struct EpiProj {
    static constexpr bool PERM = true, AFTER_DRAIN = false;
    bf16_t* O; int ldc; float* gates; int gate_pn;
    __device__ __forceinline__ void operator()(const f32x4 (&acc)[2][2][4][2], const Unit& u, int wr, int wc, int fr, int fq) const {
        const int row0 = u.pm * BM + wr * 64 + fr, col0 = u.pn * BM + wc * 32 + 8 * fq;
        const bool gt = (u.pn == gate_pn) && (wc == 0) && (fq < 2);
#pragma unroll
        for (int ai = 0; ai < 2; ++ai)
#pragma unroll
            for (int m = 0; m < 4; ++m) { const int row = row0 + ai * HALF + m * 16; bf16_t* rowp = O + (size_t)row * ldc + col0;
#pragma unroll
                for (int bj = 0; bj < 2; ++bj) { const f32x4 v0 = acc[ai][bj][m][0], v1 = acc[ai][bj][m][1];
                    u32x4 w; w.x = pkbf(v0[0], v0[1]); w.y = pkbf(v0[2], v0[3]); w.z = pkbf(v1[0], v1[1]); w.w = pkbf(v1[2], v1[3]);
                    *(u32x4*)(rowp + bj * HALF) = w;
                    if (bj == 0 && gt) { *(f32x4*)(gates + (size_t)row * 16 + 8 * fq) = v0; *(f32x4*)(gates + (size_t)row * 16 + 8 * fq + 4) = v1; } } }
    }
};
struct EpiDelta {
    static constexpr bool PERM = true, AFTER_DRAIN = false;
    bf16_t* Dl; const float* gate5;
    __device__ __forceinline__ void operator()(const f32x4 (&acc)[2][2][4][2], const Unit& u, int wr, int wc, int fr, int fq) const {
        const int row0 = u.pm * BM + wr * 64 + fr, col0 = u.pn * BM + wc * 32 + 8 * fq;
        const int v = u.pm < 16 ? 4 : ((u.pm - 16) >> 3);
        const float* g = gate5 + (size_t)v * 6144;
        f32x4 gv[2][2];
#pragma unroll
        for (int bj = 0; bj < 2; ++bj)
#pragma unroll
            for (int n = 0; n < 2; ++n) gv[bj][n] = *(const f32x4*)(g + col0 + bj * HALF + 4 * n);
#pragma unroll
        for (int ai = 0; ai < 2; ++ai)
#pragma unroll
            for (int m = 0; m < 4; ++m) { bf16_t* rowp = Dl + (size_t)(row0 + ai * HALF + m * 16) * 1024 + col0;
#pragma unroll
                for (int bj = 0; bj < 2; ++bj) { const f32x4 v0 = acc[ai][bj][m][0] * gv[bj][0], v1 = acc[ai][bj][m][1] * gv[bj][1];
                    u32x4 w; w.x = pkbf(v0[0], v0[1]); w.y = pkbf(v0[2], v0[3]); w.z = pkbf(v1[0], v1[1]); w.w = pkbf(v1[2], v1[3]);
                    *(u32x4*)(rowp + bj * HALF) = w; } }
    }
};
struct EpiQKV {
    static constexpr bool PERM = true, AFTER_DRAIN = false;
    bf16_t* Q; size_t qkv_stride;
    __device__ __forceinline__ void operator()(const f32x4 (&acc)[2][2][4][2], const Unit& u, int wr, int wc, int fr, int fq) const {
        const int t = u.pn >> 2; const int colt = (u.pn & 3) * BM;
        bf16_t* base = Q + (size_t)t * qkv_stride; const float sc = t == 0 ? 0.18033688011112042f : 1.0f;
        const int row0 = u.pm * BM + wr * 64 + fr, col0 = colt + wc * 32 + 8 * fq;
#pragma unroll
        for (int ai = 0; ai < 2; ++ai)
#pragma unroll
            for (int m = 0; m < 4; ++m) { const int row = row0 + ai * HALF + m * 16; bf16_t* rowp = base + (size_t)row * 1024 + col0;
#pragma unroll
                for (int bj = 0; bj < 2; ++bj) { const f32x4 v0 = acc[ai][bj][m][0] * sc, v1 = acc[ai][bj][m][1] * sc;
                    u32x4 w; w.x = pkbf(v0[0], v0[1]); w.y = pkbf(v0[2], v0[3]); w.z = pkbf(v1[0], v1[1]); w.w = pkbf(v1[2], v1[3]);
                    *(u32x4*)(rowp + bj * HALF) = w; } }
    }
};
template <int CTRL> __device__ __forceinline__ float dpp_mov(float old, float src) {
    return __builtin_bit_cast(float, __builtin_amdgcn_update_dpp(__builtin_bit_cast(int, old), __builtin_bit_cast(int, src), CTRL, 0xF, 0xF, false)); }
struct EpiFfn {
    static constexpr bool PERM = true, AFTER_DRAIN = false;
    bf16_t* act; const float* wconv; float* abnd; float* gbnd; PG8_LAS float* xch;
    __device__ __forceinline__ void operator()(const f32x4 (&acc)[2][2][4][2], const Unit& u, int wr, int wc, int fr, int fq) const {
        constexpr int FFW = 2816;
        const int cl = 32 * wc + 8 * fq, col8 = 128 * u.pn + cl;
        float w0[8], w1[8], w2[8];
        { const f32x4 a0 = *(const f32x4*)(wconv + col8), a1 = *(const f32x4*)(wconv + col8 + 4), b0 = *(const f32x4*)(wconv + FFW + col8), b1 = *(const f32x4*)(wconv + FFW + col8 + 4),
                      c0 = *(const f32x4*)(wconv + 2 * FFW + col8), c1 = *(const f32x4*)(wconv + 2 * FFW + col8 + 4);
#pragma unroll
          for (int i = 0; i < 4; ++i) { w0[i] = a0[i]; w0[4 + i] = a1[i]; w1[i] = b0[i]; w1[4 + i] = b1[i]; w2[i] = c0[i]; w2[4 + i] = c1[i]; } }
#pragma unroll
        for (int ai = 0; ai < 2; ++ai) { const int s = ai * 2 + wr;
            if (fr == 0) { *(PG8_LAS f32x4*)(xch + (s * 2 + 0) * 128 + cl) = acc[ai][0][0][0]; *(PG8_LAS f32x4*)(xch + (s * 2 + 0) * 128 + cl + 4) = acc[ai][0][0][1]; }
            if (fr == 15) { *(PG8_LAS f32x4*)(xch + (s * 2 + 1) * 128 + cl) = acc[ai][0][3][0]; *(PG8_LAS f32x4*)(xch + (s * 2 + 1) * 128 + cl + 4) = acc[ai][0][3][1]; } }
        asm volatile("s_waitcnt lgkmcnt(0)" ::: "memory"); __builtin_amdgcn_s_barrier(); asm volatile("" ::: "memory");
#pragma unroll
        for (int ai = 0; ai < 2; ++ai) { const int s = ai * 2 + wr;
            f32x4 up[2], dn[2];
#pragma unroll
            for (int n = 0; n < 2; ++n) { up[n] = s > 0 ? *(const PG8_LAS f32x4*)(xch + ((s - 1) * 2 + 1) * 128 + cl + 4 * n) : (f32x4){0.f, 0.f, 0.f, 0.f};
                                          dn[n] = s < 3 ? *(const PG8_LAS f32x4*)(xch + ((s + 1) * 2 + 0) * 128 + cl + 4 * n) : (f32x4){0.f, 0.f, 0.f, 0.f}; }
#pragma unroll
            for (int m = 0; m < 4; ++m) { const int row = u.pm * BM + ai * HALF + wr * 64 + m * 16 + fr; float o[8];
#pragma unroll
                for (int n = 0; n < 2; ++n)
#pragma unroll
                    for (int i = 0; i < 4; ++i) { const float cur = acc[ai][0][m][n][i];
                        const float pold = m > 0 ? dpp_mov<0x121>(0.f, acc[ai][0][m > 0 ? m - 1 : 0][n][i]) : up[n][i];
                        const float prev = dpp_mov<0x111>(pold, cur);
                        const float nold = m < 3 ? dpp_mov<0x12F>(0.f, acc[ai][0][m < 3 ? m + 1 : 3][n][i]) : dn[n][i];
                        const float next = dpp_mov<0x101>(nold, cur);
                        const float v = w0[4 * n + i] * prev + w1[4 * n + i] * cur + w2[4 * n + i] * next;
                        const float u2 = v * (-2.3022081981f + -0.1029432396f * v * v);
                        o[4 * n + i] = v * __builtin_amdgcn_rcpf(1.f + __builtin_amdgcn_exp2f(u2)) * acc[ai][1][m][n][i]; }
                const bool edge = (s == 0 && m == 0 && fr == 0) || (s == 3 && m == 3 && fr == 15);
                if (!edge) { u32x4 w; w.x = pkbf(o[0], o[1]); w.y = pkbf(o[2], o[3]); w.z = pkbf(o[4], o[5]); w.w = pkbf(o[6], o[7]); *(u32x4*)(act + (size_t)row * FFW + col8) = w; }
                if (s == 0 && m == 0 && fr < 2) { float* p = abnd + ((size_t)(u.pm * 4 + fr)) * FFW + col8; *(f32x4*)p = acc[ai][0][m][0]; *(f32x4*)(p + 4) = acc[ai][0][m][1];
                    if (fr == 0) { float* q = gbnd + ((size_t)(u.pm * 2 + 0)) * FFW + col8; *(f32x4*)q = acc[ai][1][m][0]; *(f32x4*)(q + 4) = acc[ai][1][m][1]; } }
                if (s == 3 && m == 3 && fr >= 14) { float* p = abnd + ((size_t)(u.pm * 4 + 2 + (fr - 14))) * FFW + col8; *(f32x4*)p = acc[ai][0][m][0]; *(f32x4*)(p + 4) = acc[ai][0][m][1];
                    if (fr == 15) { float* q = gbnd + ((size_t)(u.pm * 2 + 1)) * FFW + col8; *(f32x4*)q = acc[ai][1][m][0]; *(f32x4*)(q + 4) = acc[ai][1][m][1]; } }
            }
        }
    }
};
template <class Epi, class Sched, bool ALIGN_EPI = false, bool SP2 = false>
__device__ __forceinline__ void gemm_phase(PG8_LAS unsigned char* lds, const Gemm g, const Sched& S, const Epi& E) {
    const int tid = threadIdx.x, wid = __builtin_amdgcn_readfirstlane(tid >> 6), lane = tid & 63, wr = wid >> 2, wc = wid & 3, fr = lane & 15, fq = lane >> 4;
    const int K = g.K, nt = K / BK;
    unsigned voffA[2], voffB[2];
#pragma unroll
    for (int i = 0; i < 2; ++i) { int R, C; stage_rc(tid * 16 + i * 8192, R, C); const int Rb = Epi::PERM ? ((R & ~31) + perm32(R & 31)) : R;
        voffA[i] = (unsigned)(R * K + C) * 2u; voffB[i] = (unsigned)(Rb * K + C) * 2u; }
    const size_t kstep = (size_t)(BK * 2);
    const size_t hstep = (size_t)HALF * K * 2;
    const size_t tstep = 2 * hstep;
    const unsigned ldsw = (unsigned)wid * 1024u;
    const int aoff = lds_byte(wr * 64 + fr, fq * 8), boff = lds_byte(wc * 32 + fr, fq * 8);
#define PG8_SA(b, h) (((b) * 2 + (h)) * HTB)
#define PG8_SB(b, h) ((4 + (b) * 2 + (h)) * HTB)
#define PG8_STAGE(bufoff, gbase, voff) do { _Pragma("unroll") for (int _i = 0; _i < 2; ++_i) \
        __builtin_amdgcn_global_load_lds((const unsigned*)((const char*)(gbase) + (voff)[_i]), (PG8_LAS unsigned*)(lds + (bufoff) + ldsw + _i * 8192), 16, 0, 0); } while (0)
#define PG8_LDA(dst, b, h) do { _Pragma("unroll") for (int m = 0; m < 4; ++m) _Pragma("unroll") for (int k = 0; k < 2; ++k) dst[m][k] = *(const PG8_LAS bf16x8*)(lds + PG8_SA(b, h) + aoff + m * 2048 + k * 1024); } while (0)
#define PG8_LDB(dst, b, h) do { _Pragma("unroll") for (int n = 0; n < 2; ++n) _Pragma("unroll") for (int k = 0; k < 2; ++k) dst[n][k] = *(const PG8_LAS bf16x8*)(lds + PG8_SB(b, h) + boff + n * 2048 + k * 1024); } while (0)
#define PG8_MMA(ai, bj, At, Bt) do { __builtin_amdgcn_s_setprio(1); _Pragma("unroll") for (int m = 0; m < 4; ++m) _Pragma("unroll") for (int n = 0; n < 2; ++n) _Pragma("unroll") for (int k = 0; k < 2; ++k) \
        acc[ai][bj][m][n] = __builtin_amdgcn_mfma_f32_16x16x32_bf16(Bt[n][k], At[m][k], acc[ai][bj][m][n], 0, 0, 0); __builtin_amdgcn_s_setprio(0); } while (0)
#define PG8_WAIT_V(n) asm volatile("s_waitcnt vmcnt(" #n ")" ::: "memory")
#define PG8_WAIT_L(n) asm volatile("s_waitcnt lgkmcnt(" #n ")" ::: "memory")
#define PG8_BAR __builtin_amdgcn_s_barrier()
#define PG8_SCHED __builtin_amdgcn_sched_barrier(0)
    Unit cur, nxt; int ui = 0;
    if (!S.next(0, cur)) return;
    f32x4 acc[2][2][4][2];
#pragma unroll
    for (int a = 0; a < 2; ++a)
#pragma unroll
        for (int b = 0; b < 2; ++b)
#pragma unroll
            for (int m = 0; m < 4; ++m)
#pragma unroll
                for (int n = 0; n < 2; ++n) acc[a][b][m][n] = (f32x4){0.f, 0.f, 0.f, 0.f};
    bf16x8 At[4][2], B0[2][2], B1[2][2];
    const char* cA = (const char*)g.A + (size_t)cur.pm * tstep; const char* cB = (const char*)g.Bt + (size_t)cur.pn * tstep;
    S.a_ready(cur);
    if constexpr (SP2) {
        PG8_STAGE(PG8_SB(0, 0), cB, voffB); PG8_STAGE(PG8_SB(0, 1), cB + hstep, voffB); PG8_STAGE(PG8_SA(0, 0), cA, voffA); PG8_STAGE(PG8_SA(0, 1), cA + hstep, voffA);
        if (wr == 1) PG8_BAR;
        PG8_WAIT_V(2); PG8_BAR;
        PG8_STAGE(PG8_SB(1, 0), cB + kstep, voffB); PG8_STAGE(PG8_SA(1, 0), cA + kstep, voffA); PG8_STAGE(PG8_SB(1, 1), cB + hstep + kstep, voffB);
        PG8_WAIT_V(6); PG8_BAR;
    } else {
        PG8_STAGE(PG8_SB(0, 0), cB, voffB); PG8_STAGE(PG8_SA(0, 0), cA, voffA); PG8_STAGE(PG8_SB(0, 1), cB + hstep, voffB); PG8_STAGE(PG8_SA(0, 1), cA + hstep, voffA);
        if (wr == 1) PG8_BAR;
        PG8_WAIT_V(4); PG8_BAR;
        PG8_STAGE(PG8_SB(1, 0), cB + kstep, voffB); PG8_STAGE(PG8_SA(1, 0), cA + kstep, voffA); PG8_STAGE(PG8_SB(1, 1), cB + hstep + kstep, voffB);
        PG8_WAIT_V(6); PG8_BAR;
    }
    for (;;) {
        const bool has_next = S.next(ui + 1, nxt);
        const char* nA = has_next ? (const char*)g.A + (size_t)nxt.pm * tstep : cA; const char* nB = has_next ? (const char*)g.Bt + (size_t)nxt.pn * tstep : cB;
        for (int t = 0; t < nt; t += 2) {
            const bool last = (t == nt - 2);
            const char* a1 = cA + (size_t)(t + 1) * kstep;
            const char* a2 = last ? nA : cA + (size_t)(t + 2) * kstep; const char* b2 = last ? nB : cB + (size_t)(t + 2) * kstep;
            const char* a3 = a2 + kstep; const char* b3 = b2 + kstep;
            if (last && has_next) S.a_ready(nxt);
            if constexpr (SP2) {
            PG8_LDB(B0, 0, 0); PG8_LDB(B1, 0, 1); PG8_SCHED; PG8_LDA(At, 0, 0); PG8_STAGE(PG8_SA(1, 1), a1 + hstep, voffA);
            PG8_WAIT_V(8); PG8_WAIT_L(0); PG8_BAR; PG8_MMA(0, 0, At, B0); PG8_MMA(0, 1, At, B1); PG8_BAR; PG8_SCHED;
            PG8_LDA(At, 0, 1); PG8_STAGE(PG8_SB(0, 0), b2, voffB); PG8_STAGE(PG8_SB(0, 1), b2 + hstep, voffB); PG8_STAGE(PG8_SA(0, 0), a2, voffA);
            PG8_WAIT_V(8); PG8_WAIT_L(0); PG8_BAR; PG8_MMA(1, 0, At, B0); PG8_MMA(1, 1, At, B1); PG8_BAR; PG8_SCHED;
            PG8_LDB(B0, 1, 0); PG8_LDB(B1, 1, 1); PG8_SCHED; PG8_LDA(At, 1, 0); PG8_STAGE(PG8_SA(0, 1), a2 + hstep, voffA);
            PG8_WAIT_V(8); PG8_WAIT_L(0); PG8_BAR; PG8_MMA(0, 0, At, B0); PG8_MMA(0, 1, At, B1); PG8_BAR; PG8_SCHED;
            PG8_LDA(At, 1, 1); PG8_STAGE(PG8_SB(1, 0), b3, voffB); PG8_STAGE(PG8_SB(1, 1), b3 + hstep, voffB); PG8_STAGE(PG8_SA(1, 0), a3, voffA);
            PG8_WAIT_V(8); PG8_WAIT_L(0); PG8_BAR; PG8_MMA(1, 0, At, B0); PG8_MMA(1, 1, At, B1); PG8_BAR; PG8_SCHED;
            } else {
            PG8_LDB(B0, 0, 0); PG8_SCHED; PG8_LDA(At, 0, 0); PG8_STAGE(PG8_SA(1, 1), a1 + hstep, voffA);
            PG8_WAIT_L(8); PG8_BAR; PG8_WAIT_L(0); PG8_MMA(0, 0, At, B0); PG8_BAR; PG8_SCHED;
            PG8_LDB(B1, 0, 1); PG8_STAGE(PG8_SB(0, 0), b2, voffB);
            PG8_BAR; PG8_WAIT_L(0); PG8_MMA(0, 1, At, B1); PG8_BAR;
            PG8_LDA(At, 0, 1); PG8_STAGE(PG8_SA(0, 0), a2, voffA);
            PG8_BAR; PG8_WAIT_L(0); PG8_MMA(1, 0, At, B0); PG8_BAR; PG8_SCHED;
            PG8_STAGE(PG8_SB(0, 1), b2 + hstep, voffB);
            PG8_WAIT_V(6); PG8_BAR; PG8_MMA(1, 1, At, B1); PG8_BAR;
            PG8_LDB(B0, 1, 0); PG8_SCHED; PG8_LDA(At, 1, 0); PG8_STAGE(PG8_SA(0, 1), a2 + hstep, voffA);
            PG8_WAIT_L(8); PG8_BAR; PG8_WAIT_L(0); PG8_MMA(0, 0, At, B0); PG8_BAR; PG8_SCHED;
            PG8_LDB(B1, 1, 1); PG8_STAGE(PG8_SB(1, 0), b3, voffB);
            PG8_BAR; PG8_WAIT_L(0); PG8_MMA(0, 1, At, B1); PG8_BAR;
            PG8_LDA(At, 1, 1); PG8_STAGE(PG8_SA(1, 0), a3, voffA);
            PG8_BAR; PG8_WAIT_L(0); PG8_MMA(1, 0, At, B0); PG8_BAR; PG8_SCHED;
            PG8_STAGE(PG8_SB(1, 1), b3 + hstep, voffB);
            PG8_WAIT_V(6); PG8_BAR; PG8_MMA(1, 1, At, B1); PG8_BAR;
            }
        }
        if constexpr (ALIGN_EPI) { if (wr == 0) PG8_BAR; }
        if constexpr (!Epi::AFTER_DRAIN) { E(acc, cur, wr, wc, fr, fq); S.done(cur); }
        if (!has_next) break;
#pragma unroll
        for (int a = 0; a < 2; ++a)
#pragma unroll
            for (int b = 0; b < 2; ++b)
#pragma unroll
                for (int m = 0; m < 4; ++m)
#pragma unroll
                    for (int n = 0; n < 2; ++n) acc[a][b][m][n] = (f32x4){0.f, 0.f, 0.f, 0.f};
        cur = nxt; cA = nA; cB = nB; ++ui;
        if constexpr (ALIGN_EPI) { if (wr == 1) PG8_BAR; }
    }
    PG8_WAIT_V(0);
    if constexpr (!ALIGN_EPI) { if (wr == 0) PG8_BAR; }
    PG8_BAR;
    if constexpr (Epi::AFTER_DRAIN) { E.fused(acc, cur, wr, wc, fr, fq, lds, wid, lane); S.done(cur); }
#undef PG8_SA
#undef PG8_SB
#undef PG8_STAGE
#undef PG8_LDA
#undef PG8_LDB
#undef PG8_MMA
#undef PG8_WAIT_V
#undef PG8_WAIT_L
#undef PG8_BAR
#undef PG8_SCHED
}
}
#define GAS __attribute__((address_space(1)))
#define LAS __attribute__((address_space(3)))
#define DI __device__ __forceinline__
typedef unsigned short bf16;
typedef float f32x2 __attribute__((ext_vector_type(2)));
typedef float f32x4 __attribute__((ext_vector_type(4)));
typedef float f32x16 __attribute__((ext_vector_type(16)));
typedef short bf16x8 __attribute__((ext_vector_type(8)));
typedef unsigned u32x2 __attribute__((ext_vector_type(2)));
typedef unsigned u32x4 __attribute__((ext_vector_type(4)));
#define MFMA32(a, b, c) __builtin_amdgcn_mfma_f32_32x32x16_bf16((a), (b), (c), 0, 0, 0)

#ifndef MK_ONE_LAUNCH
#define MK_ONE_LAUNCH 1
#endif
namespace mk {
constexpr int NWAVES = 8, NTHR = 512;
constexpr int D = 1024, M = 12288, MPR = 4096;
constexpr int NPROJ = 3840, FF = 2816;
constexpr float EPS = 1e-6f;
constexpr int NPHASES = 18;
constexpr size_t OFF_C = 12582912, OFF_N = 14680064, OFF_MM = 14696448, OFF_K = 14696576, OFF_V = 18890880;
constexpr size_t MiB = 1u << 20;
constexpr size_t WS_CTL = 0, CTL_ZERO_BYTES = 1 * MiB;
constexpr size_t WS_MODP = 105 * MiB;
constexpr size_t WS_MODF = 5 * MiB;
constexpr size_t WS_GATES = 6 * MiB;
constexpr size_t WS_AS = 7 * MiB, WS_MS = 7 * MiB + 512 * 1024, WS_BS = 8 * MiB;
constexpr size_t WS_H2 = 10 * MiB;
constexpr size_t WS_NS = 9 * MiB;
constexpr size_t WS_R2048 = 12 * MiB;
constexpr size_t WS_R256 = 16 * MiB;
constexpr size_t WS_CK = 22 * MiB, WS_CV = 26 * MiB;
constexpr size_t WS_WAB = 30 * MiB, WS_WOAB = 38 * MiB, WS_WC = 40 * MiB, WS_WOC = 46 * MiB, WS_WUP = 48 * MiB, WS_WDN = 70 * MiB;
constexpr size_t WS_H = 81 * MiB;
constexpr size_t WS_BIG = 105 * MiB;
constexpr size_t WS_PROJ = WS_BIG;
constexpr size_t WS_QB = 195 * MiB, WS_KB = 207 * MiB;
constexpr size_t WS_UT = 219 * MiB;
constexpr size_t WS_X2T = 231 * MiB;
constexpr size_t WS_FG = 171 * MiB;
constexpr size_t WS_ABND = 140 * MiB, WS_GBND = 144 * MiB;
constexpr size_t WS_Q1 = WS_BIG, WS_K1 = 129 * MiB, WS_V1 = 153 * MiB;
constexpr size_t WS_DL = WS_BIG;
constexpr size_t WS_END = 256 * MiB;
constexpr int CW_BAR = 4096;
constexpr int RING_BYTES = 131072, LDSCTL_OFF = RING_BYTES, MISC_OFF = LDSCTL_OFF + 320, XCH_OFF = RING_BYTES + 1024, LDS_BYTES = 147456;

DI float bf2f(unsigned short b) { return __uint_as_float((unsigned)b << 16); }
DI unsigned pk2(float lo, float hi) { return pg8::pkbf(lo, hi); }
DI void unpack8(const u32x4 v, float (&f)[8]) {
    f[0] = __uint_as_float(v.x << 16); f[1] = __uint_as_float(v.x & 0xffff0000u); f[2] = __uint_as_float(v.y << 16); f[3] = __uint_as_float(v.y & 0xffff0000u);
    f[4] = __uint_as_float(v.z << 16); f[5] = __uint_as_float(v.z & 0xffff0000u); f[6] = __uint_as_float(v.w << 16); f[7] = __uint_as_float(v.w & 0xffff0000u); }
DI u32x4 pack8(const float (&f)[8]) { u32x4 w; w.x = pk2(f[0], f[1]); w.y = pk2(f[2], f[3]); w.z = pk2(f[4], f[5]); w.w = pk2(f[6], f[7]); return w; }
DI float rcp_f(float x) { return __builtin_amdgcn_rcpf(x); }
DI float exp2_f(float x) { return __builtin_amdgcn_exp2f(x); }
DI float silu_f(float x) { return x * rcp_f(1.f + exp2_f(-1.4426950408889634f * x)); }
DI float sigm_f(float x) { return rcp_f(1.f + exp2_f(-1.4426950408889634f * x)); }
DI float gelu_tanh_f(float x) { const float u2 = x * (-2.3022081986f + -0.1029432396f * x * x); return x * rcp_f(1.f + exp2_f(u2)); }
DI float logsig_f(float x) { return fminf(x, 0.f) - log1pf(__expf(-fabsf(x))); }
DI float wave_sum(float v) {
#pragma unroll
    for (int o = 1; o < 64; o <<= 1) v += __shfl_xor(v, o);
    return v; }
#define LDS_WAIT() asm volatile("s_waitcnt lgkmcnt(0)" ::: "memory")

#define XB_TMO      128
#define XB_XCNT(j)  (256  + 64 * (j))
#define XB_XSUB(j)  (1280 + 64 * (j))
#define XB_XGEN(j)  (2304 + 64 * (j))
#define XB_TOP      3328
#define XB_TOPGEN   3392
#define XCD_BAR_WORDS 3456
#define XB_SPIN_CAP (1u << 20)
DI unsigned xb_ld(unsigned* p)              { return __hip_atomic_load(p, __ATOMIC_RELAXED, __HIP_MEMORY_SCOPE_AGENT); }
DI unsigned xb_add(unsigned* p, unsigned v) { return __hip_atomic_fetch_add(p, v, __ATOMIC_RELAXED, __HIP_MEMORY_SCOPE_AGENT); }
DI unsigned xb_xcc_id() { return (unsigned)__builtin_amdgcn_s_getreg((3 << 11) | 20) & 0xFu; }
#define XB_SPIN(cond, bar) do { unsigned _sp = 0; while (cond) { __builtin_amdgcn_s_sleep(1); \
    if ((++_sp & 255u) == 0u) { if (xb_ld(&(bar)[XB_TMO])) break; if (_sp > XB_SPIN_CAP) { atomicAdd(&(bar)[XB_TMO], 1u); break; } } } } while (0)
struct XcdBarrier { unsigned* bar; unsigned x; volatile LAS unsigned* st; };
DI XcdBarrier xcd_barrier_post(unsigned* bar, volatile LAS unsigned* st) {
    XcdBarrier b; b.bar = bar; b.x = xb_xcc_id(); b.st = st;
    if (threadIdx.x == 0) (void)xb_add(&bar[XB_XCNT(b.x)], 1u);
    return b;
}
DI void xcd_barrier_complete(unsigned* bar, unsigned x, unsigned& nloc, unsigned& nx) {
    const unsigned G = gridDim.x * gridDim.y * gridDim.z;
    unsigned sum, cnt, mine, sp = 0u;
    for (;;) {
        sum = 0u; cnt = 0u; mine = 0u;
#pragma unroll
        for (unsigned j = 0; j < 16; ++j) { const unsigned c = xb_ld(&bar[XB_XCNT(j)]); sum += c; cnt += (c > 0u) ? 1u : 0u; mine = (j == x) ? c : mine; }
        if (sum == G) break;
        __builtin_amdgcn_s_sleep(1);
        if ((++sp & 255u) == 0u) { if (xb_ld(&bar[XB_TMO])) break; if (sp > XB_SPIN_CAP) { atomicAdd(&bar[XB_TMO], 1u); break; } }
    }
    nloc = mine > 0u ? mine : 1u; nx = cnt > 0u ? cnt : 1u;
}
DI void xcd_barrier(const XcdBarrier& b) {
    asm volatile("s_waitcnt vmcnt(0)" ::: "memory");
    __syncthreads();
    if (threadIdx.x == 0) {
        unsigned* bar = b.bar;
        __builtin_amdgcn_s_waitcnt(0);
        unsigned nloc = b.st[0], nx = b.st[1];
        if (nloc == 0u) { xcd_barrier_complete(bar, b.x, nloc, nx); b.st[0] = nloc; b.st[1] = nx; }
        const unsigned old = xb_add(&bar[XB_XSUB(b.x)], 1u);
        const unsigned gen = old / nloc;
        if (old + 1u == (gen + 1u) * nloc) {
            __builtin_amdgcn_fence(__ATOMIC_RELEASE, "agent");
            asm volatile("s_waitcnt vmcnt(0)" ::: "memory");
            const unsigned og = xb_add(&bar[XB_TOP], 1u);
            const unsigned tg = og / nx;
            if (og + 1u == (tg + 1u) * nx) xb_add(&bar[XB_TOPGEN], 1u);
            else XB_SPIN(xb_ld(&bar[XB_TOPGEN]) == tg, bar);
            __builtin_amdgcn_fence(__ATOMIC_ACQUIRE, "agent");
            xb_add(&bar[XB_XGEN(b.x)], 1u);
            asm volatile("s_waitcnt vmcnt(0)" ::: "memory");
        } else {
            XB_SPIN(xb_ld(&bar[XB_XGEN(b.x)]) == gen, bar);
            __builtin_amdgcn_fence(__ATOMIC_ACQUIRE, "agent");
            asm volatile("s_waitcnt vmcnt(0)" ::: "memory");
        }
    }
    __syncthreads();
}

struct Args { const float* in[33]; float* out; unsigned char* ws; int ph_lo, ph_hi; };
enum { I_XP = 0, I_XS, I_STC, I_STN, I_STM, I_CK, I_CV, I_C, I_CCTX, I_WADA, I_BADA, I_GMIX, I_GFFN, I_GFIN, I_WINAB, I_BGATES, I_WCQK, I_GMLSTM, I_WCHY,
       I_WF1, I_BF1, I_WF2, I_BF2, I_WF3, I_FREQ, I_HYB, I_WOUTAB, I_WINC, I_RPB, I_WOUTC, I_WUP, I_WCFFN, I_WDOWN };

DI void row_seq(int row, int& base, int& L) { if (row < MPR) { base = row & ~255; L = 256; } else { base = MPR + ((row - MPR) & ~2047); L = 2048; } }
DI int row_vec(int row) { return row < MPR ? 4 : ((row - MPR) >> 11); }
template <bool FFN_PERM = false> DI void p0_transpose_tile(const float* W, int K, int N, int Npad, bf16* WT, LAS float* T, int item, int tid) {
    const int nblk = Npad / 256, kb = item / nblk, nb = item % nblk, k0 = 64 * kb, n0 = 256 * nb;
    __syncthreads();
    { const int col = n0 + (tid & 63) * 4; const bool ok = col < N; const float* src = W + (size_t)k0 * N + col;
      f32x4 v[8];
#pragma unroll
      for (int i = 0; i < 8; ++i) { const int kk = i * 8 + (tid >> 6); v[i] = ok ? *(const f32x4*)(src + (size_t)kk * N) : (f32x4){0.f, 0.f, 0.f, 0.f}; }
#pragma unroll
      for (int i = 0; i < 8; ++i) { const int kk = i * 8 + (tid >> 6); *(LAS f32x4*)(T + kk * 260 + (tid & 63) * 4) = v[i]; } }
    __syncthreads();
#pragma unroll
    for (int j = 0; j < 4; ++j) { const int n = tid & 255, kg = (tid >> 8) + 2 * j; const LAS float* p = T + (8 * kg) * 260 + n;
        u32x4 o; o.x = pk2(p[0], p[260]); o.y = pk2(p[520], p[780]); o.z = pk2(p[1040], p[1300]); o.w = pk2(p[1560], p[1820]);
        int dr = n0 + n;
        if (FFN_PERM) { const int gsel = dr >= 2816, c = gsel ? dr - 2816 : dr; dr = (c >> 7) * 256 + gsel * 128 + (c & 127); }
        *(u32x4*)(WT + (size_t)dr * K + k0 + 8 * kg) = o; }
}
DI void p0_filter_stage1(const Args& a, int L, int p0, int gcol0, float* H2, LAS float* T, int tid, int lane, int wave) {
    const float* b1 = a.in[I_BF1]; const float* b2 = a.in[I_BF2]; const float* fr = a.in[I_FREQ];
    LAS float* w1s = T; LAS float* w2s = T + 2112; LAS float* hs = T + 2112 + 4096;
    __syncthreads();
    for (int i = tid; i < 2112; i += NTHR) w1s[i] = a.in[I_WF1][i];
    for (int i = tid; i < 4096; i += NTHR) w2s[i] = a.in[I_WF2][i];
    __syncthreads();
    const int p = p0 + lane; const float tpos = (float)p / (float)(L - 1), wrev = (float)p / (float)L;
    float z[33]; z[0] = tpos;
#pragma unroll
    for (int k = 0; k < 16; ++k) { const float band = 1e-4f + (float)k * ((15.0f - 1e-4f) / 15.0f); const float rv = band * wrev; const float ph = 6.283185307179586f * (rv - floorf(rv));
        z[1 + k] = __cosf(ph); z[17 + k] = -__sinf(ph); }
#pragma unroll
    for (int jj = 0; jj < 8; ++jj) { const int j = 8 * wave + jj; float t = b1[j];
#pragma unroll
        for (int i = 0; i < 33; ++i) t += z[i] * w1s[i * 64 + j];
        hs[j * 64 + lane] = sinf(fr[j] * t); }
    __syncthreads();
    float acc[8];
#pragma unroll
    for (int jj = 0; jj < 8; ++jj) acc[jj] = b2[8 * wave + jj];
#pragma unroll 8
    for (int i = 0; i < 64; ++i) { const float hv = hs[i * 64 + lane]; const LAS float* wr = w2s + i * 64 + 8 * wave;
#pragma unroll
        for (int jj = 0; jj < 8; ++jj) acc[jj] += hv * wr[jj]; }
#pragma unroll
    for (int jj = 0; jj < 8; ++jj) { const int j = 8 * wave + jj; H2[(size_t)j * 2304 + gcol0 + lane] = sinf(fr[j] * acc[jj]); }
}
DI void p1_filter_stage2(const Args& a, int L, int p0, int gcol0, int cb, const float* H2, bf16* R, LAS float* w3t, int lane) {
    const float* w3 = a.in[I_WF3];
    const int p = p0 + lane; const float tpos = (float)p / (float)(L - 1);
    float h2[64];
#pragma unroll
    for (int i = 0; i < 64; ++i) h2[i] = H2[(size_t)i * 2304 + gcol0 + lane];
#pragma unroll
    for (int r = 0; r < 16; ++r) { const int i = (lane >> 4) + 4 * r; w3t[(lane & 15) * 64 + i] = w3[i * 1024 + cb * 16 + (lane & 15)]; }
    LDS_WAIT(); asm volatile("" ::: "memory");
    const float mind = -3.0701134573f, maxd = -15.3505672866f;
#pragma unroll 2
    for (int cc = 0; cc < 16; ++cc) { const int c = cb * 16 + cc, c5 = c & 511; float t0 = 0.f, t1 = 0.f, t2 = 0.f, t3 = 0.f;
#pragma unroll
        for (int q = 0; q < 16; ++q) { const f32x4 w = *(const LAS f32x4*)(w3t + cc * 64 + 4 * q); t0 += h2[4 * q] * w[0]; t1 += h2[4 * q + 1] * w[1]; t2 += h2[4 * q + 2] * w[2]; t3 += h2[4 * q + 3] * w[3]; }
        const float delta = fabsf(mind + (float)c5 * ((maxd - mind) / 511.0f)); const float v = ((t0 + t1) + (t2 + t3)) * __expf(-tpos * delta);
        const bf16 vb = (bf16)(pk2(v, 0.f) & 0xffffu);
        if (c < 512) { R[(size_t)c * (2 * L) + (L - p)] = vb; if (p == 0) R[(size_t)c * (2 * L)] = 0; }
        else if (p >= 1) R[(size_t)c5 * (2 * L) + (L + p)] = vb; }
    LDS_WAIT(); asm volatile("" ::: "memory");
}
DI void bg_convert(const Args& a, LAS unsigned char* lds, int set, int widx, int nw, int tid) {
    unsigned char* ws = a.ws; LAS float* T = (LAS float*)lds;
    constexpr int I2 = 16 * 12, I3 = 16 * 4, I4 = 16 * 22, I5 = 44 * 4;
    if (set == 0) { for (int r = widx; r < I4; r += nw) p0_transpose_tile<true>(a.in[I_WUP], 1024, 5632, 5632, (bf16*)(ws + WS_WUP), T, r, tid); }
    else if (set == 1) { for (int r = widx; r < I5; r += nw) p0_transpose_tile(a.in[I_WDOWN], 2816, 1024, 1024, (bf16*)(ws + WS_WDN), T, r, tid); }
    else if (set == 2) { for (int r = widx; r < I2 + I3; r += nw) {
            if (r < I2) p0_transpose_tile(a.in[I_WINC], 1024, 3072, 3072, (bf16*)(ws + WS_WC), T, r, tid);
            else p0_transpose_tile(a.in[I_WOUTC], 1024, 1024, 1024, (bf16*)(ws + WS_WOC), T, r - I2, tid); } }
    else { for (int r = widx; r < I4 + I5; r += nw) {
            if (r < I4) p0_transpose_tile<true>(a.in[I_WUP] + (size_t)1024 * 5632, 1024, 5632, 5632, (bf16*)(ws + WS_WUP) + (size_t)5632 * 1024, T, r, tid);
            else p0_transpose_tile(a.in[I_WDOWN] + (size_t)2816 * 1024, 2816, 1024, 1024, (bf16*)(ws + WS_WDN) + (size_t)1024 * 2816, T, r - I4, tid); } }
    __syncthreads();
}
DI void ph_prologue(const Args& a, LAS unsigned char* lds, int tid, int lane, int wave, int bid, int G) {
    unsigned char* ws = a.ws;
    constexpr int NF1 = 36, NA = 192, I0 = 16 * 15, I1 = 16 * 4, NT = I0 + I1;
    LAS float* T = (LAS float*)lds;
#ifndef MK_P0A
#define MK_P0A 1
#define MK_P0T 1
#define MK_P0F 1
#endif
    for (int rep_ = 0; rep_ < (MK_P0A > MK_P0T ? (MK_P0A > MK_P0F ? MK_P0A : MK_P0F) : (MK_P0T > MK_P0F ? MK_P0T : MK_P0F)); ++rep_)
    for (int it0 = bid; it0 < NF1 + NA + NT; it0 += G) {
        if (it0 < NF1) { if (rep_ < MK_P0F) p0_filter_stage1(a, it0 < 32 ? 2048 : 256, it0 < 32 ? 64 * it0 : 64 * (it0 - 32), 64 * it0, (float*)(ws + WS_H2), T, tid, lane, wave); continue; }
        const int it = it0 - NF1;
        if (it < NA ? rep_ >= MK_P0A : rep_ >= MK_P0T) continue;
        if (it < NA) {
            const int l = it / 96, rem = it % 96, cb = rem >> 5, ks = rem & 31;
            __syncthreads();
            if (tid < 160) { const int v = tid >> 5, k = tid & 31; const float cv = v < 4 ? a.in[I_C][v * 1024 + ks * 32 + k] : a.in[I_CCTX][ks * 32 + k]; T[tid] = silu_f(cv); }
            __syncthreads();
            const int col = cb * 2048 + tid * 4; const float* w = a.in[I_WADA] + ((size_t)(l * 1024 + ks * 32)) * 6144 + col;
            f32x4 a0 = {0.f, 0.f, 0.f, 0.f}, a1 = a0, a2 = a0, a3 = a0, a4 = a0;
#pragma unroll
            for (int kb = 0; kb < 2; ++kb) { f32x4 wv[16];
#pragma unroll
                for (int k = 0; k < 16; ++k) wv[k] = *(const f32x4*)(w + (size_t)(16 * kb + k) * 6144);
#pragma unroll
                for (int k = 0; k < 16; ++k) { const int kk = 16 * kb + k; a0 += wv[k] * T[kk]; a1 += wv[k] * T[32 + kk]; a2 += wv[k] * T[64 + kk]; a3 += wv[k] * T[96 + kk]; a4 += wv[k] * T[128 + kk]; } }
            float* o = (float*)(ws + WS_MODP) + ((size_t)((ks * 2 + l) * 5)) * 6144 + col;
            *(f32x4*)o = a0; *(f32x4*)(o + 6144) = a1; *(f32x4*)(o + 2 * 6144) = a2; *(f32x4*)(o + 3 * 6144) = a3; *(f32x4*)(o + 4 * 6144) = a4;
            continue;
        }
        int r = it - NA;
        if (r < I0) { p0_transpose_tile(a.in[I_WINAB], 1024, 3600, 3840, (bf16*)(ws + WS_WAB), T, r, tid); continue; } r -= I0;
        p0_transpose_tile(a.in[I_WOUTAB], 1024, 1024, 1024, (bf16*)(ws + WS_WOAB), T, r, tid);
    }
    __syncthreads();
    { const int gt = bid * NTHR + tid, NGT = G * NTHR;
      for (int i = gt; i < 2 * 262144; i += NGT) { const int which = i >= 262144, j = which ? i - 262144 : i;
        const float* src = a.in[which ? I_CV : I_CK] + (size_t)j * 8; bf16* dst = (bf16*)(ws + (which ? WS_CV : WS_CK)) + (size_t)j * 8;
        const f32x4 x0 = *(const f32x4*)src, x1 = *(const f32x4*)(src + 4);
        u32x4 o; o.x = pk2(x0[0], x0[1]); o.y = pk2(x0[2], x0[3]); o.z = pk2(x1[0], x1[1]); o.w = pk2(x1[2], x1[3]); *(u32x4*)dst = o; } }
}
DI void ph_modf_norm0(const Args& a, LAS unsigned char* lds, int tid, int lane, int wave, int bid, int G) {
    const float* modP = (const float*)(a.ws + WS_MODP); float* modF = (float*)(a.ws + WS_MODF); const float* bada = a.in[I_BADA];
    for (int i = bid * NTHR + tid; i < 2 * 5 * 6144; i += G * NTHR) { const int l = i / 30720, rem = i % 30720, v = rem / 6144, col = rem % 6144;
        float s = bada[l * 6144 + col];
#pragma unroll 8
        for (int ks = 0; ks < 32; ++ks) s += modP[((size_t)((ks * 2 + l) * 5 + v)) * 6144 + col];
        modF[i] = s; }
    const int rpw = (M + G - 1) / G, r0 = rpw * bid, r1 = (r0 + rpw < M) ? r0 + rpw : M;
    LAS float* shs = (LAS float*)lds;
    for (int v = 0; v < 5; ++v) {
        const bool need = r0 < r1 && (v == 4 ? (r0 < MPR) : (r1 > MPR && ((r0 > MPR ? r0 : MPR) - MPR) >> 11 <= v && v <= ((r1 - 1 - MPR) >> 11)));
        if (!need) continue;
        { const int i = tid; const int ch = i >> 8, c4 = (i & 255) * 4;
            f32x4 s = *(const f32x4*)(bada + ch * 1024 + c4);
#pragma unroll 8
            for (int ks = 0; ks < 32; ++ks) s += *(const f32x4*)(modP + ((size_t)((ks * 2 + 0) * 5 + v)) * 6144 + ch * 1024 + c4);
            *(LAS f32x4*)(shs + (v * 2 + ch) * 1024 + c4) = s; }
    }
    const int NGW = G * NWAVES;
    for (int it = wave * G + bid; it < 2304; it += NGW) { const int pg = it >> 6, cb = it & 63;
        p1_filter_stage2(a, pg < 32 ? 2048 : 256, pg < 32 ? 64 * pg : 64 * (pg - 32), 64 * pg, cb, (const float*)(a.ws + WS_H2), (bf16*)(a.ws + (pg < 32 ? WS_R2048 : WS_R256)), (LAS float*)(lds + 65536 + wave * 4096), lane); }
    __syncthreads();
    { const float* xsB = a.in[I_XS] - (size_t)MPR * D; const float* gvec = a.in[I_GMIX]; bf16* hbuf = (bf16*)(a.ws + WS_H);
        for (int row = r0 + wave; row < r1; row += NWAVES) {
            const float* xr = (row < MPR ? a.in[I_XP] : xsB) + (size_t)row * D; const int slot = row_vec(row);
            f32x4 x[4]; float ss = 0.f;
#pragma unroll
            for (int j = 0; j < 4; ++j) { x[j] = *(const f32x4*)(xr + 4 * lane + 256 * j); ss += (x[j][0] * x[j][0] + x[j][1] * x[j][1]) + (x[j][2] * x[j][2] + x[j][3] * x[j][3]); }
            const float rstd = rsqrtf(wave_sum(ss) * (1.f / D) + EPS);
#pragma unroll
            for (int j = 0; j < 4; ++j) { const int col = 4 * lane + 256 * j; const f32x4 g = *(const f32x4*)(gvec + col), sh = *(const LAS f32x4*)(shs + (slot * 2 + 0) * 1024 + col), sc = *(const LAS f32x4*)(shs + (slot * 2 + 1) * 1024 + col);
                const f32x4 y = x[j] * rstd * g * (sc + 1.f) + sh; u32x2 o; o.x = pk2(y[0], y[1]); o.y = pk2(y[2], y[3]); *(u32x2*)(hbuf + (size_t)row * D + col) = o; }
        }
    }
}
DI void ph_norm(const float* xA, const float* xB, const bf16* delta, float* xout, const float* gvec, const float* mod5  , int chS, int chC, bf16* hbuf, int gw, int NGW, int lane) {
    for (int row0 = gw; row0 < M; row0 += 2 * NGW) {
        f32x4 x[2][4]; u32x2 dq[2][4];
#pragma unroll
        for (int r = 0; r < 2; ++r) { const int row = row0 + r * NGW; if (row < M) { const float* xr = (row < MPR ? xA : xB) + (size_t)row * D;
#pragma unroll
            for (int j = 0; j < 4; ++j) { x[r][j] = *(const f32x4*)(xr + 4 * lane + 256 * j); if (delta) dq[r][j] = *(const u32x2*)(delta + (size_t)row * D + 4 * lane + 256 * j); } } }
#pragma unroll
        for (int r = 0; r < 2; ++r) { const int row = row0 + r * NGW; if (row < M) { const int v = row_vec(row);
            const float* shp = mod5 + (size_t)v * 6144 + chS * 1024; const float* scp = mod5 + (size_t)v * 6144 + chC * 1024; float ss = 0.f;
            if (delta) {
#pragma unroll
                for (int j = 0; j < 4; ++j) { x[r][j][0] += __uint_as_float(dq[r][j].x << 16); x[r][j][1] += __uint_as_float(dq[r][j].x & 0xffff0000u); x[r][j][2] += __uint_as_float(dq[r][j].y << 16); x[r][j][3] += __uint_as_float(dq[r][j].y & 0xffff0000u);
                    *(f32x4*)(xout + (size_t)row * D + 4 * lane + 256 * j) = x[r][j]; } }
#pragma unroll
            for (int j = 0; j < 4; ++j) ss += (x[r][j][0] * x[r][j][0] + x[r][j][1] * x[r][j][1]) + (x[r][j][2] * x[r][j][2] + x[r][j][3] * x[r][j][3]);
            const float rstd = rsqrtf(wave_sum(ss) * (1.f / D) + EPS);
#pragma unroll
            for (int j = 0; j < 4; ++j) { const int col = 4 * lane + 256 * j; const f32x4 g = *(const f32x4*)(gvec + col), sh = *(const f32x4*)(shp + col), sc = *(const f32x4*)(scp + col);
                const f32x4 y = x[r][j] * rstd * g * (sc + 1.f) + sh; u32x2 o; o.x = pk2(y[0], y[1]); o.y = pk2(y[2], y[3]); *(u32x2*)(hbuf + (size_t)row * D + col) = o; } } }
    }
}
DI void ph_final_norm(float* out, const bf16* delta, const float* gvec, int gw, int NGW, int lane) {
    for (int row0 = gw; row0 < M; row0 += 2 * NGW) {
        f32x4 x[2][4]; u32x2 dq[2][4];
#pragma unroll
        for (int r = 0; r < 2; ++r) { const int row = row0 + r * NGW; if (row < M) {
#pragma unroll
            for (int j = 0; j < 4; ++j) { x[r][j] = *(const f32x4*)(out + (size_t)row * D + 4 * lane + 256 * j); dq[r][j] = *(const u32x2*)(delta + (size_t)row * D + 4 * lane + 256 * j); } } }
#pragma unroll
        for (int r = 0; r < 2; ++r) { const int row = row0 + r * NGW; if (row < M) { float ss = 0.f;
#pragma unroll
            for (int j = 0; j < 4; ++j) { x[r][j][0] += __uint_as_float(dq[r][j].x << 16); x[r][j][1] += __uint_as_float(dq[r][j].x & 0xffff0000u); x[r][j][2] += __uint_as_float(dq[r][j].y << 16); x[r][j][3] += __uint_as_float(dq[r][j].y & 0xffff0000u);
                ss += (x[r][j][0] * x[r][j][0] + x[r][j][1] * x[r][j][1]) + (x[r][j][2] * x[r][j][2] + x[r][j][3] * x[r][j][3]); }
            const float rstd = rsqrtf(wave_sum(ss) * (1.f / D) + EPS);
#pragma unroll
            for (int j = 0; j < 4; ++j) { const int col = 4 * lane + 256 * j; const f32x4 g = *(const f32x4*)(gvec + col); *(f32x4*)(out + (size_t)row * D + col) = x[r][j] * rstd * g; } } }
    }
}
DI void conv3_8(const bf16* p0, const bf16* p1, const bf16* p2, bool hp, bool hn, const float* w, int wstride, float (&o)[8]) {
    float c[8], pv[8], nx[8];
    unpack8(*(const u32x4*)p1, c);
    if (hp) unpack8(*(const u32x4*)p0, pv); else {
#pragma unroll
        for (int j = 0; j < 8; ++j) pv[j] = 0.f; }
    if (hn) unpack8(*(const u32x4*)p2, nx); else {
#pragma unroll
        for (int j = 0; j < 8; ++j) nx[j] = 0.f; }
#pragma unroll
    for (int j = 0; j < 8; ++j) o[j] = w[j] * pv[j] + w[wstride + j] * c[j] + w[2 * wstride + j] * nx[j];
}
DI void ph_e1(const Args& a, LAS unsigned char* lds, int tid, int gw, int NGW, int lane, int wave, int bid, int G) {
    unsigned char* ws = a.ws;
    const bf16* proj = (const bf16*)(ws + WS_PROJ); bf16* QB = (bf16*)(ws + WS_QB); bf16* KB = (bf16*)(ws + WS_KB); bf16* UT = (bf16*)(ws + WS_UT); bf16* X2T = (bf16*)(ws + WS_X2T);
    const float* wqk = a.in[I_WCQK]; const float* why = a.in[I_WCHY];
    LAS bf16* Ust = (LAS bf16*)lds; LAS bf16* Xst = (LAS bf16*)(lds + 65536);
    for (int it = bid; it < M / 64; it += G) {
        __syncthreads();
        int sbase, L; row_seq(it * 64, sbase, L);
#pragma unroll 1
        for (int half = 0; half < 2; ++half) {
            const int r0 = it * 64 + 8 * wave + 4 * half;
#define E1_LOAD(rawv, coff_) _Pragma("unroll") for (int j = 0; j < 6; ++j) { const int row = r0 - 1 + j; const bool ok = row >= sbase && row < sbase + L; \
                rawv[j] = ok ? *(const u32x4*)(proj + (size_t)row * NPROJ + (coff_)) : (u32x4){0u, 0u, 0u, 0u}; }
#define E1_CONV(rawv, wp_, wst_, outv) do { float w0_[8], w1_[8], w2_[8]; \
                { const f32x4 a_ = *(const f32x4*)(wp_), b_ = *(const f32x4*)((wp_) + 4), c_ = *(const f32x4*)((wp_) + (wst_)), d_ = *(const f32x4*)((wp_) + (wst_) + 4), e_ = *(const f32x4*)((wp_) + 2 * (wst_)), f_ = *(const f32x4*)((wp_) + 2 * (wst_) + 4); \
                  _Pragma("unroll") for (int j = 0; j < 4; ++j) { w0_[j] = a_[j]; w0_[4 + j] = b_[j]; w1_[j] = c_[j]; w1_[4 + j] = d_[j]; w2_[j] = e_[j]; w2_[4 + j] = f_[j]; } } \
                _Pragma("unroll") for (int o = 0; o < 4; ++o) { float p0[8], p1[8], p2[8]; unpack8(rawv[o], p0); unpack8(rawv[o + 1], p1); unpack8(rawv[o + 2], p2); \
                  _Pragma("unroll") for (int j = 0; j < 8; ++j) outv[o][j] = w0_[j] * p0[j] + w1_[j] * p1[j] + w2_[j] * p2[j]; } } while (0)
            { u32x4 rq[6], rk[6]; E1_LOAD(rq, 8 * lane); E1_LOAD(rk, 512 + 8 * lane);
              float oq[4][8], ok_[4][8]; E1_CONV(rq, wqk + 8 * lane, 1024, oq); E1_CONV(rk, wqk + 512 + 8 * lane, 1024, ok_);
#pragma unroll
              for (int o = 0; o < 4; ++o) {
#pragma unroll
                  for (int j = 0; j < 8; ++j) { oq[o][j] = silu_f(oq[o][j]); ok_[o][j] = silu_f(ok_[o][j]) * 0.08838834764831845f; }
                  *(u32x4*)(QB + (size_t)(r0 + o) * 512 + 8 * lane) = pack8(oq[o]); *(u32x4*)(KB + (size_t)(r0 + o) * 512 + 8 * lane) = pack8(ok_[o]); } }
            { u32x4 rv[6], r1[6], r2[6]; E1_LOAD(rv, 2064 + 8 * lane); E1_LOAD(r1, 2576 + 8 * lane); E1_LOAD(r2, 3088 + 8 * lane);
              float ov[4][8], o1[4][8], o2[4][8]; E1_CONV(rv, why + 8 * lane, 1536, ov); E1_CONV(r1, why + 512 + 8 * lane, 1536, o1); E1_CONV(r2, why + 1024 + 8 * lane, 1536, o2);
#pragma unroll
              for (int o = 0; o < 4; ++o) { const int rl = 8 * wave + 4 * half + o;
#pragma unroll
                  for (int j = 0; j < 8; ++j) ov[o][j] *= o1[o][j];
                  *(LAS u32x4*)(Ust + rl * 512 + 8 * lane) = pack8(ov[o]); *(LAS u32x4*)(Xst + rl * 512 + 8 * lane) = pack8(o2[o]); } }
#undef E1_LOAD
#undef E1_CONV
        }
        __syncthreads();
        for (int idx = tid; idx < 8192; idx += NTHR) { const int c = idx & 511, g = (idx >> 9) & 7, ten = idx >> 12;
            const LAS bf16* src = (ten ? Xst : Ust) + (8 * g) * 512 + c;
            u32x4 o; o.x = (unsigned)src[0] | ((unsigned)src[512] << 16); o.y = (unsigned)src[1024] | ((unsigned)src[1536] << 16);
            o.z = (unsigned)src[2048] | ((unsigned)src[2560] << 16); o.w = (unsigned)src[3072] | ((unsigned)src[3584] << 16);
            *(u32x4*)((ten ? X2T : UT) + (size_t)c * M + it * 64 + 8 * g) = o; }
    }
    const float* gates = (const float*)(ws + WS_GATES); const float* bg = a.in[I_BGATES];
    float* aS = (float*)(ws + WS_AS); float* MSv = (float*)(ws + WS_MS); float* bS = (float*)(ws + WS_BS);
    if (G > M / 64) { if (bid >= M / 64) bg_convert(a, lds, 0, bid - M / 64, G - M / 64, tid); } else bg_convert(a, lds, 0, bid, G, tid);
    const int sw0 = (G > M / 64) ? (bid - M / 64) * NWAVES + wave : gw, sws = (G > M / 64) ? (G - M / 64) * NWAVES : NGW;
    for (int it = sw0; it < 160 && it >= 0; it += sws) {
        const int seq = it >> 3, h = (it >> 1) & 3, dir = it & 1;
        const int L = seq < 16 ? 256 : 2048, base = seq < 16 ? seq * 256 : MPR + (seq - 16) * 2048, per = L / 64;
        const float m0 = seq < 16 ? 0.f : a.in[I_STM][((seq - 16) * 2 + dir) * 4 + h];
        const int gi = dir * 8 + h, gf = dir * 8 + 4 + h; const float bi = bg[gi], bf_ = bg[gf];
        float lf[32], iv[32];
#pragma unroll
        for (int k = 0; k < 32; ++k) if (k < per) { const int p = 64 * k + lane, t = dir ? L - 1 - p : p; const size_t gr = (size_t)(base + t) * 16; lf[k] = gates[gr + gf]; iv[k] = gates[gr + gi]; }
        float cb_ = 0.f, cM = m0;
#pragma unroll
        for (int k = 0; k < 32; ++k) if (k < per) {
            float x = logsig_f(lf[k] + bf_);
#pragma unroll
            for (int o = 1; o < 64; o <<= 1) { const float n = __shfl_up(x, o); if (lane >= o) x += n; }
            const float b = cb_ + x, av = (iv[k] + bi) - b;
            float y = av;
#pragma unroll
            for (int o = 1; o < 64; o <<= 1) { const float n = __shfl_up(y, o); if (lane >= o) y = fmaxf(y, n); }
            const float Mv = fmaxf(cM, y);
            const int p = 64 * k + lane, t = dir ? L - 1 - p : p; const size_t o_ = (size_t)(base + t) * 8 + dir * 4 + h;
            aS[o_] = av; MSv[o_] = Mv; bS[o_] = b;
            cb_ = __shfl(b, 63); cM = __shfl(Mv, 63); }
    }
}
DI void ffn_fix_panel(const Args& a, int layer, int pm, int tid) {
    const float* abnd = (const float*)(a.ws + WS_ABND); const float* gbnd = (const float*)(a.ws + WS_GBND); bf16* act = (bf16*)(a.ws + WS_FG); const float* w = a.in[I_WCFFN] + (size_t)layer * 3 * FF;
    for (int i = tid; i < 2 * FF; i += NTHR) { const int c = i % FF, which = i / FF, row = pm * 256 + (which ? 255 : 0);
        int sbase, L; row_seq(row, sbase, L);
        float prev, cur, next;
        if (which == 0) { cur = abnd[(size_t)(pm * 4 + 0) * FF + c]; next = abnd[(size_t)(pm * 4 + 1) * FF + c]; prev = row > sbase ? abnd[(size_t)((pm - 1) * 4 + 3) * FF + c] : 0.f; }
        else { cur = abnd[(size_t)(pm * 4 + 3) * FF + c]; prev = abnd[(size_t)(pm * 4 + 2) * FF + c]; next = row < sbase + L - 1 ? abnd[(size_t)((pm + 1) * 4 + 0) * FF + c] : 0.f; }
        const float v = w[c] * prev + w[FF + c] * cur + w[2 * FF + c] * next;
        act[(size_t)row * FF + c] = (bf16)(pk2(gelu_tanh_f(v) * gbnd[(size_t)(pm * 2 + which) * FF + c], 0.f) & 0xffffu); }
    asm volatile("s_waitcnt vmcnt(0)" ::: "memory");
    __syncthreads();
}
template <int DK> DI void stage_k_rows(LAS bf16* Kst, const bf16* src, size_t ld, int tid) {
    constexpr int CPR = DK / 8;
#pragma unroll
    for (int c = tid; c < 64 * CPR; c += NTHR) { const int key = c / CPR, ch = c % CPR;
        const u32x4 v = *(const u32x4*)(src + (size_t)key * ld + ch * 8); *(LAS u32x4*)(Kst + key * (DK + 8) + ch * 8) = v; }
}
template <int DV> DI void stage_v_transposed(LAS bf16* Vst, const bf16* src, size_t ld, int tid) {
    constexpr int NCH = DV / 8;
#pragma unroll
    for (int c = tid; c < 64 * NCH; c += NTHR) { const int key = c & 63, ch = c >> 6;
        const u32x4 v = *(const u32x4*)(src + (size_t)key * ld + ch * 8); LAS bf16* d = Vst + (ch * 8) * 72 + key;
        d[0] = (bf16)(v.x & 0xffffu); d[72] = (bf16)(v.x >> 16); d[144] = (bf16)(v.y & 0xffffu); d[216] = (bf16)(v.y >> 16);
        d[288] = (bf16)(v.z & 0xffffu); d[360] = (bf16)(v.z >> 16); d[432] = (bf16)(v.w & 0xffffu); d[504] = (bf16)(v.w >> 16); }
}
DI bf16x8 pack_frag(const f32x16& x, int s) {
    u32x4 p; p.x = pk2(x[8 * s], x[8 * s + 1]); p.y = pk2(x[8 * s + 2], x[8 * s + 3]); p.z = pk2(x[8 * s + 4], x[8 * s + 5]); p.w = pk2(x[8 * s + 6], x[8 * s + 7]);
    return __builtin_bit_cast(bf16x8, p); }
DI bf16x8 ld_vfrag(const LAS bf16* Vst, int e, int s) {
    const u32x2 lo = *(const LAS u32x2*)(Vst + e * 72 + s), hi = *(const LAS u32x2*)(Vst + e * 72 + s + 8);
    u32x4 r; r.x = lo.x; r.y = lo.y; r.z = hi.x; r.w = hi.y; return __builtin_bit_cast(bf16x8, r); }

DI void mlstm_unit(const Args& a, LAS unsigned char* lds, int seq, int h, int qt, int tid, int lane, int wave) {
    unsigned char* ws = a.ws;
    const bf16* QB = (const bf16*)(ws + WS_QB); const bf16* KB = (const bf16*)(ws + WS_KB); const bf16* proj = (const bf16*)(ws + WS_PROJ);
    const float* aS = (const float*)(ws + WS_AS); const float* MSv = (const float*)(ws + WS_MS); const float* bS = (const float*)(ws + WS_BS);
    float* hscr = a.out + OFF_K;
    bf16* ycat = (bf16*)(ws + WS_H);
    const bool isS = seq >= 16; const int L = isS ? 2048 : 256, base = isS ? MPR + (seq - 16) * 2048 : seq * 256, bs = seq - 16;
    LAS bf16* Kst = (LAS bf16*)lds;
    LAS bf16* Vst = (LAS bf16*)(lds + 17408);
    LAS bf16* C0t = (LAS bf16*)lds;
    LAS float* aT = (LAS float*)(lds + 35840);
    LAS float* n0s = (LAS float*)(lds + 36864);
    LAS bf16* Qw = (LAS bf16*)(lds + 37888 + wave * 8704);
    const bf16* GS = (const bf16*)(a.out + OFF_K + (size_t)M * 512);
    const float* NS = (const float*)(ws + WS_NS);
    asm volatile("" : "+v"(lane), "+v"(tid));
    const int lt = lane & 31, hh = lane >> 5, q0 = qt * 256 + 32 * wave, trow = base + q0 + lt;
    { u32x4 qv[8];
#pragma unroll
      for (int i = 0; i < 8; ++i) qv[i] = *(const u32x4*)(QB + (size_t)trow * 512 + h * 128 + 16 * i + 8 * hh);
#pragma unroll
      for (int i = 0; i < 8; ++i) *(LAS u32x4*)(Qw + lt * 136 + 16 * i + 8 * hh) = qv[i]; }
    LDS_WAIT(); asm volatile("" ::: "memory");
#define QF(i) (*(const LAS bf16x8*)(Qw + lt * 136 + 16 * (i) + 8 * hh))
    f32x16 O[4];
#pragma unroll 1
    for (int dir = 0; dir < 2; ++dir) {
#pragma unroll
        for (int eb = 0; eb < 4; ++eb)
#pragma unroll
            for (int r = 0; r < 16; ++r) O[eb][r] = 0.f;
        float den = 0.f;
        const float Mt = MSv[(size_t)trow * 8 + dir * 4 + h], bt = bS[(size_t)trow * 8 + dir * 4 + h];
        if (isS) {
            __syncthreads();
            const int sidx = (bs * 2 + dir) * 4 + h;
            const float m0 = a.in[I_STM][sidx];
            float cf[8]; float Mref = m0;
#pragma unroll
            for (int i = 0; i < 8; ++i) cf[i] = MSv[(size_t)(base + 256 * i + (dir ? 0 : 255)) * 8 + dir * 4 + h];
            if (dir == 0) { if (qt > 0) Mref = cf[0];
#pragma unroll
                for (int i = 1; i < 8; ++i) if (i < qt) Mref = cf[i]; }
            else { if (qt < 7) Mref = cf[7];
#pragma unroll
                for (int i = 6; i >= 0; --i) if (i > qt) Mref = cf[i]; }
            const float c0f = __expf(m0 - Mref);
#pragma unroll
            for (int i = 0; i < 8; ++i) { const bool inc = dir ? (i > qt) : (i < qt); cf[i] = inc ? __expf(cf[i] - Mref) : 0.f; }
            const float* C0 = a.in[I_STC] + (size_t)sidx * 16384; const bf16* Gb = GS + (size_t)sidx * 8 * 16384;
            for (int c = tid; c < 2048; c += NTHR) { const int d = c >> 4, e8 = (c & 15) * 8;
                const f32x4 c0a = *(const f32x4*)(C0 + d * 128 + e8), c0b = *(const f32x4*)(C0 + d * 128 + e8 + 4);
                u32x4 gq[8];
#pragma unroll
                for (int i = 0; i < 8; ++i) gq[i] = *(const u32x4*)(Gb + (size_t)i * 16384 + d * 128 + e8);
                float v[8];
#pragma unroll
                for (int j = 0; j < 4; ++j) { v[j] = c0a[j] * c0f; v[4 + j] = c0b[j] * c0f; }
#pragma unroll
                for (int i = 0; i < 8; ++i) { float g[8]; unpack8(gq[i], g);
#pragma unroll
                    for (int j = 0; j < 8; ++j) v[j] += cf[i] * g[j]; }
                const u32x4 pk = pack8(v);
                C0t[(e8 + 0) * 136 + d] = (bf16)(pk.x & 0xffffu); C0t[(e8 + 1) * 136 + d] = (bf16)(pk.x >> 16); C0t[(e8 + 2) * 136 + d] = (bf16)(pk.y & 0xffffu); C0t[(e8 + 3) * 136 + d] = (bf16)(pk.y >> 16);
                C0t[(e8 + 4) * 136 + d] = (bf16)(pk.z & 0xffffu); C0t[(e8 + 5) * 136 + d] = (bf16)(pk.z >> 16); C0t[(e8 + 6) * 136 + d] = (bf16)(pk.w & 0xffffu); C0t[(e8 + 7) * 136 + d] = (bf16)(pk.w >> 16); }
            if (tid < 128) { float nsv[8];
#pragma unroll
                for (int i = 0; i < 8; ++i) nsv[i] = NS[((size_t)sidx * 8 + i) * 128 + tid];
                float nv = a.in[I_STN][sidx * 128 + tid] * c0f;
#pragma unroll
                for (int i = 0; i < 8; ++i) nv += cf[i] * nsv[i];
                n0s[tid] = nv; }
            __syncthreads();
            const float sc = __expf(Mref - Mt);
            float dq = 0.f;
#pragma unroll
            for (int i = 0; i < 8; ++i) { float q[8]; const u32x4 qq = __builtin_bit_cast(u32x4, QF(i));
                unpack8(qq, q);
#pragma unroll
                for (int j = 0; j < 8; ++j) { dq += q[j] * n0s[16 * i + 8 * hh + j]; q[j] *= sc; }
                const bf16x8 Qs = __builtin_bit_cast(bf16x8, pack8(q));
#pragma unroll
                for (int eb = 0; eb < 4; ++eb) { const bf16x8 cf = *(const LAS bf16x8*)(C0t + (32 * eb + lt) * 136 + 16 * i + 8 * hh); O[eb] = MFMA32(cf, Qs, O[eb]); }
                asm volatile("" ::: "memory"); }
            den += sc * dq;
        }
        const int kt_lo = 4 * qt, kt_hi = 4 * qt + 3;
        u32x4 kreg[2], vreg[2]; float areg = 0.f;
#define ML_LOAD(kt_) do { const int kr0_ = base + 64 * (kt_); _Pragma("unroll") for (int i_ = 0; i_ < 2; ++i_) { const int c_ = tid + NTHR * i_; \
            kreg[i_] = *(const u32x4*)(KB + (size_t)(kr0_ + (c_ >> 4)) * 512 + h * 128 + (c_ & 15) * 8); \
            vreg[i_] = *(const u32x4*)(proj + (size_t)(kr0_ + (c_ & 63)) * NPROJ + 1024 + h * 128 + (c_ >> 6) * 8); } \
            if (tid < 64) areg = aS[(size_t)(kr0_ + tid) * 8 + dir * 4 + h]; } while (0)
        ML_LOAD(kt_lo);
#pragma unroll 1
        for (int kt = kt_lo; kt <= kt_hi; ++kt) {
            __syncthreads();
#pragma unroll
            for (int i_ = 0; i_ < 2; ++i_) { const int c_ = tid + NTHR * i_;
                *(LAS u32x4*)(Kst + (c_ >> 4) * 136 + (c_ & 15) * 8) = kreg[i_];
                LAS bf16* d = Vst + ((c_ >> 6) * 8) * 72 + (c_ & 63); const u32x4 v = vreg[i_];
                d[0] = (bf16)(v.x & 0xffffu); d[72] = (bf16)(v.x >> 16); d[144] = (bf16)(v.y & 0xffffu); d[216] = (bf16)(v.y >> 16);
                d[288] = (bf16)(v.z & 0xffffu); d[360] = (bf16)(v.z >> 16); d[432] = (bf16)(v.w & 0xffffu); d[504] = (bf16)(v.w >> 16); }
            if (tid < 64) aT[tid] = areg;
            if (kt < kt_hi) ML_LOAD(kt + 1);
            __syncthreads();
#pragma unroll 1
            for (int sub = 0; sub < 2; ++sub) {
                const int s0 = 64 * kt + 32 * sub;
                const bool skip = dir ? (s0 + 31 < q0) : (s0 > q0 + 31);
                if (!skip) {
                    f32x16 S;
#pragma unroll
                    for (int r = 0; r < 16; ++r) S[r] = 0.f;
#pragma unroll
                    for (int i = 0; i < 8; ++i) { const bf16x8 kf = *(const LAS bf16x8*)(Kst + (32 * sub + lt) * 136 + 16 * i + 8 * hh); S = MFMA32(kf, QF(i), S); }
                    const bool diag = (s0 == q0);
                    const int vlo = (diag && dir) ? lt : 0, vhi = (diag && !dir) ? lt : 31;
#pragma unroll
                    for (int r = 0; r < 16; ++r) { const int sl = (r & 3) + 8 * (r >> 2) + 4 * hh; const float av = aT[32 * sub + sl];
                        float wgt = __expf(av - Mt);
                        wgt = (sl >= vlo && sl <= vhi) ? wgt : 0.f;
                        const float p = S[r] * wgt; den += p; S[r] = p; }
                    const bf16x8 P0 = pack_frag(S, 0), P1 = pack_frag(S, 1);
#pragma unroll
                    for (int eb = 0; eb < 4; ++eb) {
                        O[eb] = MFMA32(ld_vfrag(Vst, 32 * eb + lt, 32 * sub + 4 * hh), P0, O[eb]);
                        O[eb] = MFMA32(ld_vfrag(Vst, 32 * eb + lt, 32 * sub + 16 + 4 * hh), P1, O[eb]); }
                }
            }
        }
#undef ML_LOAD
        const float dent = den + __shfl_xor(den, 32);
        const float inv = 1.f / fmaxf(fabsf(dent), __expf(-(bt + Mt)));
        int trow2 = trow; asm volatile("" : "+v"(trow2));
        float* hp = hscr + (size_t)trow2 * 512 + h * 128 + 4 * hh;
        if (dir == 0) {
#pragma unroll
            for (int eb = 0; eb < 4; ++eb)
#pragma unroll
                for (int g = 0; g < 4; ++g) { f32x4 v; v[0] = O[eb][4 * g] * inv; v[1] = O[eb][4 * g + 1] * inv; v[2] = O[eb][4 * g + 2] * inv; v[3] = O[eb][4 * g + 3] * inv;
                    *(f32x4*)(hp + 32 * eb + 8 * g) = v; }
        } else {
            float ss = 0.f;
#pragma unroll
            for (int eb = 0; eb < 4; ++eb)
#pragma unroll
                for (int g = 0; g < 4; ++g) { const f32x4 v = *(const f32x4*)(hp + 32 * eb + 8 * g);
#pragma unroll
                    for (int j = 0; j < 4; ++j) { const float x = __builtin_fmaf(O[eb][4 * g + j], inv, v[j]); O[eb][4 * g + j] = x; ss = __builtin_fmaf(x, x, ss); }
                    asm volatile("" ::: "memory"); }
            ss += __shfl_xor(ss, 32);
            const float rs = rsqrtf(ss * (1.f / 128.f) + EPS);
            const float* gh = a.in[I_GMLSTM] + h * 128 + 4 * hh; const bf16* op = proj + (size_t)trow2 * NPROJ + 1536 + h * 128 + 4 * hh; bf16* yp = ycat + (size_t)trow2 * 1024 + h * 128 + 4 * hh;
#pragma unroll
            for (int eb = 0; eb < 4; ++eb)
#pragma unroll
                for (int g = 0; g < 4; ++g) { const int e = 32 * eb + 8 * g; const u32x2 ov = *(const u32x2*)(op + e); const f32x4 gv = *(const f32x4*)(gh + e);
                    const float o0 = __uint_as_float(ov.x << 16), o1 = __uint_as_float(ov.x & 0xffff0000u), o2 = __uint_as_float(ov.y << 16), o3 = __uint_as_float(ov.y & 0xffff0000u);
                    u32x2 w; w.x = pk2(O[eb][4 * g] * rs * gv[0] * sigm_f(o0), O[eb][4 * g + 1] * rs * gv[1] * sigm_f(o1));
                    w.y = pk2(O[eb][4 * g + 2] * rs * gv[2] * sigm_f(o2), O[eb][4 * g + 3] * rs * gv[3] * sigm_f(o3)); *(u32x2*)(yp + e) = w;
                    if (g == 3) asm volatile("" ::: "memory"); }
        }
    }
    __syncthreads();
#undef QF
}
DI void mlstm_state_unit(const Args& a, LAS unsigned char* lds, int seq, int h, int dir, int blk, int tid, int lane, int wave) {
    unsigned char* ws = a.ws;
    const bf16* KB = (const bf16*)(ws + WS_KB); const bf16* proj = (const bf16*)(ws + WS_PROJ);
    const float* aS = (const float*)(ws + WS_AS); const float* MSv = (const float*)(ws + WS_MS); const float* bS = (const float*)(ws + WS_BS);
    asm volatile("" : "+v"(lane), "+v"(tid));
    const bool isS = seq >= 16; const int base = (isS ? MPR + (seq - 16) * 2048 : seq * 256) + 256 * blk, lastrow = base + (dir ? 0 : 255);
    const float ML = MSv[(size_t)lastrow * 8 + dir * 4 + h], bL = bS[(size_t)lastrow * 8 + dir * 4 + h];
    LAS bf16* Kt = (LAS bf16*)lds;
    LAS bf16* Vst = (LAS bf16*)(lds + 18432);
    const int lt = lane & 31, hh = lane >> 5, db = wave >> 1, eb0 = 2 * (wave & 1);
    f32x16 C[2];
#pragma unroll
    for (int j = 0; j < 2; ++j)
#pragma unroll
        for (int r = 0; r < 16; ++r) C[j][r] = 0.f;
    float nacc = 0.f;
    u32x4 kreg[2], vreg[2]; float wreg[2];
#define ST_LOAD(kt_) do { const int kr0_ = base + 64 * (kt_); _Pragma("unroll") for (int i_ = 0; i_ < 2; ++i_) { const int c_ = tid + NTHR * i_, key_ = c_ & 63, ch_ = c_ >> 6; \
        kreg[i_] = *(const u32x4*)(KB + (size_t)(kr0_ + key_) * 512 + h * 128 + ch_ * 8); vreg[i_] = *(const u32x4*)(proj + (size_t)(kr0_ + key_) * NPROJ + 1024 + h * 128 + ch_ * 8); \
        wreg[i_] = aS[(size_t)(kr0_ + key_) * 8 + dir * 4 + h]; } } while (0)
    ST_LOAD(0);
#pragma unroll 1
    for (int kt = 0; kt < 4; ++kt) {
        __syncthreads();
#pragma unroll
        for (int i_ = 0; i_ < 2; ++i_) { const int c_ = tid + NTHR * i_, key = c_ & 63, ch = c_ >> 6; float k[8]; unpack8(kreg[i_], k);
            const float w = __expf(wreg[i_] - ML);
#pragma unroll
            for (int j = 0; j < 8; j += 2) { const unsigned p = pk2(k[j] * w, k[j + 1] * w); Kt[(ch * 8 + j) * 72 + key] = (bf16)(p & 0xffffu); Kt[(ch * 8 + j + 1) * 72 + key] = (bf16)(p >> 16); }
            LAS bf16* d = Vst + (ch * 8) * 72 + key; const u32x4 v = vreg[i_];
            d[0] = (bf16)(v.x & 0xffffu); d[72] = (bf16)(v.x >> 16); d[144] = (bf16)(v.y & 0xffffu); d[216] = (bf16)(v.y >> 16);
            d[288] = (bf16)(v.z & 0xffffu); d[360] = (bf16)(v.z >> 16); d[432] = (bf16)(v.w & 0xffffu); d[504] = (bf16)(v.w >> 16); }
        if (kt < 3) ST_LOAD(kt + 1);
        __syncthreads();
#pragma unroll
        for (int i = 0; i < 4; ++i) { const bf16x8 kf = *(const LAS bf16x8*)(Kt + (32 * db + lt) * 72 + 16 * i + 8 * hh);
#pragma unroll
            for (int j = 0; j < 2; ++j) { const bf16x8 vf = *(const LAS bf16x8*)(Vst + (32 * (eb0 + j) + lt) * 72 + 16 * i + 8 * hh); C[j] = MFMA32(kf, vf, C[j]); } }
        if (tid < 128) { float s = 0.f;
#pragma unroll 8
            for (int k = 0; k < 64; ++k) s += bf2f(Kt[tid * 72 + k]);
            nacc += s; }
    }
#undef ST_LOAD
    if (!isS) {
        float* oc = a.out + OFF_C + ((size_t)((seq * 2 + dir) * 4 + h)) * 16384;
#pragma unroll
        for (int j = 0; j < 2; ++j)
#pragma unroll
            for (int r = 0; r < 16; ++r) { const int d = 32 * db + (r & 3) + 8 * (r >> 2) + 4 * hh, e = 32 * (eb0 + j) + lt; oc[d * 128 + e] = C[j][r]; }
        if (tid < 128) a.out[OFF_N + ((size_t)((seq * 2 + dir) * 4 + h)) * 128 + tid] = nacc;
        if (tid == 0) a.out[OFF_MM + (seq * 2 + dir) * 4 + h] = bL + ML;
    } else {
        const size_t u = ((size_t)(((seq - 16) * 2 + dir) * 4 + h)) * 8 + blk;
        bf16* og = (bf16*)(a.out + OFF_K + (size_t)M * 512) + u * 16384;
#pragma unroll
        for (int j = 0; j < 2; ++j)
#pragma unroll
            for (int r = 0; r < 16; ++r) { const int d = 32 * db + (r & 3) + 8 * (r >> 2) + 4 * hh, e = 32 * (eb0 + j) + lt; og[d * 128 + e] = (bf16)(pk2(C[j][r], 0.f) & 0xffffu); }
        if (tid < 128) ((float*)(ws + WS_NS))[u * 128 + tid] = nacc;
    }
    __syncthreads();
}
constexpr int HY_CP = 8224;
constexpr int HY_UB = 65792, HY_XB = 90624;
DI u32x4 ld16_or0(const bf16* p, bool ok) { u32x4 z = {0u, 0u, 0u, 0u}; return ok ? *(const u32x4*)p : z; }
DI void hy_build_copies(LAS unsigned char* lds, const bf16* R, int RL, int tid) {
    const int nch = RL / 8;
    for (int mch = tid; mch <= nch; mch += NTHR) {
        const u32x4 lo = ld16_or0(R + 8 * (mch - 1), mch >= 1), hi = ld16_or0(R + 8 * mch, mch < nch);
        const unsigned W[8] = {lo.x, lo.y, lo.z, lo.w, hi.x, hi.y, hi.z, hi.w};
#pragma unroll
        for (int sg = 0; sg < 8; ++sg) { u32x4 o;
            if ((sg & 1) == 0) { o.x = W[sg / 2]; o.y = W[sg / 2 + 1]; o.z = W[sg / 2 + 2]; o.w = W[sg / 2 + 3]; }
            else { const int q = (sg - 1) / 2; o.x = __builtin_amdgcn_alignbit(W[q + 1], W[q], 16); o.y = __builtin_amdgcn_alignbit(W[q + 2], W[q + 1], 16);
                   o.z = __builtin_amdgcn_alignbit(W[q + 3], W[q + 2], 16); o.w = __builtin_amdgcn_alignbit(W[q + 4], W[q + 3], 16); }
            *(LAS u32x4*)(lds + sg * HY_CP + 16 * mch) = o; }
    }
}
DI f32x16 hy_mfma_loop(LAS unsigned char* lds, unsigned abase, unsigned bbase, int dlo, int dhi) {
    f32x16 acc;
#pragma unroll
    for (int r = 0; r < 16; ++r) acc[r] = 0.f;
#pragma unroll 2
    for (int dl = dlo; dl <= dhi; ++dl) { const int off = -64 * dl;
        const bf16x8 a0 = *(const LAS bf16x8*)(lds + abase + off), b0 = *(const LAS bf16x8*)(lds + bbase + off);
        const bf16x8 a1 = *(const LAS bf16x8*)(lds + abase + off + 32), b1 = *(const LAS bf16x8*)(lds + bbase + off + 32);
        acc = MFMA32(a0, b0, acc); acc = MFMA32(a1, b1, acc); }
    return acc;
}
DI void hyena_channel(const Args& a, LAS unsigned char* lds, int c, int tid, int lane, int wave) {
    unsigned char* ws = a.ws;
    const bf16* UT = (const bf16*)(ws + WS_UT) + (size_t)c * M; const bf16* X2T = (const bf16*)(ws + WS_X2T) + (size_t)c * M;
    bf16* ycat = (bf16*)(ws + WS_H) + 512 + c; const float hb = a.in[I_HYB][c];
    const int lt = lane & 31, hh = lane >> 5, sg = (8 - (lt & 7)) & 7, i8 = (lt + 7) & ~7;
    LAS bf16* Ub = (LAS bf16*)(lds + HY_UB); LAS bf16* Xb = (LAS bf16*)(lds + HY_XB);
    __syncthreads();
    for (int i = tid; i < 24832 / 16; i += NTHR) *(LAS u32x4*)(lds + HY_UB + 16 * i) = (u32x4){0u, 0u, 0u, 0u};
    hy_build_copies(lds, (const bf16*)(ws + WS_R2048) + (size_t)c * 4096, 4096, tid);
    __syncthreads();
    for (int i = tid; i < 1024; i += NTHR) { const int b = i >> 8, mch = i & 255; const size_t g = (size_t)MPR + b * 2048 + 8 * mch;
        *(LAS u32x4*)(Ub + b * 2568 + 256 + 8 * mch) = *(const u32x4*)(UT + g); *(LAS u32x4*)(Xb + b * 2568 + 256 + 8 * mch) = *(const u32x4*)(X2T + g); }
    __syncthreads();
    { const int bq = lt & 3, Ib = 8 * wave + (lt >> 2);
      const unsigned abase = sg * HY_CP + 2 * (2048 + 8 + 8 * hh - i8), bbase = HY_UB + 2 * (bq * 2568 + 256 + 32 * Ib + 8 * hh);
      const f32x16 acc = hy_mfma_loop(lds, abase, bbase, 8 * wave - 63, 8 * wave + 7);
#pragma unroll
      for (int r = 0; r < 16; ++r) { int t = 32 * Ib + (r & 3) + 8 * (r >> 2) + 4 * hh; asm volatile("" : "+v"(t));
          const float u = bf2f(Ub[bq * 2568 + 256 + t]), x2 = bf2f(Xb[bq * 2568 + 256 + t]);
          const float y = x2 * (acc[r] + hb * u); ycat[(size_t)(MPR + bq * 2048 + t) * 1024] = (bf16)(pk2(y, 0.f) & 0xffffu); } }
    __syncthreads();
    for (int i = tid; i < 24832 / 16; i += NTHR) *(LAS u32x4*)(lds + HY_UB + 16 * i) = (u32x4){0u, 0u, 0u, 0u};
    hy_build_copies(lds, (const bf16*)(ws + WS_R256) + (size_t)c * 512, 512, tid);
    __syncthreads();
    { const int sq = tid >> 5, mch = tid & 31; const size_t g = (size_t)sq * 256 + 8 * mch;
      *(LAS u32x4*)(Ub + sq * 776 + 256 + 8 * mch) = *(const u32x4*)(UT + g); *(LAS u32x4*)(Xb + sq * 776 + 256 + 8 * mch) = *(const u32x4*)(X2T + g); }
    __syncthreads();
    if (wave < 4) { const int bq = 4 * wave + (lt & 3), Ib = lt >> 2;
      const unsigned abase = sg * HY_CP + 2 * (256 + 8 + 8 * hh - i8), bbase = HY_UB + 2 * (bq * 776 + 256 + 32 * Ib + 8 * hh);
      const f32x16 acc = hy_mfma_loop(lds, abase, bbase, -7, 7);
#pragma unroll
      for (int r = 0; r < 16; ++r) { int t = 32 * Ib + (r & 3) + 8 * (r >> 2) + 4 * hh; asm volatile("" : "+v"(t));
          const float u = bf2f(Ub[bq * 776 + 256 + t]), x2 = bf2f(Xb[bq * 776 + 256 + t]);
          const float y = x2 * (acc[r] + hb * u); ycat[(size_t)(bq * 256 + t) * 1024] = (bf16)(pk2(y, 0.f) & 0xffffu); } }
    __syncthreads();
}
#ifndef MK_MB_S
#define MK_MB_S 1
#define MK_MB_P 1
#define MK_MA_H 1
#define MK_MA_S 1
#endif
constexpr int HY_A1 = 256, HY_A2 = 384;
DI void hyena_range(const Args& a, LAS unsigned char* lds, int c_lo, int c_hi, int widx, int nw, int tid, int lane, int wave) {
    const int nch = c_hi - c_lo, nlines = nch / 64;
    if (nch % 64 == 0 && nw % 8 == 0 && nch % nw == 0 && 64 % (8 * nlines) == 0) { const int x = widx & 7, cnt = nch / nw, c0 = c_lo + x * 8 * nlines + (widx >> 3) * cnt;
        for (int c = 0; c < cnt; ++c) hyena_channel(a, lds, c0 + c, tid, lane, wave); }
    else for (int c = c_lo + widx; c < c_hi; c += nw) hyena_channel(a, lds, c, tid, lane, wave);
}
DI void ph_mixers_a(const Args& a, LAS unsigned char* lds, int tid, int lane, int wave, int bid, int G) {
    if (G == 256) { for (int rp = 0; rp < MK_MA_H; ++rp) { hyena_range(a, lds, 0, HY_A1, bid, G, tid, lane, wave); if (bid >= 128) hyena_range(a, lds, HY_A1, HY_A2, bid - 128, 128, tid, lane, wave); } }
    else hyena_range(a, lds, 0, 512, bid, G, tid, lane, wave);
    for (int it = bid; it < 384; it += G) { const bool smp = it < 256; const int rr = smp ? it : it - 256;
        for (int rp = 0; rp < MK_MA_S; ++rp)
        mlstm_state_unit(a, lds, smp ? 16 + (rr >> 6) : (rr >> 3), smp ? (rr >> 4) & 3 : (rr >> 1) & 3, smp ? (rr >> 3) & 1 : rr & 1, smp ? rr & 7 : 0, tid, lane, wave); }
}
DI void ph_mixers_b(const Args& a, LAS unsigned char* lds, int tid, int lane, int wave, int bid, int G) {
    if (G == 256 && bid >= 192) hyena_range(a, lds, HY_A2, 512, bid - 192, 64, tid, lane, wave);
    for (int it = bid; it < 192; it += G) { const bool smp = it < 128; const int rr = smp ? it : it - 128;
        for (int rp = 0; rp < (smp ? MK_MB_S : MK_MB_P); ++rp)
        mlstm_unit(a, lds, smp ? 16 + (rr >> 5) : (rr >> 2), smp ? (rr >> 3) & 3 : rr & 3, smp ? rr & 7 : 0, tid, lane, wave); }
}
DI void attn_unit(const Args& a, LAS unsigned char* lds, int kind, int b, int h, int blk, int tid, int lane, int wave) {
    unsigned char* ws = a.ws;
    const bf16* Q1 = (const bf16*)(ws + WS_Q1); const bf16* K1 = (const bf16*)(ws + WS_K1); const bf16* V1 = (const bf16*)(ws + WS_V1);
    const bf16* CK = (const bf16*)(ws + WS_CK); const bf16* CV = (const bf16*)(ws + WS_CV);
    bf16* obuf = (bf16*)(ws + WS_H);
    LAS bf16* Kst = (LAS bf16*)lds;
    LAS bf16* Vst = (LAS bf16*)(lds + 9216);
    LAS float* rpbs = (LAS float*)(lds + 18432);
    asm volatile("" : "+v"(lane), "+v"(tid));
    const int lt = lane & 31, hh = lane >> 5;
    int qrow, r = 0, qc = 0, nctx, nloc, kr_lo = 0, rs = 0, cs = 0;
    if (kind == 0) { qrow = b * 256 + 32 * wave + lt; nctx = 0; nloc = 4; }
    else { const int r0 = 4 * blk; r = r0 + (wave >> 1); qc = 32 * (wave & 1) + lt; qrow = MPR + b * 2048 + r * 64 + qc; nctx = 8;
        const int lo = r0 - 4 < 0 ? 0 : (r0 - 4 > 24 ? 24 : r0 - 4); const int r3 = r0 + 3 - 4; const int hi = (r3 < 0 ? 0 : (r3 > 24 ? 24 : r3)) + 7;
        kr_lo = lo; nloc = hi - lo + 1; rs = r - 4 < 0 ? 0 : (r - 4 > 24 ? 24 : r - 4); cs = qc - 8 < 0 ? 0 : (qc - 8 > 48 ? 48 : qc - 8);
        __syncthreads();
        if (tid < 465) rpbs[tid] = a.in[I_RPB][h * 465 + tid] * 1.4426950408889634f;
    }
    int icol[2][16]; unsigned okm[2] = {0u, 0u};
#pragma unroll
    for (int sub = 0; sub < 2; ++sub)
#pragma unroll
        for (int q = 0; q < 16; ++q) { const int kc = 32 * sub + (q & 3) + 8 * (q >> 2) + 4 * hh; int ic = kc - qc + 15; ic = ic < 0 ? 0 : (ic > 30 ? 30 : ic);
            icol[sub][q] = ic; okm[sub] |= ((kc >= cs) && (kc < cs + 16)) ? (1u << q) : 0u; }
    bf16x8 Qf[4];
#pragma unroll
    for (int i = 0; i < 4; ++i) Qf[i] = *(const bf16x8*)(Q1 + (size_t)qrow * 1024 + h * 64 + 16 * i + 8 * hh);
    f32x16 O[2];
#pragma unroll
    for (int eb = 0; eb < 2; ++eb)
#pragma unroll
        for (int q = 0; q < 16; ++q) O[eb][q] = 0.f;
    float mrun = -INFINITY, lrun = 0.f;
    const int kkey = tid >> 3, kch = tid & 7, vkey = tid & 63, vch = tid >> 6;
    u32x4 kreg, vreg;
#define ATT_SRC(st_, ksrc_, vsrc_, ld_) do { const bool ic_ = (st_) < nctx; const int kr_ = kr_lo + ((st_) - nctx); \
        if (ic_) { ksrc_ = CK + ((size_t)((b * 16 + h) * 512 + 64 * (st_))) * 64; vsrc_ = CV + ((size_t)((b * 16 + h) * 512 + 64 * (st_))) * 64; ld_ = 64; } \
        else if (kind == 0) { const size_t row0 = (size_t)b * 256 + 64 * (st_); ksrc_ = K1 + row0 * 1024 + h * 64; vsrc_ = V1 + row0 * 1024 + h * 64; ld_ = 1024; } \
        else { const size_t row0 = (size_t)MPR + b * 2048 + kr_ * 64; ksrc_ = K1 + row0 * 1024 + h * 64; vsrc_ = V1 + row0 * 1024 + h * 64; ld_ = 1024; } } while (0)
    { const bf16* ksrc; const bf16* vsrc; size_t ld; ATT_SRC(0, ksrc, vsrc, ld);
      kreg = *(const u32x4*)(ksrc + (size_t)kkey * ld + kch * 8); vreg = *(const u32x4*)(vsrc + (size_t)vkey * ld + vch * 8); }
#pragma unroll 1
    for (int st = 0; st < nctx + nloc; ++st) {
        const bool isctx = st < nctx; const int kr = kr_lo + (st - nctx);
        __syncthreads();
        *(LAS u32x4*)(Kst + kkey * 72 + kch * 8) = kreg;
        { LAS bf16* d = Vst + (vch * 8) * 72 + vkey;
          d[0] = (bf16)(vreg.x & 0xffffu); d[72] = (bf16)(vreg.x >> 16); d[144] = (bf16)(vreg.y & 0xffffu); d[216] = (bf16)(vreg.y >> 16);
          d[288] = (bf16)(vreg.z & 0xffffu); d[360] = (bf16)(vreg.z >> 16); d[432] = (bf16)(vreg.w & 0xffffu); d[504] = (bf16)(vreg.w >> 16); }
        if (st + 1 < nctx + nloc) { const bf16* ksrc; const bf16* vsrc; size_t ld; ATT_SRC(st + 1, ksrc, vsrc, ld);
            kreg = *(const u32x4*)(ksrc + (size_t)kkey * ld + kch * 8); vreg = *(const u32x4*)(vsrc + (size_t)vkey * ld + vch * 8); }
        __syncthreads();
        const bool active = (kind == 0) || isctx || (kr >= rs && kr < rs + 8);
        if (active) {
#pragma unroll
            for (int sub = 0; sub < 2; ++sub) {
                f32x16 S;
#pragma unroll
                for (int q = 0; q < 16; ++q) S[q] = 0.f;
#pragma unroll
                for (int i = 0; i < 4; ++i) { const bf16x8 kf = *(const LAS bf16x8*)(Kst + (32 * sub + lt) * 72 + 16 * i + 8 * hh); S = MFMA32(kf, Qf[i], S); }
                if (kind == 1 && !isctx) {
                    const LAS float* rb = rpbs + (kr - r + 7) * 31;
                    float bv[16];
#pragma unroll
                    for (int q = 0; q < 16; ++q) bv[q] = rb[icol[sub][q]];
#pragma unroll
                    for (int q = 0; q < 16; ++q) S[q] = ((okm[sub] >> q) & 1u) ? S[q] + bv[q] : -INFINITY;
                }
                float mx = fmaxf(fmaxf(fmaxf(S[0], S[1]), fmaxf(S[2], S[3])), fmaxf(fmaxf(S[4], S[5]), fmaxf(S[6], S[7])));
                mx = fmaxf(mx, fmaxf(fmaxf(fmaxf(S[8], S[9]), fmaxf(S[10], S[11])), fmaxf(fmaxf(S[12], S[13]), fmaxf(S[14], S[15]))));
                { const auto sw_ = __builtin_amdgcn_permlane32_swap(__float_as_uint(mx), __float_as_uint(mx), false, false); mx = fmaxf(__uint_as_float(sw_[0]), __uint_as_float(sw_[1])); }
                if (!__all(mx <= mrun + 8.f)) { const float mnew = fmaxf(mrun, mx); const float alpha = exp2_f(mrun - mnew);
                    lrun *= alpha; mrun = mnew;
#pragma unroll
                    for (int eb = 0; eb < 2; ++eb)
#pragma unroll
                        for (int q = 0; q < 16; ++q) O[eb][q] *= alpha; }
                float ps = 0.f;
#pragma unroll
                for (int q = 0; q < 16; ++q) { const float p = exp2_f(S[q] - mrun); S[q] = p; ps += p; }
                lrun += ps;
                const bf16x8 P0 = pack_frag(S, 0), P1 = pack_frag(S, 1);
#pragma unroll
                for (int eb = 0; eb < 2; ++eb) {
                    O[eb] = MFMA32(ld_vfrag(Vst, 32 * eb + lt, 32 * sub + 4 * hh), P0, O[eb]);
                    O[eb] = MFMA32(ld_vfrag(Vst, 32 * eb + lt, 32 * sub + 16 + 4 * hh), P1, O[eb]); }
            }
        }
    }
    const float inv = 1.f / (lrun + __shfl_xor(lrun, 32));
    bf16* op = obuf + (size_t)qrow * 1024 + h * 64;
#pragma unroll
    for (int eb = 0; eb < 2; ++eb)
#pragma unroll
        for (int g = 0; g < 4; ++g) { u32x2 w; w.x = pk2(O[eb][4 * g] * inv, O[eb][4 * g + 1] * inv); w.y = pk2(O[eb][4 * g + 2] * inv, O[eb][4 * g + 3] * inv);
            *(u32x2*)(op + 32 * eb + 8 * g + 4 * hh) = w; }
    __syncthreads();
#undef ATT_SRC
}
#ifndef MK_AT_N
#define MK_AT_N 1
#define MK_AT_C 1
#endif
DI void ph_attention(const Args& a, LAS unsigned char* lds, int tid, int lane, int wave, int bid, int G) {
    for (int it = bid; it < 768; it += G) {
        if (it < 512) { for (int rp = 0; rp < MK_AT_N; ++rp) attn_unit(a, lds, 1, it >> 7, (it >> 3) & 15, it & 7, tid, lane, wave); }
        else { const int r = it - 512; for (int rp = 0; rp < MK_AT_C; ++rp) attn_unit(a, lds, 0, r >> 4, r & 15, 0, tid, lane, wave); }
    }
}
DI void cache_out(const Args& a, int widx, int nw, int tid) {
    const bf16* K1 = (const bf16*)(a.ws + WS_K1); const bf16* V1 = (const bf16*)(a.ws + WS_V1);
    for (int i = widx * NTHR + tid; i < 2 * MPR * 128; i += nw * NTHR) { const int ten = i >= MPR * 128, j = ten ? i - MPR * 128 : i, row = j >> 7, c8 = (j & 127) * 8;
        float f[8]; unpack8(*(const u32x4*)((ten ? V1 : K1) + (size_t)row * 1024 + c8), f);
        const int hh = c8 >> 6, d = c8 & 63, b = row >> 8, tt = row & 255;
        float* p = a.out + (ten ? OFF_V : OFF_K) + ((size_t)((b * 16 + hh) * 256 + tt)) * 64 + d;
        *(f32x4*)p = (f32x4){f[0], f[1], f[2], f[3]}; *(f32x4*)(p + 4) = (f32x4){f[4], f[5], f[6], f[7]}; }
}
__global__ void __launch_bounds__(NTHR, 2) mk_fwd(Args a) {
    extern __shared__ __attribute__((aligned(16))) unsigned char lds_raw[];
    LAS unsigned char* lds = (LAS unsigned char*)lds_raw;
    const int tid = threadIdx.x, lane = tid & 63, wave = __builtin_amdgcn_readfirstlane(tid >> 6), bid = blockIdx.x, G = gridDim.x;
    const int gw = bid * NWAVES + wave, NGW = G * NWAVES;
    unsigned char* ws = a.ws;
    for (int u = tid; u < (LDS_BYTES - LDSCTL_OFF) / 4; u += NTHR) ((LAS unsigned*)(lds + LDSCTL_OFF))[u] = 0u;
    __syncthreads();
    XcdBarrier bar; bar.bar = (unsigned*)(ws + WS_CTL) + CW_BAR; bar.x = 0; bar.st = nullptr;
    const bool multi = (a.ph_hi - a.ph_lo) > 1;
    if (multi) bar = xcd_barrier_post((unsigned*)(ws + WS_CTL) + CW_BAR, (volatile LAS unsigned*)(lds + MISC_OFF) + 8);
    float* out = a.out;
    float* modF = (float*)(ws + WS_MODF);
    bf16* hbuf = (bf16*)(ws + WS_H);
    bf16* dlt = (bf16*)(ws + WS_DL);
    const float* xsB = a.in[I_XS] - (size_t)MPR * D;
    const int lo = a.ph_lo, hi = a.ph_hi;
#ifndef MK_ONLY
#define MK_ONLY -1
#endif
#define IN(k) ((MK_ONLY < 0 || MK_ONLY == (k)) && lo <= (k) && (k) < hi)
#define SEAM(k) do { if ((k) + 1 < hi) xcd_barrier(bar); } while (0)
#ifndef MK_REPMASK
#define MK_REPMASK 0u
#endif
#define MK_REP(k) (((MK_REPMASK >> (k)) & 1u) ? 2 : 1)
#define PH(k, ...) if (IN(k)) { if (MK_REP(k) == 2) { __VA_ARGS__ xcd_barrier(bar); } { __VA_ARGS__ } SEAM(k); }
#define GEMM_UP(l) do { pg8::Gemm g{hbuf, (const bf16*)(ws + WS_WUP) + (size_t)(l) * 5632 * 1024, M, 2 * FF, D}; pg8::StaticOrder S; S.init(M, 2 * FF, G, bid); \
            pg8::EpiFfn E{(bf16*)(ws + WS_FG), a.in[I_WCFFN] + (size_t)(l) * 3 * FF, (float*)(ws + WS_ABND), (float*)(ws + WS_GBND), (LAS float*)(lds + XCH_OFF)}; \
            pg8::gemm_phase<pg8::EpiFfn, pg8::StaticOrder, true, true>(lds, g, S, E); } while (0)
#define GEMM_DOWN(l) do { pg8::Gemm g{(const bf16*)(ws + WS_FG), (const bf16*)(ws + WS_WDN) + (size_t)(l) * 1024 * FF, M, D, FF}; pg8::StaticOrder S; S.init(M, D, G, bid); \
            { pg8::Unit u_; for (int i_ = 0; S.next(i_, u_); ++i_) ffn_fix_panel(a, (l), u_.pm, tid); }     \
            pg8::EpiDelta E{dlt, modF + (size_t)(l) * 5 * 6144 + 5 * 1024}; \
            pg8::gemm_phase<pg8::EpiDelta, pg8::StaticOrder, true, true>(lds, g, S, E); } while (0)
    PH(0, ph_prologue(a, lds, tid, lane, wave, bid, G);)
    PH(1, ph_modf_norm0(a, lds, tid, lane, wave, bid, G);)
    PH(2, pg8::Gemm g{hbuf, (const bf16*)(ws + WS_WAB), M, NPROJ, D}; pg8::StaticOrder S; S.init(M, NPROJ, G, bid);
            pg8::EpiProj E{(bf16*)(ws + WS_PROJ), NPROJ, (float*)(ws + WS_GATES), 8};
            pg8::gemm_phase<pg8::EpiProj, pg8::StaticOrder, true, true>(lds, g, S, E);)
    PH(3, ph_e1(a, lds, tid, gw, NGW, lane, wave, bid, G);)
    PH(4, ph_mixers_a(a, lds, tid, lane, wave, bid, G);)
    PH(5, ph_mixers_b(a, lds, tid, lane, wave, bid, G);)
    PH(6, pg8::Gemm g{hbuf, (const bf16*)(ws + WS_WOAB), M, D, D}; pg8::StaticOrder S; S.init(M, D, G, bid);
            pg8::EpiDelta E{dlt, modF + 2 * 1024};
            pg8::gemm_phase<pg8::EpiDelta, pg8::StaticOrder, true, true>(lds, g, S, E);
            { const int busy = (M / 256) * (D / 256); if (G > busy) { if (bid >= busy) bg_convert(a, lds, 1, bid - busy, G - busy, tid); } else bg_convert(a, lds, 1, bid, G, tid); })
    PH(7, ph_norm(a.in[I_XP], xsB, dlt, out, a.in[I_GFFN], modF, 3, 4, hbuf, gw, NGW, lane);)
    PH(8, GEMM_UP(0);)
    PH(9, GEMM_DOWN(0); { const int busy = (M / 256) * (D / 256); if (G > busy) { if (bid >= busy) bg_convert(a, lds, 2, bid - busy, G - busy, tid); } else bg_convert(a, lds, 2, bid, G, tid); })
    PH(10, ph_norm(out, out, dlt, out, a.in[I_GMIX] + D, modF + 5 * 6144, 0, 1, hbuf, gw, NGW, lane);)
    PH(11, pg8::Gemm g{hbuf, (const bf16*)(ws + WS_WC), M, 3 * D, D}; pg8::StaticOrder S; S.init(M, 3 * D, G, bid);
            pg8::EpiQKV E{(bf16*)(ws + WS_Q1), (size_t)(WS_K1 - WS_Q1) / 2};
            pg8::gemm_phase<pg8::EpiQKV, pg8::StaticOrder, true, true>(lds, g, S, E);
            { const int nt_ = (M / 256) * (3 * D / 256), full = nt_ % G; if (full > 0 && full < G) { if (bid >= full) bg_convert(a, lds, 3, bid - full, G - full, tid); } else bg_convert(a, lds, 3, bid, G, tid); })
    PH(12, ph_attention(a, lds, tid, lane, wave, bid, G);)
    PH(13, pg8::Gemm g{hbuf, (const bf16*)(ws + WS_WOC), M, D, D}; pg8::StaticOrder S; S.init(M, D, G, bid);
            pg8::EpiDelta E{dlt, modF + 5 * 6144 + 2 * 1024};
            pg8::gemm_phase<pg8::EpiDelta, pg8::StaticOrder, true, true>(lds, g, S, E);
            { const int busy = (M / 256) * (D / 256); if (G > busy) { if (bid >= busy) cache_out(a, bid - busy, G - busy, tid); } else cache_out(a, bid, G, tid); })
    PH(14, ph_norm(out, out, dlt, out, a.in[I_GFFN] + D, modF + 5 * 6144, 3, 4, hbuf, gw, NGW, lane);)
    PH(15, GEMM_UP(1);)
    PH(16, GEMM_DOWN(1);)
    PH(17, ph_final_norm(out, dlt, a.in[I_GFIN], gw, NGW, lane);)
#undef IN
#undef SEAM
}
}

extern "C" void kernel_launch(void* const* d_in, const int* in_sizes, int n_in, void* d_out, int out_size, void* d_ws, size_t ws_size, hipStream_t stream) {
    using namespace mk;
    static int grid = 0;
    if (grid == 0) {
        if (n_in != 33 || out_size != 23085184 || ws_size < WS_END) { fprintf(stderr, "kernel_launch: unexpected shapes: n_in %d out %d ws %zu\n", n_in, out_size, ws_size); grid = -1; return; }
        int dev = 0, cus = 0, per_cu = 0;
        if (hipGetDevice(&dev) != hipSuccess || hipDeviceGetAttribute(&cus, hipDeviceAttributeMultiprocessorCount, dev) != hipSuccess) { grid = -1; return; }
        if (hipFuncSetAttribute((const void*)mk_fwd, hipFuncAttributeMaxDynamicSharedMemorySize, LDS_BYTES) != hipSuccess) { fprintf(stderr, "kernel_launch: hipFuncSetAttribute failed\n"); grid = -1; return; }
        if (hipOccupancyMaxActiveBlocksPerMultiprocessor(&per_cu, (const void*)mk_fwd, NTHR, LDS_BYTES) != hipSuccess || per_cu < 1) { fprintf(stderr, "kernel_launch: occupancy query says %d\n", per_cu); per_cu = 1; }
        (void)hipGetLastError();
        grid = cus;
    }
    if (grid < 0) return;
    if (hipMemsetAsync((char*)d_ws + WS_CTL, 0, CTL_ZERO_BYTES, stream) != hipSuccess) return;
    Args a{};
    for (int i = 0; i < 33; ++i) a.in[i] = (const float*)d_in[i];
    a.out = (float*)d_out; a.ws = (unsigned char*)d_ws;
#if MK_ONE_LAUNCH
    a.ph_lo = 0; a.ph_hi = NPHASES;
    { void* args[] = {&a};
      hipError_t e = hipLaunchCooperativeKernel((const void*)mk_fwd, dim3(grid), dim3(NTHR), args, LDS_BYTES, stream);
      if (e != hipSuccess) fprintf(stderr, "kernel_launch: cooperative launch failed: %s (grid %d)\n", hipGetErrorString(e), grid); }
#else
    for (int ph = 0; ph < NPHASES; ++ph) { a.ph_lo = ph; a.ph_hi = ph + 1; hipLaunchKernelGGL(mk_fwd, dim3(grid), dim3(NTHR), LDS_BYTES, stream, a); }
#endif
}
```

```cpp
#include <hip/hip_runtime.h>
#include <cstdio>
#include <cstdint>
namespace pg8 {
#define PG8_LAS __attribute__((address_space(3)))
typedef unsigned short bf16_t;
typedef short bf16x8 __attribute__((ext_vector_type(8)));
typedef float f32x4 __attribute__((ext_vector_type(4)));
typedef unsigned u32x4 __attribute__((ext_vector_type(4)));
constexpr int BM = 256, BK = 64, HALF = 128, HTB = HALF * BK * 2  , STAGE_BYTES = 8 * HTB, NXCD = 8, WGM = 8;

__host__ __device__ __forceinline__ int lds_byte(int r, int c) { const int st = (r >> 4) * 2 + (c >> 5), rr = r & 15, cc = c & 31, ob = rr * 64 + cc * 2; return st * 1024 + (ob ^ (((ob >> 9) & 1) << 5)); }
__host__ __device__ __forceinline__ void stage_rc(int b, int& R, int& C) { const int st = b / 1024, sb = b % 1024, swz = sb ^ (((sb >> 9) & 1) << 5); R = (st >> 1) * 16 + swz / 64; C = (st & 1) * 32 + (swz % 64) / 2; }
__host__ __device__ __forceinline__ int perm32(int rho) { const int n = rho >> 4, i = rho & 15; return 8 * (i >> 2) + 4 * n + (i & 3); }

struct Unit { int pm, pn; };
struct Gemm { const bf16_t* A; const bf16_t* Bt; int M, N, K; };

struct StaticOrder {
    int nM, nN, nwg, G, c;
    __host__ __device__ void init(int M, int N, int G_, int c_) { nM = M / BM; nN = N / BM; nwg = nM * nN; G = G_; c = c_; }
    __host__ __device__ __forceinline__ bool next(int i, Unit& u) const {
        const long L = (long)i * G + c; if (L >= nwg) return false;
        int wgid = (int)L; { const int q = nwg / NXCD, r = nwg % NXCD, xcd = wgid % NXCD, off = wgid / NXCD; wgid = (xcd < r ? xcd * (q + 1) : r * (q + 1) + (xcd - r) * q) + off; }
        const int nig = WGM * nN, gid = wgid / nig, fm = gid * WGM, gsz = (nM - fm) < WGM ? (nM - fm) : WGM;
        u.pm = fm + ((wgid % nig) % gsz); u.pn = (wgid % nig) / gsz; return true;
    }
    __device__ __forceinline__ void a_ready(const Unit&) const {}
    __device__ __forceinline__ void done(const Unit&) const {}
};

__device__ __forceinline__ unsigned cvt_pk_bf16(float lo, float hi) { unsigned r; asm volatile("v_cvt_pk_bf16_f32 %0, %1, %2" : "=v"(r) : "v"(lo), "v"(hi)); return r; }
typedef float f32x2 __attribute__((ext_vector_type(2)));
__device__ __forceinline__ f32x2 gelu_pk(f32x2 v) {
    const f32x2 av = __builtin_elementwise_abs(v), d = av * 0.2316418882f + 1.0f;
    f32x2 t; t.x = __builtin_amdgcn_rcpf(d.x); t.y = __builtin_amdgcn_rcpf(d.y);
    f32x2 q = t * 0.5307027145f + (-0.7265760135f); q = q * t + 0.7107068705f; q = q * t + (-0.142248368f); q = q * t + 0.127414796f; q = q * t;
    const f32x2 s = (v * v) * (-0.72134752044f);
    f32x2 e; e.x = __builtin_amdgcn_exp2f(s.x); e.y = __builtin_amdgcn_exp2f(s.y);
    const f32x2 m = v * (q * e), r = v - m;
    f32x2 o; o.x = v.x < 0.f ? m.x : r.x; o.y = v.y < 0.f ? m.y : r.y; return o;
}

template <int ACT  > struct EpiBf16 {
    static constexpr bool PERM = true, AFTER_DRAIN = false; static_assert(ACT == 0 || ACT == 1, "EpiBf16: ACT is 0 (none) or 1 (gelu_pk)");
    bf16_t* O; int ldc; const float* bias; int split_cols; size_t split_stride; float scale0;
    __device__ __forceinline__ void operator()(const f32x4 (&acc)[2][2][4][2], const Unit& u, int wr, int wc, int fr, int fq) const {
        const int row0 = u.pm * BM + wr * 64 + fr; int colt = u.pn * BM; bf16_t* base = O;
        float sc = 1.f; if (split_cols) { const int t = colt / split_cols; base += (size_t)t * split_stride; colt -= t * split_cols; if (t == 0) sc = scale0; }
        const int col0 = colt + wc * 32 + 8 * fq, bcol0 = u.pn * BM + wc * 32 + 8 * fq;
        f32x4 bv[2][2];
#pragma unroll
        for (int bj = 0; bj < 2; ++bj)
#pragma unroll
            for (int n = 0; n < 2; ++n) bv[bj][n] = bias ? *(const f32x4*)(bias + bcol0 + bj * HALF + 4 * n) : (f32x4){0.f, 0.f, 0.f, 0.f};
#pragma unroll
        for (int ai = 0; ai < 2; ++ai)
#pragma unroll
            for (int m = 0; m < 4; ++m) { bf16_t* rowp = base + (size_t)(row0 + ai * HALF + m * 16) * ldc + col0;
#pragma unroll
                for (int bj = 0; bj < 2; ++bj) { f32x4 v0 = acc[ai][bj][m][0] + bv[bj][0], v1 = acc[ai][bj][m][1] + bv[bj][1];
                    if (ACT == 1) { f32x2 a = gelu_pk((f32x2){v0[0], v0[1]}), b = gelu_pk((f32x2){v0[2], v0[3]}), c = gelu_pk((f32x2){v1[0], v1[1]}), d = gelu_pk((f32x2){v1[2], v1[3]});
                        v0 = (f32x4){a.x, a.y, b.x, b.y}; v1 = (f32x4){c.x, c.y, d.x, d.y}; }
                    v0 = v0 * sc; v1 = v1 * sc; u32x4 w; w.x = cvt_pk_bf16(v0[0], v0[1]); w.y = cvt_pk_bf16(v0[2], v0[3]); w.z = cvt_pk_bf16(v1[0], v1[1]); w.w = cvt_pk_bf16(v1[2], v1[3]);
                    *(u32x4*)(rowp + bj * HALF) = w; } }
    }
};
typedef float f32x2e __attribute__((ext_vector_type(2)));
typedef __bf16 bf2e __attribute__((ext_vector_type(2)));
__device__ __forceinline__ unsigned pkbf(float lo, float hi) { f32x2e v = {lo, hi}; bf2e b = __builtin_convertvector(v, bf2e); return __builtin_bit_cast(unsigned, b); }
template <int CTRL> __device__ __forceinline__ float dpp_mov(float old, float src) {
    return __builtin_bit_cast(float, __builtin_amdgcn_update_dpp(__builtin_bit_cast(int, old), __builtin_bit_cast(int, src), CTRL, 0xF, 0xF, false)); }
struct EpiInAB {
    static constexpr bool PERM = true, AFTER_DRAIN = false;
    bf16_t* QK; bf16_t* VO; float* gates; const float* wconv; float* qkbnd; PG8_LAS float* xch;
    __device__ __forceinline__ void operator()(const f32x4 (&acc)[2][2][4][2], const Unit& u, int wr, int wc, int fr, int fq) const {
        const int row0 = u.pm * BM + wr * 64 + fr;
        if (u.pn >= 4) {
            if (u.pn < 8) { const int col0 = (u.pn - 4) * BM + wc * 32 + 8 * fq;
#pragma unroll
                for (int ai = 0; ai < 2; ++ai)
#pragma unroll
                    for (int m = 0; m < 4; ++m) { bf16_t* rowp = VO + (size_t)(row0 + ai * HALF + m * 16) * 1024 + col0;
#pragma unroll
                        for (int bj = 0; bj < 2; ++bj) { const f32x4 v0 = acc[ai][bj][m][0], v1 = acc[ai][bj][m][1];
                            u32x4 w; w.x = pkbf(v0[0], v0[1]); w.y = pkbf(v0[2], v0[3]); w.z = pkbf(v1[0], v1[1]); w.w = pkbf(v1[2], v1[3]); *(u32x4*)(rowp + bj * HALF) = w; } }
            } else if (wc == 0 && fq < 2) {
#pragma unroll
                for (int ai = 0; ai < 2; ++ai)
#pragma unroll
                    for (int m = 0; m < 4; ++m) { float* g = gates + (size_t)(row0 + ai * HALF + m * 16) * 16 + 8 * fq; *(f32x4*)g = acc[ai][0][m][0]; *(f32x4*)(g + 4) = acc[ai][0][m][1]; }
            }
            asm volatile("s_waitcnt lgkmcnt(0)" ::: "memory"); __builtin_amdgcn_s_barrier(); asm volatile("" ::: "memory");
            return;
        }
        const int cl = 32 * wc + 8 * fq;
        const int isk = u.pn >> 1; const float osc = isk ? 0.08838834764831845f : 1.0f;
        bf16_t* obase = QK + (size_t)isk * ((size_t)12288 * 512) + (u.pn & 1) * BM;
#pragma unroll
        for (int ai = 0; ai < 2; ++ai) { const int s = ai * 2 + wr;
#pragma unroll
            for (int bj = 0; bj < 2; ++bj) {
                if (fr == 0) { *(PG8_LAS f32x4*)(xch + (s * 2 + 0) * 256 + bj * HALF + cl) = acc[ai][bj][0][0]; *(PG8_LAS f32x4*)(xch + (s * 2 + 0) * 256 + bj * HALF + cl + 4) = acc[ai][bj][0][1]; }
                if (fr == 15) { *(PG8_LAS f32x4*)(xch + (s * 2 + 1) * 256 + bj * HALF + cl) = acc[ai][bj][3][0]; *(PG8_LAS f32x4*)(xch + (s * 2 + 1) * 256 + bj * HALF + cl + 4) = acc[ai][bj][3][1]; } } }
        asm volatile("s_waitcnt lgkmcnt(0)" ::: "memory"); __builtin_amdgcn_s_barrier(); asm volatile("" ::: "memory");
#pragma unroll
        for (int bj = 0; bj < 2; ++bj) { const int colw = u.pn * BM + bj * HALF + cl;
            float w0[8], w1[8], w2[8];
            { const f32x4 a0 = *(const f32x4*)(wconv + colw), a1 = *(const f32x4*)(wconv + colw + 4), b0 = *(const f32x4*)(wconv + 1024 + colw), b1 = *(const f32x4*)(wconv + 1024 + colw + 4),
                          c0 = *(const f32x4*)(wconv + 2048 + colw), c1 = *(const f32x4*)(wconv + 2048 + colw + 4);
#pragma unroll
              for (int i = 0; i < 4; ++i) { w0[i] = a0[i]; w0[4 + i] = a1[i]; w1[i] = b0[i]; w1[4 + i] = b1[i]; w2[i] = c0[i]; w2[4 + i] = c1[i]; } }
#pragma unroll
            for (int ai = 0; ai < 2; ++ai) { const int s = ai * 2 + wr;
                f32x4 up[2], dn[2];
#pragma unroll
                for (int n = 0; n < 2; ++n) { up[n] = s > 0 ? *(const PG8_LAS f32x4*)(xch + ((s - 1) * 2 + 1) * 256 + bj * HALF + cl + 4 * n) : (f32x4){0.f, 0.f, 0.f, 0.f};
                                              dn[n] = s < 3 ? *(const PG8_LAS f32x4*)(xch + ((s + 1) * 2 + 0) * 256 + bj * HALF + cl + 4 * n) : (f32x4){0.f, 0.f, 0.f, 0.f}; }
#pragma unroll
                for (int m = 0; m < 4; ++m) { const int row = row0 + ai * HALF + m * 16; float o[8];
#pragma unroll
                    for (int n = 0; n < 2; ++n)
#pragma unroll
                        for (int i = 0; i < 4; ++i) { const float cur = acc[ai][bj][m][n][i];
                            const float pold = m > 0 ? dpp_mov<0x121>(0.f, acc[ai][bj][m > 0 ? m - 1 : 0][n][i]) : up[n][i];
                            const float prev = dpp_mov<0x111>(pold, cur);
                            const float nold = m < 3 ? dpp_mov<0x12F>(0.f, acc[ai][bj][m < 3 ? m + 1 : 3][n][i]) : dn[n][i];
                            const float next = dpp_mov<0x101>(nold, cur);
                            const float v = w0[4 * n + i] * prev + w1[4 * n + i] * cur + w2[4 * n + i] * next;
                            o[4 * n + i] = v * __builtin_amdgcn_rcpf(1.f + __builtin_amdgcn_exp2f(-1.4426950408889634f * v)) * osc; }
                    const bool edge = (s == 0 && m == 0 && fr == 0) || (s == 3 && m == 3 && fr == 15);
                    if (!edge) { u32x4 w; w.x = pkbf(o[0], o[1]); w.y = pkbf(o[2], o[3]); w.z = pkbf(o[4], o[5]); w.w = pkbf(o[6], o[7]); *(u32x4*)(obase + (size_t)row * 512 + bj * HALF + cl) = w; }
                    if (s == 0 && m == 0 && fr < 2) { float* p = qkbnd + ((size_t)(u.pm * 4 + fr)) * 1024 + colw; *(f32x4*)p = acc[ai][bj][m][0]; *(f32x4*)(p + 4) = acc[ai][bj][m][1]; }
                    if (s == 3 && m == 3 && fr >= 14) { float* p = qkbnd + ((size_t)(u.pm * 4 + 2 + (fr - 14))) * 1024 + colw; *(f32x4*)p = acc[ai][bj][m][0]; *(f32x4*)(p + 4) = acc[ai][bj][m][1]; }
                }
            }
        }
    }
};
struct EpiDelta {
    static constexpr bool PERM = true, AFTER_DRAIN = false;
    bf16_t* Dl; const float* gate5;
    __device__ __forceinline__ void operator()(const f32x4 (&acc)[2][2][4][2], const Unit& u, int wr, int wc, int fr, int fq) const {
        const int row0 = u.pm * BM + wr * 64 + fr, col0 = u.pn * BM + wc * 32 + 8 * fq;
        const int v = u.pm < 16 ? 4 : ((u.pm - 16) >> 3);
        const float* g = gate5 + (size_t)v * 6144;
        f32x4 gv[2][2];
#pragma unroll
        for (int bj = 0; bj < 2; ++bj)
#pragma unroll
            for (int n = 0; n < 2; ++n) gv[bj][n] = *(const f32x4*)(g + col0 + bj * HALF + 4 * n);
#pragma unroll
        for (int ai = 0; ai < 2; ++ai)
#pragma unroll
            for (int m = 0; m < 4; ++m) { bf16_t* rowp = Dl + (size_t)(row0 + ai * HALF + m * 16) * 1024 + col0;
#pragma unroll
                for (int bj = 0; bj < 2; ++bj) { const f32x4 v0 = acc[ai][bj][m][0] * gv[bj][0], v1 = acc[ai][bj][m][1] * gv[bj][1];
                    u32x4 w; w.x = pkbf(v0[0], v0[1]); w.y = pkbf(v0[2], v0[3]); w.z = pkbf(v1[0], v1[1]); w.w = pkbf(v1[2], v1[3]);
                    *(u32x4*)(rowp + bj * HALF) = w; } }
    }
};
struct EpiQKV {
    static constexpr bool PERM = true, AFTER_DRAIN = false;
    bf16_t* Q; size_t qkv_stride;
    __device__ __forceinline__ void operator()(const f32x4 (&acc)[2][2][4][2], const Unit& u, int wr, int wc, int fr, int fq) const {
        const int t = u.pn >> 2; const int colt = (u.pn & 3) * BM;
        bf16_t* base = Q + (size_t)t * qkv_stride; const float sc = t == 0 ? 0.18033688011112042f : 1.0f;
        const int row0 = u.pm * BM + wr * 64 + fr, col0 = colt + wc * 32 + 8 * fq;
#pragma unroll
        for (int ai = 0; ai < 2; ++ai)
#pragma unroll
            for (int m = 0; m < 4; ++m) { const int row = row0 + ai * HALF + m * 16; bf16_t* rowp = base + (size_t)row * 1024 + col0;
#pragma unroll
                for (int bj = 0; bj < 2; ++bj) { const f32x4 v0 = acc[ai][bj][m][0] * sc, v1 = acc[ai][bj][m][1] * sc;
                    u32x4 w; w.x = pkbf(v0[0], v0[1]); w.y = pkbf(v0[2], v0[3]); w.z = pkbf(v1[0], v1[1]); w.w = pkbf(v1[2], v1[3]);
                    *(u32x4*)(rowp + bj * HALF) = w; } }
    }
};
struct EpiFfn {
    static constexpr bool PERM = true, AFTER_DRAIN = false;
    bf16_t* act; const float* wconv; float* abnd; float* gbnd; PG8_LAS float* xch;
    __device__ __forceinline__ void operator()(const f32x4 (&acc)[2][2][4][2], const Unit& u, int wr, int wc, int fr, int fq) const {
        constexpr int FFW = 2816;
        const int cl = 32 * wc + 8 * fq, col8 = 128 * u.pn + cl;
        float w0[8], w1[8], w2[8];
        { const f32x4 a0 = *(const f32x4*)(wconv + col8), a1 = *(const f32x4*)(wconv + col8 + 4), b0 = *(const f32x4*)(wconv + FFW + col8), b1 = *(const f32x4*)(wconv + FFW + col8 + 4),
                      c0 = *(const f32x4*)(wconv + 2 * FFW + col8), c1 = *(const f32x4*)(wconv + 2 * FFW + col8 + 4);
#pragma unroll
          for (int i = 0; i < 4; ++i) { w0[i] = a0[i]; w0[4 + i] = a1[i]; w1[i] = b0[i]; w1[4 + i] = b1[i]; w2[i] = c0[i]; w2[4 + i] = c1[i]; } }
#pragma unroll
        for (int ai = 0; ai < 2; ++ai) { const int s = ai * 2 + wr;
            if (fr == 0) { *(PG8_LAS f32x4*)(xch + (s * 2 + 0) * 128 + cl) = acc[ai][0][0][0]; *(PG8_LAS f32x4*)(xch + (s * 2 + 0) * 128 + cl + 4) = acc[ai][0][0][1]; }
            if (fr == 15) { *(PG8_LAS f32x4*)(xch + (s * 2 + 1) * 128 + cl) = acc[ai][0][3][0]; *(PG8_LAS f32x4*)(xch + (s * 2 + 1) * 128 + cl + 4) = acc[ai][0][3][1]; } }
        asm volatile("s_waitcnt lgkmcnt(0)" ::: "memory"); __builtin_amdgcn_s_barrier(); asm volatile("" ::: "memory");
#pragma unroll
        for (int ai = 0; ai < 2; ++ai) { const int s = ai * 2 + wr;
            f32x4 up[2], dn[2];
#pragma unroll
            for (int n = 0; n < 2; ++n) { up[n] = s > 0 ? *(const PG8_LAS f32x4*)(xch + ((s - 1) * 2 + 1) * 128 + cl + 4 * n) : (f32x4){0.f, 0.f, 0.f, 0.f};
                                          dn[n] = s < 3 ? *(const PG8_LAS f32x4*)(xch + ((s + 1) * 2 + 0) * 128 + cl + 4 * n) : (f32x4){0.f, 0.f, 0.f, 0.f}; }
#pragma unroll
            for (int m = 0; m < 4; ++m) { const int row = u.pm * BM + ai * HALF + wr * 64 + m * 16 + fr; float o[8];
#pragma unroll
                for (int n = 0; n < 2; ++n)
#pragma unroll
                    for (int i = 0; i < 4; ++i) { const float cur = acc[ai][0][m][n][i];
                        const float pold = m > 0 ? dpp_mov<0x121>(0.f, acc[ai][0][m > 0 ? m - 1 : 0][n][i]) : up[n][i];
                        const float prev = dpp_mov<0x111>(pold, cur);
                        const float nold = m < 3 ? dpp_mov<0x12F>(0.f, acc[ai][0][m < 3 ? m + 1 : 3][n][i]) : dn[n][i];
                        const float next = dpp_mov<0x101>(nold, cur);
                        const float v = w0[4 * n + i] * prev + w1[4 * n + i] * cur + w2[4 * n + i] * next;
                        const float u2 = v * (-2.3022081981f + -0.1029432396f * v * v);
                        o[4 * n + i] = v * __builtin_amdgcn_rcpf(1.f + __builtin_amdgcn_exp2f(u2)) * acc[ai][1][m][n][i]; }
                const bool edge = (s == 0 && m == 0 && fr == 0) || (s == 3 && m == 3 && fr == 15);
                if (!edge) { u32x4 w; w.x = pkbf(o[0], o[1]); w.y = pkbf(o[2], o[3]); w.z = pkbf(o[4], o[5]); w.w = pkbf(o[6], o[7]); *(u32x4*)(act + (size_t)row * FFW + col8) = w; }
                if (s == 0 && m == 0 && fr < 2) { float* p = abnd + ((size_t)(u.pm * 4 + fr)) * FFW + col8; *(f32x4*)p = acc[ai][0][m][0]; *(f32x4*)(p + 4) = acc[ai][0][m][1];
                    if (fr == 0) { float* q = gbnd + ((size_t)(u.pm * 2 + 0)) * FFW + col8; *(f32x4*)q = acc[ai][1][m][0]; *(f32x4*)(q + 4) = acc[ai][1][m][1]; } }
                if (s == 3 && m == 3 && fr >= 14) { float* p = abnd + ((size_t)(u.pm * 4 + 2 + (fr - 14))) * FFW + col8; *(f32x4*)p = acc[ai][0][m][0]; *(f32x4*)(p + 4) = acc[ai][0][m][1];
                    if (fr == 15) { float* q = gbnd + ((size_t)(u.pm * 2 + 1)) * FFW + col8; *(f32x4*)q = acc[ai][1][m][0]; *(f32x4*)(q + 4) = acc[ai][1][m][1]; } }
            }
        }
    }
};
template <class Epi, class Sched, bool ALIGN_EPI = false, bool SP2 = false>
__device__ __forceinline__ void gemm_phase(PG8_LAS unsigned char* lds, const Gemm g, const Sched& S, const Epi& E) {
    const int tid = threadIdx.x, wid = __builtin_amdgcn_readfirstlane(tid >> 6), lane = tid & 63, wr = wid >> 2, wc = wid & 3, fr = lane & 15, fq = lane >> 4;
    const int K = g.K, nt = K / BK;
    unsigned voffA[2], voffB[2];
#pragma unroll
    for (int i = 0; i < 2; ++i) { int R, C; stage_rc(tid * 16 + i * 8192, R, C); const int Rb = Epi::PERM ? ((R & ~31) + perm32(R & 31)) : R;
        voffA[i] = (unsigned)(R * K + C) * 2u; voffB[i] = (unsigned)(Rb * K + C) * 2u; }
    const size_t kstep = (size_t)(BK * 2);
    const size_t hstep = (size_t)HALF * K * 2;
    const size_t tstep = 2 * hstep;
    const unsigned ldsw = (unsigned)wid * 1024u;
    const int aoff = lds_byte(wr * 64 + fr, fq * 8), boff = lds_byte(wc * 32 + fr, fq * 8);
#define PG8_SA(b, h) (((b) * 2 + (h)) * HTB)
#define PG8_SB(b, h) ((4 + (b) * 2 + (h)) * HTB)
#define PG8_STAGE(bufoff, gbase, voff) do { _Pragma("unroll") for (int _i = 0; _i < 2; ++_i) \
        __builtin_amdgcn_global_load_lds((const unsigned*)((const char*)(gbase) + (voff)[_i]), (PG8_LAS unsigned*)(lds + (bufoff) + ldsw + _i * 8192), 16, 0, 0); } while (0)
#define PG8_LDA(dst, b, h) do { _Pragma("unroll") for (int m = 0; m < 4; ++m) _Pragma("unroll") for (int k = 0; k < 2; ++k) dst[m][k] = *(const PG8_LAS bf16x8*)(lds + PG8_SA(b, h) + aoff + m * 2048 + k * 1024); } while (0)
#define PG8_LDB(dst, b, h) do { _Pragma("unroll") for (int n = 0; n < 2; ++n) _Pragma("unroll") for (int k = 0; k < 2; ++k) dst[n][k] = *(const PG8_LAS bf16x8*)(lds + PG8_SB(b, h) + boff + n * 2048 + k * 1024); } while (0)
#define PG8_MMA(ai, bj, At, Bt) do { __builtin_amdgcn_s_setprio(1); _Pragma("unroll") for (int m = 0; m < 4; ++m) _Pragma("unroll") for (int n = 0; n < 2; ++n) _Pragma("unroll") for (int k = 0; k < 2; ++k) \
        acc[ai][bj][m][n] = __builtin_amdgcn_mfma_f32_16x16x32_bf16(Bt[n][k], At[m][k], acc[ai][bj][m][n], 0, 0, 0); __builtin_amdgcn_s_setprio(0); } while (0)
#define PG8_WAIT_V(n) asm volatile("s_waitcnt vmcnt(" #n ")" ::: "memory")
#define PG8_WAIT_L(n) asm volatile("s_waitcnt lgkmcnt(" #n ")" ::: "memory")
#define PG8_BAR __builtin_amdgcn_s_barrier()
#define PG8_SCHED __builtin_amdgcn_sched_barrier(0)
    Unit cur, nxt; int ui = 0;
    if (!S.next(0, cur)) return;
    f32x4 acc[2][2][4][2];
#pragma unroll
    for (int a = 0; a < 2; ++a)
#pragma unroll
        for (int b = 0; b < 2; ++b)
#pragma unroll
            for (int m = 0; m < 4; ++m)
#pragma unroll
                for (int n = 0; n < 2; ++n) acc[a][b][m][n] = (f32x4){0.f, 0.f, 0.f, 0.f};
    bf16x8 At[4][2], B0[2][2], B1[2][2];
    const char* cA = (const char*)g.A + (size_t)cur.pm * tstep; const char* cB = (const char*)g.Bt + (size_t)cur.pn * tstep;
    S.a_ready(cur);
    if constexpr (SP2) {
        PG8_STAGE(PG8_SB(0, 0), cB, voffB); PG8_STAGE(PG8_SB(0, 1), cB + hstep, voffB); PG8_STAGE(PG8_SA(0, 0), cA, voffA); PG8_STAGE(PG8_SA(0, 1), cA + hstep, voffA);
        if (wr == 1) PG8_BAR;
        PG8_WAIT_V(2); PG8_BAR;
        PG8_STAGE(PG8_SB(1, 0), cB + kstep, voffB); PG8_STAGE(PG8_SA(1, 0), cA + kstep, voffA); PG8_STAGE(PG8_SB(1, 1), cB + hstep + kstep, voffB);
        PG8_WAIT_V(6); PG8_BAR;
    } else {
        PG8_STAGE(PG8_SB(0, 0), cB, voffB); PG8_STAGE(PG8_SA(0, 0), cA, voffA); PG8_STAGE(PG8_SB(0, 1), cB + hstep, voffB); PG8_STAGE(PG8_SA(0, 1), cA + hstep, voffA);
        if (wr == 1) PG8_BAR;
        PG8_WAIT_V(4); PG8_BAR;
        PG8_STAGE(PG8_SB(1, 0), cB + kstep, voffB); PG8_STAGE(PG8_SA(1, 0), cA + kstep, voffA); PG8_STAGE(PG8_SB(1, 1), cB + hstep + kstep, voffB);
        PG8_WAIT_V(6); PG8_BAR;
    }
    for (;;) {
        const bool has_next = S.next(ui + 1, nxt);
        const char* nA = has_next ? (const char*)g.A + (size_t)nxt.pm * tstep : cA; const char* nB = has_next ? (const char*)g.Bt + (size_t)nxt.pn * tstep : cB;
        for (int t = 0; t < nt; t += 2) {
            const bool last = (t == nt - 2);
            const char* a1 = cA + (size_t)(t + 1) * kstep;
            const char* a2 = last ? nA : cA + (size_t)(t + 2) * kstep; const char* b2 = last ? nB : cB + (size_t)(t + 2) * kstep;
            const char* a3 = a2 + kstep; const char* b3 = b2 + kstep;
            if (last && has_next) S.a_ready(nxt);
            if constexpr (SP2) {
            PG8_LDB(B0, 0, 0); PG8_LDB(B1, 0, 1); PG8_SCHED; PG8_LDA(At, 0, 0); PG8_STAGE(PG8_SA(1, 1), a1 + hstep, voffA);
            PG8_WAIT_V(8); PG8_WAIT_L(0); PG8_BAR; PG8_MMA(0, 0, At, B0); PG8_MMA(0, 1, At, B1); PG8_BAR; PG8_SCHED;
            PG8_LDA(At, 0, 1); PG8_STAGE(PG8_SB(0, 0), b2, voffB); PG8_STAGE(PG8_SB(0, 1), b2 + hstep, voffB); PG8_STAGE(PG8_SA(0, 0), a2, voffA);
            PG8_WAIT_V(8); PG8_WAIT_L(0); PG8_BAR; PG8_MMA(1, 0, At, B0); PG8_MMA(1, 1, At, B1); PG8_BAR; PG8_SCHED;
            PG8_LDB(B0, 1, 0); PG8_LDB(B1, 1, 1); PG8_SCHED; PG8_LDA(At, 1, 0); PG8_STAGE(PG8_SA(0, 1), a2 + hstep, voffA);
            PG8_WAIT_V(8); PG8_WAIT_L(0); PG8_BAR; PG8_MMA(0, 0, At, B0); PG8_MMA(0, 1, At, B1); PG8_BAR; PG8_SCHED;
            PG8_LDA(At, 1, 1); PG8_STAGE(PG8_SB(1, 0), b3, voffB); PG8_STAGE(PG8_SB(1, 1), b3 + hstep, voffB); PG8_STAGE(PG8_SA(1, 0), a3, voffA);
            PG8_WAIT_V(8); PG8_WAIT_L(0); PG8_BAR; PG8_MMA(1, 0, At, B0); PG8_MMA(1, 1, At, B1); PG8_BAR; PG8_SCHED;
            } else {
            PG8_LDB(B0, 0, 0); PG8_SCHED; PG8_LDA(At, 0, 0); PG8_STAGE(PG8_SA(1, 1), a1 + hstep, voffA);
            PG8_WAIT_L(8); PG8_BAR; PG8_WAIT_L(0); PG8_MMA(0, 0, At, B0); PG8_BAR; PG8_SCHED;
            PG8_LDB(B1, 0, 1); PG8_STAGE(PG8_SB(0, 0), b2, voffB);
            PG8_BAR; PG8_WAIT_L(0); PG8_MMA(0, 1, At, B1); PG8_BAR;
            PG8_LDA(At, 0, 1); PG8_STAGE(PG8_SA(0, 0), a2, voffA);
            PG8_BAR; PG8_WAIT_L(0); PG8_MMA(1, 0, At, B0); PG8_BAR; PG8_SCHED;
            PG8_STAGE(PG8_SB(0, 1), b2 + hstep, voffB);
            PG8_WAIT_V(6); PG8_BAR; PG8_MMA(1, 1, At, B1); PG8_BAR;
            PG8_LDB(B0, 1, 0); PG8_SCHED; PG8_LDA(At, 1, 0); PG8_STAGE(PG8_SA(0, 1), a2 + hstep, voffA);
            PG8_WAIT_L(8); PG8_BAR; PG8_WAIT_L(0); PG8_MMA(0, 0, At, B0); PG8_BAR; PG8_SCHED;
            PG8_LDB(B1, 1, 1); PG8_STAGE(PG8_SB(1, 0), b3, voffB);
            PG8_BAR; PG8_WAIT_L(0); PG8_MMA(0, 1, At, B1); PG8_BAR;
            PG8_LDA(At, 1, 1); PG8_STAGE(PG8_SA(1, 0), a3, voffA);
            PG8_BAR; PG8_WAIT_L(0); PG8_MMA(1, 0, At, B0); PG8_BAR; PG8_SCHED;
            PG8_STAGE(PG8_SB(1, 1), b3 + hstep, voffB);
            PG8_WAIT_V(6); PG8_BAR; PG8_MMA(1, 1, At, B1); PG8_BAR;
            }
        }
        if constexpr (ALIGN_EPI) { if (wr == 0) PG8_BAR; }
        if constexpr (!Epi::AFTER_DRAIN) { E(acc, cur, wr, wc, fr, fq); S.done(cur); }
        if (!has_next) break;
#pragma unroll
        for (int a = 0; a < 2; ++a)
#pragma unroll
            for (int b = 0; b < 2; ++b)
#pragma unroll
                for (int m = 0; m < 4; ++m)
#pragma unroll
                    for (int n = 0; n < 2; ++n) acc[a][b][m][n] = (f32x4){0.f, 0.f, 0.f, 0.f};
        cur = nxt; cA = nA; cB = nB; ++ui;
        if constexpr (ALIGN_EPI) { if (wr == 1) PG8_BAR; }
    }
    PG8_WAIT_V(0);
    if constexpr (!ALIGN_EPI) { if (wr == 0) PG8_BAR; }
    PG8_BAR;
    if constexpr (Epi::AFTER_DRAIN) { E.fused(acc, cur, wr, wc, fr, fq, lds, wid, lane); S.done(cur); }
#undef PG8_SA
#undef PG8_SB
#undef PG8_STAGE
#undef PG8_LDA
#undef PG8_LDB
#undef PG8_MMA
#undef PG8_WAIT_V
#undef PG8_WAIT_L
#undef PG8_BAR
#undef PG8_SCHED
}
}
#define GAS __attribute__((address_space(1)))
#define LAS __attribute__((address_space(3)))
#define DI __device__ __forceinline__
typedef unsigned short bf16;
typedef float f32x2 __attribute__((ext_vector_type(2)));
typedef float f32x4 __attribute__((ext_vector_type(4)));
typedef float f32x16 __attribute__((ext_vector_type(16)));
typedef short bf16x8 __attribute__((ext_vector_type(8)));
typedef unsigned u32x2 __attribute__((ext_vector_type(2)));
typedef unsigned u32x4 __attribute__((ext_vector_type(4)));
#define MFMA32(a, b, c) __builtin_amdgcn_mfma_f32_32x32x16_bf16((a), (b), (c), 0, 0, 0)

#ifndef MK_ONE_LAUNCH
#define MK_ONE_LAUNCH 1
#endif
namespace mk {
constexpr int NWAVES = 8, NTHR = 512;
constexpr int D = 1024, M = 12288, MPR = 4096;
constexpr int NPROJ = 2304, FF = 2816;
constexpr float EPS = 1e-6f;
constexpr int NPHASES = 18;
constexpr size_t OFF_C = 12582912, OFF_N = 14680064, OFF_MM = 14696448, OFF_K = 14696576, OFF_V = 18890880;
constexpr size_t MiB = 1u << 20;
constexpr size_t WS_CTL = 0, CTL_ZERO_BYTES = 1 * MiB;
constexpr size_t WS_MODP = 105 * MiB;
constexpr size_t WS_MODF = 5 * MiB;
constexpr size_t WS_GATES = 6 * MiB;
constexpr size_t WS_AS = 7 * MiB, WS_MS = 7 * MiB + 512 * 1024, WS_BS = 8 * MiB;
constexpr size_t WS_H2 = 10 * MiB;
constexpr size_t WS_NS = 9 * MiB;
constexpr size_t WS_R2048 = 12 * MiB;
constexpr size_t WS_R256 = 16 * MiB;
constexpr size_t WS_CK = 22 * MiB, WS_CV = 26 * MiB;
constexpr size_t WS_WAB = 30 * MiB, WS_WHY = 35 * MiB, WS_WOAB = 38 * MiB, WS_WC = 40 * MiB, WS_WOC = 46 * MiB, WS_WUP = 48 * MiB, WS_WDN = 70 * MiB;
constexpr size_t WS_H = 81 * MiB;
constexpr size_t WS_BIG = 105 * MiB;
constexpr size_t WS_VO = WS_BIG;
constexpr size_t WS_HYT = 129 * MiB;
constexpr size_t WS_QKBND = 166 * MiB;
constexpr size_t WS_QB = 195 * MiB, WS_KB = 207 * MiB;
constexpr size_t WS_FG = 171 * MiB;
constexpr size_t WS_ABND = 140 * MiB, WS_GBND = 144 * MiB;
constexpr size_t WS_Q1 = WS_BIG, WS_K1 = 129 * MiB, WS_V1 = 153 * MiB;
constexpr size_t WS_DL = WS_BIG;
constexpr size_t WS_END = 256 * MiB;
constexpr int CW_BAR = 4096;
constexpr int RING_BYTES = 131072, LDSCTL_OFF = RING_BYTES, MISC_OFF = LDSCTL_OFF + 320, XCH_OFF = RING_BYTES + 1024, LDS_BYTES = 147456;

DI float bf2f(unsigned short b) { return __uint_as_float((unsigned)b << 16); }
DI unsigned pk2(float lo, float hi) { return pg8::pkbf(lo, hi); }
DI void unpack8(const u32x4 v, float (&f)[8]) {
    f[0] = __uint_as_float(v.x << 16); f[1] = __uint_as_float(v.x & 0xffff0000u); f[2] = __uint_as_float(v.y << 16); f[3] = __uint_as_float(v.y & 0xffff0000u);
    f[4] = __uint_as_float(v.z << 16); f[5] = __uint_as_float(v.z & 0xffff0000u); f[6] = __uint_as_float(v.w << 16); f[7] = __uint_as_float(v.w & 0xffff0000u); }
DI u32x4 pack8(const float (&f)[8]) { u32x4 w; w.x = pk2(f[0], f[1]); w.y = pk2(f[2], f[3]); w.z = pk2(f[4], f[5]); w.w = pk2(f[6], f[7]); return w; }
DI float rcp_f(float x) { return __builtin_amdgcn_rcpf(x); }
DI float exp2_f(float x) { return __builtin_amdgcn_exp2f(x); }
DI float silu_f(float x) { return x * rcp_f(1.f + exp2_f(-1.4426950408889634f * x)); }
DI float sigm_f(float x) { return rcp_f(1.f + exp2_f(-1.4426950408889634f * x)); }
DI float gelu_tanh_f(float x) { const float u2 = x * (-2.3022081986f + -0.1029432396f * x * x); return x * rcp_f(1.f + exp2_f(u2)); }
DI float logsig_f(float x) { return fminf(x, 0.f) - log1pf(__expf(-fabsf(x))); }
DI float wave_sum(float v) {
#pragma unroll
    for (int o = 1; o < 64; o <<= 1) v += __shfl_xor(v, o);
    return v; }
#define LDS_WAIT() asm volatile("s_waitcnt lgkmcnt(0)" ::: "memory")

#define XB_TMO      128
#define XB_XCNT(j)  (256  + 64 * (j))
#define XB_XSUB(j)  (1280 + 64 * (j))
#define XB_XGEN(j)  (2304 + 64 * (j))
#define XB_TOP      3328
#define XB_TOPGEN   3392
#define XCD_BAR_WORDS 3456
#define XB_SPIN_CAP (1u << 20)
DI unsigned xb_ld(unsigned* p)              { return __hip_atomic_load(p, __ATOMIC_RELAXED, __HIP_MEMORY_SCOPE_AGENT); }
DI unsigned xb_add(unsigned* p, unsigned v) { return __hip_atomic_fetch_add(p, v, __ATOMIC_RELAXED, __HIP_MEMORY_SCOPE_AGENT); }
DI unsigned xb_xcc_id() { return (unsigned)__builtin_amdgcn_s_getreg((3 << 11) | 20) & 0xFu; }
#define XB_SPIN(cond, bar) do { unsigned _sp = 0; while (cond) { __builtin_amdgcn_s_sleep(1); \
    if ((++_sp & 255u) == 0u) { if (xb_ld(&(bar)[XB_TMO])) break; if (_sp > XB_SPIN_CAP) { atomicAdd(&(bar)[XB_TMO], 1u); break; } } } } while (0)
struct XcdBarrier { unsigned* bar; unsigned x; volatile LAS unsigned* st; };
DI XcdBarrier xcd_barrier_post(unsigned* bar, volatile LAS unsigned* st) {
    XcdBarrier b; b.bar = bar; b.x = xb_xcc_id(); b.st = st;
    if (threadIdx.x == 0) (void)xb_add(&bar[XB_XCNT(b.x)], 1u);
    return b;
}
DI void xcd_barrier_complete(unsigned* bar, unsigned x, unsigned& nloc, unsigned& nx) {
    const unsigned G = gridDim.x * gridDim.y * gridDim.z;
    unsigned sum, cnt, mine, sp = 0u;
    for (;;) {
        sum = 0u; cnt = 0u; mine = 0u;
#pragma unroll
        for (unsigned j = 0; j < 16; ++j) { const unsigned c = xb_ld(&bar[XB_XCNT(j)]); sum += c; cnt += (c > 0u) ? 1u : 0u; mine = (j == x) ? c : mine; }
        if (sum == G) break;
        __builtin_amdgcn_s_sleep(1);
        if ((++sp & 255u) == 0u) { if (xb_ld(&bar[XB_TMO])) break; if (sp > XB_SPIN_CAP) { atomicAdd(&bar[XB_TMO], 1u); break; } }
    }
    nloc = mine > 0u ? mine : 1u; nx = cnt > 0u ? cnt : 1u;
}
DI void xcd_barrier(const XcdBarrier& b) {
    asm volatile("s_waitcnt vmcnt(0)" ::: "memory");
    __syncthreads();
    if (threadIdx.x == 0) {
        unsigned* bar = b.bar;
        __builtin_amdgcn_s_waitcnt(0);
        unsigned nloc = b.st[0], nx = b.st[1];
        if (nloc == 0u) { xcd_barrier_complete(bar, b.x, nloc, nx); b.st[0] = nloc; b.st[1] = nx; }
        const unsigned old = xb_add(&bar[XB_XSUB(b.x)], 1u);
        const unsigned gen = old / nloc;
        if (old + 1u == (gen + 1u) * nloc) {
            __builtin_amdgcn_fence(__ATOMIC_RELEASE, "agent");
            asm volatile("s_waitcnt vmcnt(0)" ::: "memory");
            const unsigned og = xb_add(&bar[XB_TOP], 1u);
            const unsigned tg = og / nx;
            if (og + 1u == (tg + 1u) * nx) xb_add(&bar[XB_TOPGEN], 1u);
            else XB_SPIN(xb_ld(&bar[XB_TOPGEN]) == tg, bar);
            __builtin_amdgcn_fence(__ATOMIC_ACQUIRE, "agent");
            xb_add(&bar[XB_XGEN(b.x)], 1u);
            asm volatile("s_waitcnt vmcnt(0)" ::: "memory");
        } else {
            XB_SPIN(xb_ld(&bar[XB_XGEN(b.x)]) == gen, bar);
            __builtin_amdgcn_fence(__ATOMIC_ACQUIRE, "agent");
            asm volatile("s_waitcnt vmcnt(0)" ::: "memory");
        }
    }
    __syncthreads();
}

struct Args { const float* in[33]; float* out; unsigned char* ws; int ph_lo, ph_hi; };
enum { I_XP = 0, I_XS, I_STC, I_STN, I_STM, I_CK, I_CV, I_C, I_CCTX, I_WADA, I_BADA, I_GMIX, I_GFFN, I_GFIN, I_WINAB, I_BGATES, I_WCQK, I_GMLSTM, I_WCHY,
       I_WF1, I_BF1, I_WF2, I_BF2, I_WF3, I_FREQ, I_HYB, I_WOUTAB, I_WINC, I_RPB, I_WOUTC, I_WUP, I_WCFFN, I_WDOWN };

DI void row_seq(int row, int& base, int& L) { if (row < MPR) { base = row & ~255; L = 256; } else { base = MPR + ((row - MPR) & ~2047); L = 2048; } }
DI int row_vec(int row) { return row < MPR ? 4 : ((row - MPR) >> 11); }
template <bool FFN_PERM = false> DI void p0_transpose_tile(const float* W, int K, int N, int Npad, bf16* WT, LAS float* T, int item, int tid, int ldw = 0) {
    if (ldw == 0) ldw = N;
    const int nblk = Npad / 256, kb = item / nblk, nb = item % nblk, k0 = 64 * kb, n0 = 256 * nb;
    __syncthreads();
    { const int col = n0 + (tid & 63) * 4; const bool ok = col < N; const float* src = W + (size_t)k0 * ldw + col;
      f32x4 v[8];
#pragma unroll
      for (int i = 0; i < 8; ++i) { const int kk = i * 8 + (tid >> 6); v[i] = ok ? *(const f32x4*)(src + (size_t)kk * ldw) : (f32x4){0.f, 0.f, 0.f, 0.f}; }
#pragma unroll
      for (int i = 0; i < 8; ++i) { const int kk = i * 8 + (tid >> 6); *(LAS f32x4*)(T + kk * 260 + (tid & 63) * 4) = v[i]; } }
    __syncthreads();
#pragma unroll
    for (int j = 0; j < 4; ++j) { const int n = tid & 255, kg = (tid >> 8) + 2 * j; const LAS float* p = T + (8 * kg) * 260 + n;
        u32x4 o; o.x = pk2(p[0], p[260]); o.y = pk2(p[520], p[780]); o.z = pk2(p[1040], p[1300]); o.w = pk2(p[1560], p[1820]);
        int dr = n0 + n;
        if (FFN_PERM) { const int gsel = dr >= 2816, c = gsel ? dr - 2816 : dr; dr = (c >> 7) * 256 + gsel * 128 + (c & 127); }
        *(u32x4*)(WT + (size_t)dr * K + k0 + 8 * kg) = o; }
}
DI void p0_filter_stage1(const Args& a, int L, int p0, int gcol0, float* H2, LAS float* T, int tid, int lane, int wave) {
    const float* b1 = a.in[I_BF1]; const float* b2 = a.in[I_BF2]; const float* fr = a.in[I_FREQ];
    LAS float* w1s = T; LAS float* w2s = T + 2112; LAS float* hs = T + 2112 + 4096;
    __syncthreads();
    for (int i = tid; i < 2112; i += NTHR) w1s[i] = a.in[I_WF1][i];
    for (int i = tid; i < 4096; i += NTHR) w2s[i] = a.in[I_WF2][i];
    __syncthreads();
    const int p = p0 + lane; const float tpos = (float)p / (float)(L - 1), wrev = (float)p / (float)L;
    float z[33]; z[0] = tpos;
#pragma unroll
    for (int k = 0; k < 16; ++k) { const float band = 1e-4f + (float)k * ((15.0f - 1e-4f) / 15.0f); const float rv = band * wrev; const float ph = 6.283185307179586f * (rv - floorf(rv));
        z[1 + k] = __cosf(ph); z[17 + k] = -__sinf(ph); }
#pragma unroll
    for (int jj = 0; jj < 8; ++jj) { const int j = 8 * wave + jj; float t = b1[j];
#pragma unroll
        for (int i = 0; i < 33; ++i) t += z[i] * w1s[i * 64 + j];
        hs[j * 64 + lane] = sinf(fr[j] * t); }
    __syncthreads();
    float acc[8];
#pragma unroll
    for (int jj = 0; jj < 8; ++jj) acc[jj] = b2[8 * wave + jj];
#pragma unroll 8
    for (int i = 0; i < 64; ++i) { const float hv = hs[i * 64 + lane]; const LAS float* wr = w2s + i * 64 + 8 * wave;
#pragma unroll
        for (int jj = 0; jj < 8; ++jj) acc[jj] += hv * wr[jj]; }
#pragma unroll
    for (int jj = 0; jj < 8; ++jj) { const int j = 8 * wave + jj; H2[(size_t)j * 2304 + gcol0 + lane] = sinf(fr[j] * acc[jj]); }
}
DI void p1_filter_stage2(const Args& a, int L, int p0, int gcol0, int cb, const float* H2, bf16* R, LAS float* w3t, int lane) {
    const float* w3 = a.in[I_WF3];
    const int p = p0 + lane; const float tpos = (float)p / (float)(L - 1);
    float h2[64];
#pragma unroll
    for (int i = 0; i < 64; ++i) h2[i] = H2[(size_t)i * 2304 + gcol0 + lane];
#pragma unroll
    for (int r = 0; r < 16; ++r) { const int i = (lane >> 4) + 4 * r; w3t[(lane & 15) * 64 + i] = w3[i * 1024 + cb * 16 + (lane & 15)]; }
    LDS_WAIT(); asm volatile("" ::: "memory");
    const float mind = -3.0701134573f, maxd = -15.3505672866f;
#pragma unroll 2
    for (int cc = 0; cc < 16; ++cc) { const int c = cb * 16 + cc, c5 = c & 511; float t0 = 0.f, t1 = 0.f, t2 = 0.f, t3 = 0.f;
#pragma unroll
        for (int q = 0; q < 16; ++q) { const f32x4 w = *(const LAS f32x4*)(w3t + cc * 64 + 4 * q); t0 += h2[4 * q] * w[0]; t1 += h2[4 * q + 1] * w[1]; t2 += h2[4 * q + 2] * w[2]; t3 += h2[4 * q + 3] * w[3]; }
        const float delta = fabsf(mind + (float)c5 * ((maxd - mind) / 511.0f)); const float v = ((t0 + t1) + (t2 + t3)) * __expf(-tpos * delta);
        const bf16 vb = (bf16)(pk2(v, 0.f) & 0xffffu);
        if (c < 512) { R[(size_t)c * (2 * L) + (L - p)] = vb; if (p == 0) R[(size_t)c * (2 * L)] = 0; }
        else if (p >= 1) R[(size_t)c5 * (2 * L) + (L + p)] = vb; }
    LDS_WAIT(); asm volatile("" ::: "memory");
}
DI void bg_convert(const Args& a, LAS unsigned char* lds, int set, int widx, int nw, int tid) {
    unsigned char* ws = a.ws; LAS float* T = (LAS float*)lds;
    constexpr int I2 = 16 * 12, I3 = 16 * 4, I4 = 16 * 22, I5 = 44 * 4;
    if (set == 0) { for (int r = widx; r < I4; r += nw) p0_transpose_tile<true>(a.in[I_WUP], 1024, 5632, 5632, (bf16*)(ws + WS_WUP), T, r, tid); }
    else if (set == 1) { for (int r = widx; r < I5; r += nw) p0_transpose_tile(a.in[I_WDOWN], 2816, 1024, 1024, (bf16*)(ws + WS_WDN), T, r, tid); }
    else if (set == 2) { for (int r = widx; r < I2 + I3; r += nw) {
            if (r < I2) p0_transpose_tile(a.in[I_WINC], 1024, 3072, 3072, (bf16*)(ws + WS_WC), T, r, tid);
            else p0_transpose_tile(a.in[I_WOUTC], 1024, 1024, 1024, (bf16*)(ws + WS_WOC), T, r - I2, tid); } }
    else { for (int r = widx; r < I4 + I5; r += nw) {
            if (r < I4) p0_transpose_tile<true>(a.in[I_WUP] + (size_t)1024 * 5632, 1024, 5632, 5632, (bf16*)(ws + WS_WUP) + (size_t)5632 * 1024, T, r, tid);
            else p0_transpose_tile(a.in[I_WDOWN] + (size_t)2816 * 1024, 2816, 1024, 1024, (bf16*)(ws + WS_WDN) + (size_t)1024 * 2816, T, r - I4, tid); } }
    __syncthreads();
}
DI void ph_prologue(const Args& a, LAS unsigned char* lds, int tid, int lane, int wave, int bid, int G) {
    unsigned char* ws = a.ws;
    constexpr int NF1 = 36, NA = 192, I0 = 16 * 9, IH = 16 * 6, I1 = 16 * 4, NT = I0 + IH + I1;
    LAS float* T = (LAS float*)lds;
#ifndef MK_P0A
#define MK_P0A 1
#define MK_P0T 1
#define MK_P0F 1
#endif
    for (int rep_ = 0; rep_ < (MK_P0A > MK_P0T ? (MK_P0A > MK_P0F ? MK_P0A : MK_P0F) : (MK_P0T > MK_P0F ? MK_P0T : MK_P0F)); ++rep_)
    for (int it0 = bid; it0 < NF1 + NA + NT; it0 += G) {
        if (it0 < NF1) { if (rep_ < MK_P0F) p0_filter_stage1(a, it0 < 32 ? 2048 : 256, it0 < 32 ? 64 * it0 : 64 * (it0 - 32), 64 * it0, (float*)(ws + WS_H2), T, tid, lane, wave); continue; }
        const int it = it0 - NF1;
        if (it < NA ? rep_ >= MK_P0A : rep_ >= MK_P0T) continue;
        if (it < NA) {
            const int l = it / 96, rem = it % 96, cb = rem >> 5, ks = rem & 31;
            __syncthreads();
            if (tid < 160) { const int v = tid >> 5, k = tid & 31; const float cv = v < 4 ? a.in[I_C][v * 1024 + ks * 32 + k] : a.in[I_CCTX][ks * 32 + k]; T[tid] = silu_f(cv); }
            __syncthreads();
            const int col = cb * 2048 + tid * 4; const float* w = a.in[I_WADA] + ((size_t)(l * 1024 + ks * 32)) * 6144 + col;
            f32x4 a0 = {0.f, 0.f, 0.f, 0.f}, a1 = a0, a2 = a0, a3 = a0, a4 = a0;
#pragma unroll
            for (int kb = 0; kb < 2; ++kb) { f32x4 wv[16];
#pragma unroll
                for (int k = 0; k < 16; ++k) wv[k] = *(const f32x4*)(w + (size_t)(16 * kb + k) * 6144);
#pragma unroll
                for (int k = 0; k < 16; ++k) { const int kk = 16 * kb + k; a0 += wv[k] * T[kk]; a1 += wv[k] * T[32 + kk]; a2 += wv[k] * T[64 + kk]; a3 += wv[k] * T[96 + kk]; a4 += wv[k] * T[128 + kk]; } }
            float* o = (float*)(ws + WS_MODP) + ((size_t)((ks * 2 + l) * 5)) * 6144 + col;
            *(f32x4*)o = a0; *(f32x4*)(o + 6144) = a1; *(f32x4*)(o + 2 * 6144) = a2; *(f32x4*)(o + 3 * 6144) = a3; *(f32x4*)(o + 4 * 6144) = a4;
            continue;
        }
        int r = it - NA;
        if (r < I0) { p0_transpose_tile(a.in[I_WINAB], 1024, 2064, 2304, (bf16*)(ws + WS_WAB), T, r, tid, 3600); continue; } r -= I0;
        if (r < IH) { p0_transpose_tile(a.in[I_WINAB] + 2064, 1024, 1536, 1536, (bf16*)(ws + WS_WHY), T, r, tid, 3600); continue; } r -= IH;
        p0_transpose_tile(a.in[I_WOUTAB], 1024, 1024, 1024, (bf16*)(ws + WS_WOAB), T, r, tid);
    }
    __syncthreads();
    { const int gt = bid * NTHR + tid, NGT = G * NTHR;
      for (int i = gt; i < 2 * 262144; i += NGT) { const int which = i >= 262144, j = which ? i - 262144 : i;
        const float* src = a.in[which ? I_CV : I_CK] + (size_t)j * 8; bf16* dst = (bf16*)(ws + (which ? WS_CV : WS_CK)) + (size_t)j * 8;
        const f32x4 x0 = *(const f32x4*)src, x1 = *(const f32x4*)(src + 4);
        u32x4 o; o.x = pk2(x0[0], x0[1]); o.y = pk2(x0[2], x0[3]); o.z = pk2(x1[0], x1[1]); o.w = pk2(x1[2], x1[3]); *(u32x4*)dst = o; } }
}
DI void ph_modf_norm0(const Args& a, LAS unsigned char* lds, int tid, int lane, int wave, int bid, int G) {
    const float* modP = (const float*)(a.ws + WS_MODP); float* modF = (float*)(a.ws + WS_MODF); const float* bada = a.in[I_BADA];
    for (int i = bid * NTHR + tid; i < 2 * 5 * 6144; i += G * NTHR) { const int l = i / 30720, rem = i % 30720, v = rem / 6144, col = rem % 6144;
        float s = bada[l * 6144 + col];
#pragma unroll 8
        for (int ks = 0; ks < 32; ++ks) s += modP[((size_t)((ks * 2 + l) * 5 + v)) * 6144 + col];
        modF[i] = s; }
    const int rpw = (M + G - 1) / G, r0 = rpw * bid, r1 = (r0 + rpw < M) ? r0 + rpw : M;
    LAS float* shs = (LAS float*)lds;
    for (int v = 0; v < 5; ++v) {
        const bool need = r0 < r1 && (v == 4 ? (r0 < MPR) : (r1 > MPR && ((r0 > MPR ? r0 : MPR) - MPR) >> 11 <= v && v <= ((r1 - 1 - MPR) >> 11)));
        if (!need) continue;
        { const int i = tid; const int ch = i >> 8, c4 = (i & 255) * 4;
            f32x4 s = *(const f32x4*)(bada + ch * 1024 + c4);
#pragma unroll 8
            for (int ks = 0; ks < 32; ++ks) s += *(const f32x4*)(modP + ((size_t)((ks * 2 + 0) * 5 + v)) * 6144 + ch * 1024 + c4);
            *(LAS f32x4*)(shs + (v * 2 + ch) * 1024 + c4) = s; }
    }
    const int NGW = G * NWAVES;
    for (int it = wave * G + bid; it < 2304; it += NGW) { const int pg = it >> 6, cb = it & 63;
        p1_filter_stage2(a, pg < 32 ? 2048 : 256, pg < 32 ? 64 * pg : 64 * (pg - 32), 64 * pg, cb, (const float*)(a.ws + WS_H2), (bf16*)(a.ws + (pg < 32 ? WS_R2048 : WS_R256)), (LAS float*)(lds + 65536 + wave * 4096), lane); }
    __syncthreads();
    { const float* xsB = a.in[I_XS] - (size_t)MPR * D; const float* gvec = a.in[I_GMIX]; bf16* hbuf = (bf16*)(a.ws + WS_H);
        for (int row = r0 + wave; row < r1; row += NWAVES) {
            const float* xr = (row < MPR ? a.in[I_XP] : xsB) + (size_t)row * D; const int slot = row_vec(row);
            f32x4 x[4]; float ss = 0.f;
#pragma unroll
            for (int j = 0; j < 4; ++j) { x[j] = *(const f32x4*)(xr + 4 * lane + 256 * j); ss += (x[j][0] * x[j][0] + x[j][1] * x[j][1]) + (x[j][2] * x[j][2] + x[j][3] * x[j][3]); }
            const float rstd = rsqrtf(wave_sum(ss) * (1.f / D) + EPS);
#pragma unroll
            for (int j = 0; j < 4; ++j) { const int col = 4 * lane + 256 * j; const f32x4 g = *(const f32x4*)(gvec + col), sh = *(const LAS f32x4*)(shs + (slot * 2 + 0) * 1024 + col), sc = *(const LAS f32x4*)(shs + (slot * 2 + 1) * 1024 + col);
                const f32x4 y = x[j] * rstd * g * (sc + 1.f) + sh; u32x2 o; o.x = pk2(y[0], y[1]); o.y = pk2(y[2], y[3]); *(u32x2*)(hbuf + (size_t)row * D + col) = o; }
        }
    }
}
DI void ph_norm(const float* xA, const float* xB, const bf16* delta, float* xout, const float* gvec, const float* mod5  , int chS, int chC, bf16* hbuf, int gw, int NGW, int lane) {
    for (int row0 = gw; row0 < M; row0 += 2 * NGW) {
        f32x4 x[2][4]; u32x2 dq[2][4];
#pragma unroll
        for (int r = 0; r < 2; ++r) { const int row = row0 + r * NGW; if (row < M) { const float* xr = (row < MPR ? xA : xB) + (size_t)row * D;
#pragma unroll
            for (int j = 0; j < 4; ++j) { x[r][j] = *(const f32x4*)(xr + 4 * lane + 256 * j); if (delta) dq[r][j] = *(const u32x2*)(delta + (size_t)row * D + 4 * lane + 256 * j); } } }
#pragma unroll
        for (int r = 0; r < 2; ++r) { const int row = row0 + r * NGW; if (row < M) { const int v = row_vec(row);
            const float* shp = mod5 + (size_t)v * 6144 + chS * 1024; const float* scp = mod5 + (size_t)v * 6144 + chC * 1024; float ss = 0.f;
            if (delta) {
#pragma unroll
                for (int j = 0; j < 4; ++j) { x[r][j][0] += __uint_as_float(dq[r][j].x << 16); x[r][j][1] += __uint_as_float(dq[r][j].x & 0xffff0000u); x[r][j][2] += __uint_as_float(dq[r][j].y << 16); x[r][j][3] += __uint_as_float(dq[r][j].y & 0xffff0000u);
                    *(f32x4*)(xout + (size_t)row * D + 4 * lane + 256 * j) = x[r][j]; } }
#pragma unroll
            for (int j = 0; j < 4; ++j) ss += (x[r][j][0] * x[r][j][0] + x[r][j][1] * x[r][j][1]) + (x[r][j][2] * x[r][j][2] + x[r][j][3] * x[r][j][3]);
            const float rstd = rsqrtf(wave_sum(ss) * (1.f / D) + EPS);
#pragma unroll
            for (int j = 0; j < 4; ++j) { const int col = 4 * lane + 256 * j; const f32x4 g = *(const f32x4*)(gvec + col), sh = *(const f32x4*)(shp + col), sc = *(const f32x4*)(scp + col);
                const f32x4 y = x[r][j] * rstd * g * (sc + 1.f) + sh; u32x2 o; o.x = pk2(y[0], y[1]); o.y = pk2(y[2], y[3]); *(u32x2*)(hbuf + (size_t)row * D + col) = o; } } }
    }
}
DI void ph_final_norm(float* out, const bf16* delta, const float* gvec, int gw, int NGW, int lane) {
    for (int row0 = gw; row0 < M; row0 += 2 * NGW) {
        f32x4 x[2][4]; u32x2 dq[2][4];
#pragma unroll
        for (int r = 0; r < 2; ++r) { const int row = row0 + r * NGW; if (row < M) {
#pragma unroll
            for (int j = 0; j < 4; ++j) { x[r][j] = *(const f32x4*)(out + (size_t)row * D + 4 * lane + 256 * j); dq[r][j] = *(const u32x2*)(delta + (size_t)row * D + 4 * lane + 256 * j); } } }
#pragma unroll
        for (int r = 0; r < 2; ++r) { const int row = row0 + r * NGW; if (row < M) { float ss = 0.f;
#pragma unroll
            for (int j = 0; j < 4; ++j) { x[r][j][0] += __uint_as_float(dq[r][j].x << 16); x[r][j][1] += __uint_as_float(dq[r][j].x & 0xffff0000u); x[r][j][2] += __uint_as_float(dq[r][j].y << 16); x[r][j][3] += __uint_as_float(dq[r][j].y & 0xffff0000u);
                ss += (x[r][j][0] * x[r][j][0] + x[r][j][1] * x[r][j][1]) + (x[r][j][2] * x[r][j][2] + x[r][j][3] * x[r][j][3]); }
            const float rstd = rsqrtf(wave_sum(ss) * (1.f / D) + EPS);
#pragma unroll
            for (int j = 0; j < 4; ++j) { const int col = 4 * lane + 256 * j; const f32x4 g = *(const f32x4*)(gvec + col); *(f32x4*)(out + (size_t)row * D + col) = x[r][j] * rstd * g; } } }
    }
}
DI void ph_e1(const Args& a, LAS unsigned char* lds, int tid, int gw, int NGW, int lane, int wave, int bid, int G) {
    unsigned char* ws = a.ws;
    { const float* qkb = (const float*)(ws + WS_QKBND); bf16* QB = (bf16*)(ws + WS_QB); const float* w = a.in[I_WCQK];
      for (int i = bid * NTHR + tid; i < 96 * 1024; i += G * NTHR) { const int c = i & 1023, rr = i >> 10, pm = rr >> 1, which = rr & 1, row = pm * 256 + (which ? 255 : 0);
        int sbase, L; row_seq(row, sbase, L);
        float prev, cur, next;
        if (which == 0) { cur = qkb[(size_t)(pm * 4 + 0) * 1024 + c]; next = qkb[(size_t)(pm * 4 + 1) * 1024 + c]; prev = row > sbase ? qkb[(size_t)((pm - 1) * 4 + 3) * 1024 + c] : 0.f; }
        else { cur = qkb[(size_t)(pm * 4 + 3) * 1024 + c]; prev = qkb[(size_t)(pm * 4 + 2) * 1024 + c]; next = row < sbase + L - 1 ? qkb[(size_t)((pm + 1) * 4 + 0) * 1024 + c] : 0.f; }
        const float v = silu_f(w[c] * prev + w[1024 + c] * cur + w[2048 + c] * next) * (c >= 512 ? 0.08838834764831845f : 1.0f);
        QB[(size_t)(c >> 9) * ((size_t)M * 512) + (size_t)row * 512 + (c & 511)] = (bf16)(pk2(v, 0.f) & 0xffffu); } }
    bg_convert(a, lds, 0, bid, G, tid);
    const float* gates = (const float*)(ws + WS_GATES); const float* bg = a.in[I_BGATES];
    float* aS = (float*)(ws + WS_AS); float* MSv = (float*)(ws + WS_MS); float* bS = (float*)(ws + WS_BS);
    for (int it = wave * G + bid; it < 160; it += NGW) {
        const int seq = it >> 3, h = (it >> 1) & 3, dir = it & 1;
        const int L = seq < 16 ? 256 : 2048, base = seq < 16 ? seq * 256 : MPR + (seq - 16) * 2048, per = L / 64;
        const float m0 = seq < 16 ? 0.f : a.in[I_STM][((seq - 16) * 2 + dir) * 4 + h];
        const int gi = dir * 8 + h, gf = dir * 8 + 4 + h; const float bi = bg[gi], bf_ = bg[gf];
        float lf[32], iv[32];
#pragma unroll
        for (int k = 0; k < 32; ++k) if (k < per) { const int p = 64 * k + lane, t = dir ? L - 1 - p : p; const size_t gr = (size_t)(base + t) * 16; lf[k] = gates[gr + gf]; iv[k] = gates[gr + gi]; }
        float cb_ = 0.f, cM = m0;
#pragma unroll
        for (int k = 0; k < 32; ++k) if (k < per) {
            float x = logsig_f(lf[k] + bf_);
#pragma unroll
            for (int o = 1; o < 64; o <<= 1) { const float n = __shfl_up(x, o); if (lane >= o) x += n; }
            const float b = cb_ + x, av = (iv[k] + bi) - b;
            float y = av;
#pragma unroll
            for (int o = 1; o < 64; o <<= 1) { const float n = __shfl_up(y, o); if (lane >= o) y = fmaxf(y, n); }
            const float Mv = fmaxf(cM, y);
            const int p = 64 * k + lane, t = dir ? L - 1 - p : p; const size_t o_ = (size_t)(base + t) * 8 + dir * 4 + h;
            aS[o_] = av; MSv[o_] = Mv; bS[o_] = b;
            cb_ = __shfl(b, 63); cM = __shfl(Mv, 63); }
    }
}
DI void ffn_fix_panel(const Args& a, int layer, int pm, int tid) {
    const float* abnd = (const float*)(a.ws + WS_ABND); const float* gbnd = (const float*)(a.ws + WS_GBND); bf16* act = (bf16*)(a.ws + WS_FG); const float* w = a.in[I_WCFFN] + (size_t)layer * 3 * FF;
    for (int i = tid; i < 2 * FF; i += NTHR) { const int c = i % FF, which = i / FF, row = pm * 256 + (which ? 255 : 0);
        int sbase, L; row_seq(row, sbase, L);
        float prev, cur, next;
        if (which == 0) { cur = abnd[(size_t)(pm * 4 + 0) * FF + c]; next = abnd[(size_t)(pm * 4 + 1) * FF + c]; prev = row > sbase ? abnd[(size_t)((pm - 1) * 4 + 3) * FF + c] : 0.f; }
        else { cur = abnd[(size_t)(pm * 4 + 3) * FF + c]; prev = abnd[(size_t)(pm * 4 + 2) * FF + c]; next = row < sbase + L - 1 ? abnd[(size_t)((pm + 1) * 4 + 0) * FF + c] : 0.f; }
        const float v = w[c] * prev + w[FF + c] * cur + w[2 * FF + c] * next;
        act[(size_t)row * FF + c] = (bf16)(pk2(gelu_tanh_f(v) * gbnd[(size_t)(pm * 2 + which) * FF + c], 0.f) & 0xffffu); }
    asm volatile("s_waitcnt vmcnt(0)" ::: "memory");
    __syncthreads();
}
template <int DK> DI void stage_k_rows(LAS bf16* Kst, const bf16* src, size_t ld, int tid) {
    constexpr int CPR = DK / 8;
#pragma unroll
    for (int c = tid; c < 64 * CPR; c += NTHR) { const int key = c / CPR, ch = c % CPR;
        const u32x4 v = *(const u32x4*)(src + (size_t)key * ld + ch * 8); *(LAS u32x4*)(Kst + key * (DK + 8) + ch * 8) = v; }
}
template <int DV> DI void stage_v_transposed(LAS bf16* Vst, const bf16* src, size_t ld, int tid) {
    constexpr int NCH = DV / 8;
#pragma unroll
    for (int c = tid; c < 64 * NCH; c += NTHR) { const int key = c & 63, ch = c >> 6;
        const u32x4 v = *(const u32x4*)(src + (size_t)key * ld + ch * 8); LAS bf16* d = Vst + (ch * 8) * 72 + key;
        d[0] = (bf16)(v.x & 0xffffu); d[72] = (bf16)(v.x >> 16); d[144] = (bf16)(v.y & 0xffffu); d[216] = (bf16)(v.y >> 16);
        d[288] = (bf16)(v.z & 0xffffu); d[360] = (bf16)(v.z >> 16); d[432] = (bf16)(v.w & 0xffffu); d[504] = (bf16)(v.w >> 16); }
}
DI bf16x8 pack_frag(const f32x16& x, int s) {
    u32x4 p; p.x = pk2(x[8 * s], x[8 * s + 1]); p.y = pk2(x[8 * s + 2], x[8 * s + 3]); p.z = pk2(x[8 * s + 4], x[8 * s + 5]); p.w = pk2(x[8 * s + 6], x[8 * s + 7]);
    return __builtin_bit_cast(bf16x8, p); }
DI bf16x8 ld_vfrag(const LAS bf16* Vst, int e, int s) {
    const u32x2 lo = *(const LAS u32x2*)(Vst + e * 72 + s), hi = *(const LAS u32x2*)(Vst + e * 72 + s + 8);
    u32x4 r; r.x = lo.x; r.y = lo.y; r.z = hi.x; r.w = hi.y; return __builtin_bit_cast(bf16x8, r); }

DI void mlstm_unit(const Args& a, LAS unsigned char* lds, int seq, int h, int qt, int tid, int lane, int wave) {
    unsigned char* ws = a.ws;
    const bf16* QB = (const bf16*)(ws + WS_QB); const bf16* KB = (const bf16*)(ws + WS_KB); const bf16* VO = (const bf16*)(ws + WS_VO);
    const float* aS = (const float*)(ws + WS_AS); const float* MSv = (const float*)(ws + WS_MS); const float* bS = (const float*)(ws + WS_BS);
    float* hscr = a.out + OFF_K;
    bf16* ycat = (bf16*)(ws + WS_H);
    const bool isS = seq >= 16; const int L = isS ? 2048 : 256, base = isS ? MPR + (seq - 16) * 2048 : seq * 256, bs = seq - 16;
    LAS bf16* Kst = (LAS bf16*)lds;
    LAS bf16* Vst = (LAS bf16*)(lds + 17408);
    LAS bf16* C0t = (LAS bf16*)lds;
    LAS float* aT = (LAS float*)(lds + 35840);
    LAS float* n0s = (LAS float*)(lds + 36864);
    LAS bf16* Qw = (LAS bf16*)(lds + 37888 + wave * 8704);
    const bf16* GS = (const bf16*)(a.out + OFF_K + (size_t)M * 512);
    const float* NS = (const float*)(ws + WS_NS);
    asm volatile("" : "+v"(lane), "+v"(tid));
    const int lt = lane & 31, hh = lane >> 5, q0 = qt * 256 + 32 * wave, trow = base + q0 + lt;
    { u32x4 qv[8];
#pragma unroll
      for (int i = 0; i < 8; ++i) qv[i] = *(const u32x4*)(QB + (size_t)trow * 512 + h * 128 + 16 * i + 8 * hh);
#pragma unroll
      for (int i = 0; i < 8; ++i) *(LAS u32x4*)(Qw + lt * 136 + 16 * i + 8 * hh) = qv[i]; }
    LDS_WAIT(); asm volatile("" ::: "memory");
#define QF(i) (*(const LAS bf16x8*)(Qw + lt * 136 + 16 * (i) + 8 * hh))
    f32x16 O[4];
#pragma unroll 1
    for (int dir = 0; dir < 2; ++dir) {
#pragma unroll
        for (int eb = 0; eb < 4; ++eb)
#pragma unroll
            for (int r = 0; r < 16; ++r) O[eb][r] = 0.f;
        float den = 0.f;
        const float Mt = MSv[(size_t)trow * 8 + dir * 4 + h], bt = bS[(size_t)trow * 8 + dir * 4 + h];
        if (isS) {
            __syncthreads();
            const int sidx = (bs * 2 + dir) * 4 + h;
            const float m0 = a.in[I_STM][sidx];
            float cf[8]; float Mref = m0;
#pragma unroll
            for (int i = 0; i < 8; ++i) cf[i] = MSv[(size_t)(base + 256 * i + (dir ? 0 : 255)) * 8 + dir * 4 + h];
            if (dir == 0) { if (qt > 0) Mref = cf[0];
#pragma unroll
                for (int i = 1; i < 8; ++i) if (i < qt) Mref = cf[i]; }
            else { if (qt < 7) Mref = cf[7];
#pragma unroll
                for (int i = 6; i >= 0; --i) if (i > qt) Mref = cf[i]; }
            const float c0f = __expf(m0 - Mref);
#pragma unroll
            for (int i = 0; i < 8; ++i) { const bool inc = dir ? (i > qt) : (i < qt); cf[i] = inc ? __expf(cf[i] - Mref) : 0.f; }
            const float* C0 = a.in[I_STC] + (size_t)sidx * 16384; const bf16* Gb = GS + (size_t)sidx * 8 * 16384;
            for (int c = tid; c < 2048; c += NTHR) { const int d = c >> 4, e8 = (c & 15) * 8;
                const f32x4 c0a = *(const f32x4*)(C0 + d * 128 + e8), c0b = *(const f32x4*)(C0 + d * 128 + e8 + 4);
                u32x4 gq[8];
#pragma unroll
                for (int i = 0; i < 8; ++i) gq[i] = *(const u32x4*)(Gb + (size_t)i * 16384 + d * 128 + e8);
                float v[8];
#pragma unroll
                for (int j = 0; j < 4; ++j) { v[j] = c0a[j] * c0f; v[4 + j] = c0b[j] * c0f; }
#pragma unroll
                for (int i = 0; i < 8; ++i) { float g[8]; unpack8(gq[i], g);
#pragma unroll
                    for (int j = 0; j < 8; ++j) v[j] += cf[i] * g[j]; }
                const u32x4 pk = pack8(v);
                C0t[(e8 + 0) * 136 + d] = (bf16)(pk.x & 0xffffu); C0t[(e8 + 1) * 136 + d] = (bf16)(pk.x >> 16); C0t[(e8 + 2) * 136 + d] = (bf16)(pk.y & 0xffffu); C0t[(e8 + 3) * 136 + d] = (bf16)(pk.y >> 16);
                C0t[(e8 + 4) * 136 + d] = (bf16)(pk.z & 0xffffu); C0t[(e8 + 5) * 136 + d] = (bf16)(pk.z >> 16); C0t[(e8 + 6) * 136 + d] = (bf16)(pk.w & 0xffffu); C0t[(e8 + 7) * 136 + d] = (bf16)(pk.w >> 16); }
            if (tid < 128) { float nsv[8];
#pragma unroll
                for (int i = 0; i < 8; ++i) nsv[i] = NS[((size_t)sidx * 8 + i) * 128 + tid];
                float nv = a.in[I_STN][sidx * 128 + tid] * c0f;
#pragma unroll
                for (int i = 0; i < 8; ++i) nv += cf[i] * nsv[i];
                n0s[tid] = nv; }
            __syncthreads();
            const float sc = __expf(Mref - Mt);
            float dq = 0.f;
#pragma unroll
            for (int i = 0; i < 8; ++i) { float q[8]; const u32x4 qq = __builtin_bit_cast(u32x4, QF(i));
                unpack8(qq, q);
#pragma unroll
                for (int j = 0; j < 8; ++j) { dq += q[j] * n0s[16 * i + 8 * hh + j]; q[j] *= sc; }
                const bf16x8 Qs = __builtin_bit_cast(bf16x8, pack8(q));
#pragma unroll
                for (int eb = 0; eb < 4; ++eb) { const bf16x8 cf = *(const LAS bf16x8*)(C0t + (32 * eb + lt) * 136 + 16 * i + 8 * hh); O[eb] = MFMA32(cf, Qs, O[eb]); }
                asm volatile("" ::: "memory"); }
            den += sc * dq;
        }
        const int kt_lo = 4 * qt, kt_hi = 4 * qt + 3;
        u32x4 kreg[2], vreg[2]; float areg = 0.f;
#define ML_LOAD(kt_) do { const int kr0_ = base + 64 * (kt_); _Pragma("unroll") for (int i_ = 0; i_ < 2; ++i_) { const int c_ = tid + NTHR * i_; \
            kreg[i_] = *(const u32x4*)(KB + (size_t)(kr0_ + (c_ >> 4)) * 512 + h * 128 + (c_ & 15) * 8); \
            vreg[i_] = *(const u32x4*)(VO + (size_t)(kr0_ + (c_ & 63)) * 1024 + h * 128 + (c_ >> 6) * 8); } \
            if (tid < 64) areg = aS[(size_t)(kr0_ + tid) * 8 + dir * 4 + h]; } while (0)
        ML_LOAD(kt_lo);
#pragma unroll 1
        for (int kt = kt_lo; kt <= kt_hi; ++kt) {
            __syncthreads();
#pragma unroll
            for (int i_ = 0; i_ < 2; ++i_) { const int c_ = tid + NTHR * i_;
                *(LAS u32x4*)(Kst + (c_ >> 4) * 136 + (c_ & 15) * 8) = kreg[i_];
                LAS bf16* d = Vst + ((c_ >> 6) * 8) * 72 + (c_ & 63); const u32x4 v = vreg[i_];
                d[0] = (bf16)(v.x & 0xffffu); d[72] = (bf16)(v.x >> 16); d[144] = (bf16)(v.y & 0xffffu); d[216] = (bf16)(v.y >> 16);
                d[288] = (bf16)(v.z & 0xffffu); d[360] = (bf16)(v.z >> 16); d[432] = (bf16)(v.w & 0xffffu); d[504] = (bf16)(v.w >> 16); }
            if (tid < 64) aT[tid] = areg;
            if (kt < kt_hi) ML_LOAD(kt + 1);
            __syncthreads();
#pragma unroll 1
            for (int sub = 0; sub < 2; ++sub) {
                const int s0 = 64 * kt + 32 * sub;
                const bool skip = dir ? (s0 + 31 < q0) : (s0 > q0 + 31);
                if (!skip) {
                    f32x16 S;
#pragma unroll
                    for (int r = 0; r < 16; ++r) S[r] = 0.f;
#pragma unroll
                    for (int i = 0; i < 8; ++i) { const bf16x8 kf = *(const LAS bf16x8*)(Kst + (32 * sub + lt) * 136 + 16 * i + 8 * hh); S = MFMA32(kf, QF(i), S); }
                    const bool diag = (s0 == q0);
                    const int vlo = (diag && dir) ? lt : 0, vhi = (diag && !dir) ? lt : 31;
#pragma unroll
                    for (int r = 0; r < 16; ++r) { const int sl = (r & 3) + 8 * (r >> 2) + 4 * hh; const float av = aT[32 * sub + sl];
                        float wgt = __expf(av - Mt);
                        wgt = (sl >= vlo && sl <= vhi) ? wgt : 0.f;
                        const float p = S[r] * wgt; den += p; S[r] = p; }
                    const bf16x8 P0 = pack_frag(S, 0), P1 = pack_frag(S, 1);
#pragma unroll
                    for (int eb = 0; eb < 4; ++eb) {
                        O[eb] = MFMA32(ld_vfrag(Vst, 32 * eb + lt, 32 * sub + 4 * hh), P0, O[eb]);
                        O[eb] = MFMA32(ld_vfrag(Vst, 32 * eb + lt, 32 * sub + 16 + 4 * hh), P1, O[eb]); }
                }
            }
        }
#undef ML_LOAD
        const float dent = den + __shfl_xor(den, 32);
        const float inv = 1.f / fmaxf(fabsf(dent), __expf(-(bt + Mt)));
        int trow2 = trow; asm volatile("" : "+v"(trow2));
        float* hp = hscr + (size_t)trow2 * 512 + h * 128 + 4 * hh;
        if (dir == 0) {
#pragma unroll
            for (int eb = 0; eb < 4; ++eb)
#pragma unroll
                for (int g = 0; g < 4; ++g) { f32x4 v; v[0] = O[eb][4 * g] * inv; v[1] = O[eb][4 * g + 1] * inv; v[2] = O[eb][4 * g + 2] * inv; v[3] = O[eb][4 * g + 3] * inv;
                    *(f32x4*)(hp + 32 * eb + 8 * g) = v; }
        } else {
            float ss = 0.f;
#pragma unroll
            for (int eb = 0; eb < 4; ++eb)
#pragma unroll
                for (int g = 0; g < 4; ++g) { const f32x4 v = *(const f32x4*)(hp + 32 * eb + 8 * g);
#pragma unroll
                    for (int j = 0; j < 4; ++j) { const float x = __builtin_fmaf(O[eb][4 * g + j], inv, v[j]); O[eb][4 * g + j] = x; ss = __builtin_fmaf(x, x, ss); }
                    asm volatile("" ::: "memory"); }
            ss += __shfl_xor(ss, 32);
            const float rs = rsqrtf(ss * (1.f / 128.f) + EPS);
            const float* gh = a.in[I_GMLSTM] + h * 128 + 4 * hh; const bf16* op = VO + (size_t)trow2 * 1024 + 512 + h * 128 + 4 * hh; bf16* yp = ycat + (size_t)trow2 * 1024 + h * 128 + 4 * hh;
#pragma unroll
            for (int eb = 0; eb < 4; ++eb)
#pragma unroll
                for (int g = 0; g < 4; ++g) { const int e = 32 * eb + 8 * g; const u32x2 ov = *(const u32x2*)(op + e); const f32x4 gv = *(const f32x4*)(gh + e);
                    const float o0 = __uint_as_float(ov.x << 16), o1 = __uint_as_float(ov.x & 0xffff0000u), o2 = __uint_as_float(ov.y << 16), o3 = __uint_as_float(ov.y & 0xffff0000u);
                    u32x2 w; w.x = pk2(O[eb][4 * g] * rs * gv[0] * sigm_f(o0), O[eb][4 * g + 1] * rs * gv[1] * sigm_f(o1));
                    w.y = pk2(O[eb][4 * g + 2] * rs * gv[2] * sigm_f(o2), O[eb][4 * g + 3] * rs * gv[3] * sigm_f(o3)); *(u32x2*)(yp + e) = w;
                    if (g == 3) asm volatile("" ::: "memory"); }
        }
    }
    __syncthreads();
#undef QF
}
DI void mlstm_state_unit(const Args& a, LAS unsigned char* lds, int seq, int h, int dir, int blk, int tid, int lane, int wave) {
    unsigned char* ws = a.ws;
    const bf16* KB = (const bf16*)(ws + WS_KB); const bf16* VO = (const bf16*)(ws + WS_VO);
    const float* aS = (const float*)(ws + WS_AS); const float* MSv = (const float*)(ws + WS_MS); const float* bS = (const float*)(ws + WS_BS);
    asm volatile("" : "+v"(lane), "+v"(tid));
    const bool isS = seq >= 16; const int base = (isS ? MPR + (seq - 16) * 2048 : seq * 256) + 256 * blk, lastrow = base + (dir ? 0 : 255);
    const float ML = MSv[(size_t)lastrow * 8 + dir * 4 + h], bL = bS[(size_t)lastrow * 8 + dir * 4 + h];
    LAS bf16* Kt = (LAS bf16*)lds;
    LAS bf16* Vst = (LAS bf16*)(lds + 18432);
    const int lt = lane & 31, hh = lane >> 5, db = wave >> 1, eb0 = 2 * (wave & 1);
    f32x16 C[2];
#pragma unroll
    for (int j = 0; j < 2; ++j)
#pragma unroll
        for (int r = 0; r < 16; ++r) C[j][r] = 0.f;
    float nacc = 0.f;
    u32x4 kreg[2], vreg[2]; float wreg[2];
#define ST_LOAD(kt_) do { const int kr0_ = base + 64 * (kt_); _Pragma("unroll") for (int i_ = 0; i_ < 2; ++i_) { const int c_ = tid + NTHR * i_, key_ = c_ & 63, ch_ = c_ >> 6; \
        kreg[i_] = *(const u32x4*)(KB + (size_t)(kr0_ + key_) * 512 + h * 128 + ch_ * 8); vreg[i_] = *(const u32x4*)(VO + (size_t)(kr0_ + key_) * 1024 + h * 128 + ch_ * 8); \
        wreg[i_] = aS[(size_t)(kr0_ + key_) * 8 + dir * 4 + h]; } } while (0)
    ST_LOAD(0);
#pragma unroll 1
    for (int kt = 0; kt < 4; ++kt) {
        __syncthreads();
#pragma unroll
        for (int i_ = 0; i_ < 2; ++i_) { const int c_ = tid + NTHR * i_, key = c_ & 63, ch = c_ >> 6; float k[8]; unpack8(kreg[i_], k);
            const float w = __expf(wreg[i_] - ML);
#pragma unroll
            for (int j = 0; j < 8; j += 2) { const unsigned p = pk2(k[j] * w, k[j + 1] * w); Kt[(ch * 8 + j) * 72 + key] = (bf16)(p & 0xffffu); Kt[(ch * 8 + j + 1) * 72 + key] = (bf16)(p >> 16); }
            LAS bf16* d = Vst + (ch * 8) * 72 + key; const u32x4 v = vreg[i_];
            d[0] = (bf16)(v.x & 0xffffu); d[72] = (bf16)(v.x >> 16); d[144] = (bf16)(v.y & 0xffffu); d[216] = (bf16)(v.y >> 16);
            d[288] = (bf16)(v.z & 0xffffu); d[360] = (bf16)(v.z >> 16); d[432] = (bf16)(v.w & 0xffffu); d[504] = (bf16)(v.w >> 16); }
        if (kt < 3) ST_LOAD(kt + 1);
        __syncthreads();
#pragma unroll
        for (int i = 0; i < 4; ++i) { const bf16x8 kf = *(const LAS bf16x8*)(Kt + (32 * db + lt) * 72 + 16 * i + 8 * hh);
#pragma unroll
            for (int j = 0; j < 2; ++j) { const bf16x8 vf = *(const LAS bf16x8*)(Vst + (32 * (eb0 + j) + lt) * 72 + 16 * i + 8 * hh); C[j] = MFMA32(kf, vf, C[j]); } }
        if (tid < 128) { float s = 0.f;
#pragma unroll 8
            for (int k = 0; k < 64; ++k) s += bf2f(Kt[tid * 72 + k]);
            nacc += s; }
    }
#undef ST_LOAD
    if (!isS) {
        float* oc = a.out + OFF_C + ((size_t)((seq * 2 + dir) * 4 + h)) * 16384;
#pragma unroll
        for (int j = 0; j < 2; ++j)
#pragma unroll
            for (int r = 0; r < 16; ++r) { const int d = 32 * db + (r & 3) + 8 * (r >> 2) + 4 * hh, e = 32 * (eb0 + j) + lt; oc[d * 128 + e] = C[j][r]; }
        if (tid < 128) a.out[OFF_N + ((size_t)((seq * 2 + dir) * 4 + h)) * 128 + tid] = nacc;
        if (tid == 0) a.out[OFF_MM + (seq * 2 + dir) * 4 + h] = bL + ML;
    } else {
        const size_t u = ((size_t)(((seq - 16) * 2 + dir) * 4 + h)) * 8 + blk;
        bf16* og = (bf16*)(a.out + OFF_K + (size_t)M * 512) + u * 16384;
#pragma unroll
        for (int j = 0; j < 2; ++j)
#pragma unroll
            for (int r = 0; r < 16; ++r) { const int d = 32 * db + (r & 3) + 8 * (r >> 2) + 4 * hh, e = 32 * (eb0 + j) + lt; og[d * 128 + e] = (bf16)(pk2(C[j][r], 0.f) & 0xffffu); }
        if (tid < 128) ((float*)(ws + WS_NS))[u * 128 + tid] = nacc;
    }
    __syncthreads();
}
constexpr int HY_CP = 8224;
constexpr int HY_UB = 65792, HY_XB = 90624;
DI u32x4 ld16_or0(const bf16* p, bool ok) { u32x4 z = {0u, 0u, 0u, 0u}; return ok ? *(const u32x4*)p : z; }
DI void hy_build_copies(LAS unsigned char* lds, const bf16* R, int RL, int tid) {
    const int nch = RL / 8;
    for (int mch = tid; mch <= nch; mch += NTHR) {
        const u32x4 lo = ld16_or0(R + 8 * (mch - 1), mch >= 1), hi = ld16_or0(R + 8 * mch, mch < nch);
        const unsigned W[8] = {lo.x, lo.y, lo.z, lo.w, hi.x, hi.y, hi.z, hi.w};
#pragma unroll
        for (int sg = 0; sg < 8; ++sg) { u32x4 o;
            if ((sg & 1) == 0) { o.x = W[sg / 2]; o.y = W[sg / 2 + 1]; o.z = W[sg / 2 + 2]; o.w = W[sg / 2 + 3]; }
            else { const int q = (sg - 1) / 2; o.x = __builtin_amdgcn_alignbit(W[q + 1], W[q], 16); o.y = __builtin_amdgcn_alignbit(W[q + 2], W[q + 1], 16);
                   o.z = __builtin_amdgcn_alignbit(W[q + 3], W[q + 2], 16); o.w = __builtin_amdgcn_alignbit(W[q + 4], W[q + 3], 16); }
            *(LAS u32x4*)(lds + sg * HY_CP + 16 * mch) = o; }
    }
}
DI f32x16 hy_mfma_loop(LAS unsigned char* lds, unsigned abase, unsigned bbase, int dlo, int dhi) {
    f32x16 acc;
#pragma unroll
    for (int r = 0; r < 16; ++r) acc[r] = 0.f;
#pragma unroll 2
    for (int dl = dlo; dl <= dhi; ++dl) { const int off = -64 * dl;
        const bf16x8 a0 = *(const LAS bf16x8*)(lds + abase + off), b0 = *(const LAS bf16x8*)(lds + bbase + off);
        const bf16x8 a1 = *(const LAS bf16x8*)(lds + abase + off + 32), b1 = *(const LAS bf16x8*)(lds + bbase + off + 32);
        acc = MFMA32(a0, b0, acc); acc = MFMA32(a1, b1, acc); }
    return acc;
}
DI void hyena_channel(const Args& a, LAS unsigned char* lds, int c, int tid, int lane, int wave) {
    unsigned char* ws = a.ws;
    const bf16* HV = (const bf16*)(ws + WS_HYT) + (size_t)c * M; const bf16* H1 = HV + (size_t)512 * M; const bf16* H2 = HV + (size_t)1024 * M;
    const float* wch = a.in[I_WCHY] + c;
    const float wv0 = wch[0], wv1 = wch[1536], wv2 = wch[3072], w10 = wch[512], w11 = wch[512 + 1536], w12 = wch[512 + 3072], w20 = wch[1024], w21 = wch[1024 + 1536], w22 = wch[1024 + 3072];
#define HY_CONV8(g_, sb_, L_, uo_, xo_) do { const bool hp_ = (g_) > (sb_), hn_ = (g_) + 8 < (sb_) + (L_); float o_u[8], o_x[8]; \
        _Pragma("unroll") for (int tn_ = 0; tn_ < 3; ++tn_) { const bf16* p_ = tn_ == 0 ? HV : (tn_ == 1 ? H1 : H2); const float k0_ = tn_ == 0 ? wv0 : (tn_ == 1 ? w10 : w20), k1_ = tn_ == 0 ? wv1 : (tn_ == 1 ? w11 : w21), k2_ = tn_ == 0 ? wv2 : (tn_ == 1 ? w12 : w22); \
            float x_[8]; unpack8(*(const u32x4*)(p_ + (g_)), x_); const float xm_ = bf2f(p_[hp_ ? (g_) - 1 : (g_)]) * (hp_ ? 1.f : 0.f), xp_ = bf2f(p_[hn_ ? (g_) + 8 : (g_)]) * (hn_ ? 1.f : 0.f); \
            _Pragma("unroll") for (int j_ = 0; j_ < 8; ++j_) { const float r_ = k0_ * (j_ ? x_[j_ ? j_ - 1 : 0] : xm_) + k1_ * x_[j_] + k2_ * (j_ < 7 ? x_[j_ < 7 ? j_ + 1 : 7] : xp_); \
                if (tn_ == 0) o_u[j_] = r_; else if (tn_ == 1) o_u[j_] *= r_; else o_x[j_] = r_; } } \
        uo_ = pack8(o_u); xo_ = pack8(o_x); } while (0)
    bf16* ycat = (bf16*)(ws + WS_H) + 512 + c; const float hb = a.in[I_HYB][c];
    const int lt = lane & 31, hh = lane >> 5, sg = (8 - (lt & 7)) & 7, i8 = (lt + 7) & ~7;
    LAS bf16* Ub = (LAS bf16*)(lds + HY_UB); LAS bf16* Xb = (LAS bf16*)(lds + HY_XB);
    __syncthreads();
    for (int i = tid; i < 24832 / 16; i += NTHR) *(LAS u32x4*)(lds + HY_UB + 16 * i) = (u32x4){0u, 0u, 0u, 0u};
    hy_build_copies(lds, (const bf16*)(ws + WS_R2048) + (size_t)c * 4096, 4096, tid);
    __syncthreads();
    for (int i = tid; i < 1024; i += NTHR) { const int b = i >> 8, mch = i & 255; const int sb = MPR + b * 2048, g = sb + 8 * mch; u32x4 uo, xo; HY_CONV8(g, sb, 2048, uo, xo);
        *(LAS u32x4*)(Ub + b * 2568 + 256 + 8 * mch) = uo; *(LAS u32x4*)(Xb + b * 2568 + 256 + 8 * mch) = xo; }
    __syncthreads();
    { const int bq = lt & 3, Ib = 8 * wave + (lt >> 2);
      const unsigned abase = sg * HY_CP + 2 * (2048 + 8 + 8 * hh - i8), bbase = HY_UB + 2 * (bq * 2568 + 256 + 32 * Ib + 8 * hh);
      const f32x16 acc = hy_mfma_loop(lds, abase, bbase, 8 * wave - 63, 8 * wave + 7);
#pragma unroll
      for (int r = 0; r < 16; ++r) { int t = 32 * Ib + (r & 3) + 8 * (r >> 2) + 4 * hh; asm volatile("" : "+v"(t));
          const float u = bf2f(Ub[bq * 2568 + 256 + t]), x2 = bf2f(Xb[bq * 2568 + 256 + t]);
          const float y = x2 * (acc[r] + hb * u); ycat[(size_t)(MPR + bq * 2048 + t) * 1024] = (bf16)(pk2(y, 0.f) & 0xffffu); } }
    __syncthreads();
    for (int i = tid; i < 24832 / 16; i += NTHR) *(LAS u32x4*)(lds + HY_UB + 16 * i) = (u32x4){0u, 0u, 0u, 0u};
    hy_build_copies(lds, (const bf16*)(ws + WS_R256) + (size_t)c * 512, 512, tid);
    __syncthreads();
    { const int sq = tid >> 5, mch = tid & 31; const int sb = sq * 256, g = sb + 8 * mch; u32x4 uo, xo; HY_CONV8(g, sb, 256, uo, xo);
      *(LAS u32x4*)(Ub + sq * 776 + 256 + 8 * mch) = uo; *(LAS u32x4*)(Xb + sq * 776 + 256 + 8 * mch) = xo; }
#undef HY_CONV8
    __syncthreads();
    if (wave < 4) { const int bq = 4 * wave + (lt & 3), Ib = lt >> 2;
      const unsigned abase = sg * HY_CP + 2 * (256 + 8 + 8 * hh - i8), bbase = HY_UB + 2 * (bq * 776 + 256 + 32 * Ib + 8 * hh);
      const f32x16 acc = hy_mfma_loop(lds, abase, bbase, -7, 7);
#pragma unroll
      for (int r = 0; r < 16; ++r) { int t = 32 * Ib + (r & 3) + 8 * (r >> 2) + 4 * hh; asm volatile("" : "+v"(t));
          const float u = bf2f(Ub[bq * 776 + 256 + t]), x2 = bf2f(Xb[bq * 776 + 256 + t]);
          const float y = x2 * (acc[r] + hb * u); ycat[(size_t)(bq * 256 + t) * 1024] = (bf16)(pk2(y, 0.f) & 0xffffu); } }
    __syncthreads();
}
#ifndef MK_MB_S
#define MK_MB_S 1
#define MK_MB_P 1
#define MK_MA_H 1
#define MK_MA_S 1
#endif
constexpr int HY_A1 = 256, HY_A2 = 384;
DI void hyena_range(const Args& a, LAS unsigned char* lds, int c_lo, int c_hi, int widx, int nw, int tid, int lane, int wave) {
    const int nch = c_hi - c_lo, nlines = nch / 64;
    if (nch % 64 == 0 && nw % 8 == 0 && nch % nw == 0 && 64 % (8 * nlines) == 0) { const int x = widx & 7, cnt = nch / nw, c0 = c_lo + x * 8 * nlines + (widx >> 3) * cnt;
        for (int c = 0; c < cnt; ++c) hyena_channel(a, lds, c0 + c, tid, lane, wave); }
    else for (int c = c_lo + widx; c < c_hi; c += nw) hyena_channel(a, lds, c, tid, lane, wave);
}
DI void ph_mixers_a(const Args& a, LAS unsigned char* lds, int tid, int lane, int wave, int bid, int G) {
    if (G == 256) { for (int rp = 0; rp < MK_MA_H; ++rp) { hyena_range(a, lds, 0, HY_A1, bid, G, tid, lane, wave); if (bid >= 128) hyena_range(a, lds, HY_A1, HY_A2, bid - 128, 128, tid, lane, wave); } }
    else hyena_range(a, lds, 0, 512, bid, G, tid, lane, wave);
    for (int it = bid; it < 384; it += G) { const bool smp = it < 256; const int rr = smp ? it : it - 256;
        for (int rp = 0; rp < MK_MA_S; ++rp)
        mlstm_state_unit(a, lds, smp ? 16 + (rr >> 6) : (rr >> 3), smp ? (rr >> 4) & 3 : (rr >> 1) & 3, smp ? (rr >> 3) & 1 : rr & 1, smp ? rr & 7 : 0, tid, lane, wave); }
}
DI void ph_mixers_b(const Args& a, LAS unsigned char* lds, int tid, int lane, int wave, int bid, int G) {
    if (G == 256 && bid >= 192) hyena_range(a, lds, HY_A2, 512, bid - 192, 64, tid, lane, wave);
    for (int it = bid; it < 192; it += G) { const bool smp = it < 128; const int rr = smp ? it : it - 128;
        for (int rp = 0; rp < (smp ? MK_MB_S : MK_MB_P); ++rp)
        mlstm_unit(a, lds, smp ? 16 + (rr >> 5) : (rr >> 2), smp ? (rr >> 3) & 3 : rr & 3, smp ? rr & 7 : 0, tid, lane, wave); }
}
DI void attn_unit(const Args& a, LAS unsigned char* lds, int kind, int b, int h, int blk, int tid, int lane, int wave) {
    unsigned char* ws = a.ws;
    const bf16* Q1 = (const bf16*)(ws + WS_Q1); const bf16* K1 = (const bf16*)(ws + WS_K1); const bf16* V1 = (const bf16*)(ws + WS_V1);
    const bf16* CK = (const bf16*)(ws + WS_CK); const bf16* CV = (const bf16*)(ws + WS_CV);
    bf16* obuf = (bf16*)(ws + WS_H);
    LAS bf16* Kst = (LAS bf16*)lds;
    LAS bf16* Vst = (LAS bf16*)(lds + 9216);
    LAS float* rpbs = (LAS float*)(lds + 18432);
    asm volatile("" : "+v"(lane), "+v"(tid));
    const int lt = lane & 31, hh = lane >> 5;
    int qrow, r = 0, qc = 0, nctx, nloc, kr_lo = 0, rs = 0, cs = 0;
    if (kind == 0) { qrow = b * 256 + 32 * wave + lt; nctx = 0; nloc = 4; }
    else { const int r0 = 4 * blk; r = r0 + (wave >> 1); qc = 32 * (wave & 1) + lt; qrow = MPR + b * 2048 + r * 64 + qc; nctx = 8;
        const int lo = r0 - 4 < 0 ? 0 : (r0 - 4 > 24 ? 24 : r0 - 4); const int r3 = r0 + 3 - 4; const int hi = (r3 < 0 ? 0 : (r3 > 24 ? 24 : r3)) + 7;
        kr_lo = lo; nloc = hi - lo + 1; rs = r - 4 < 0 ? 0 : (r - 4 > 24 ? 24 : r - 4); cs = qc - 8 < 0 ? 0 : (qc - 8 > 48 ? 48 : qc - 8);
        __syncthreads();
        if (tid < 465) rpbs[tid] = a.in[I_RPB][h * 465 + tid] * 1.4426950408889634f;
    }
    int icol[2][16]; unsigned okm[2] = {0u, 0u};
#pragma unroll
    for (int sub = 0; sub < 2; ++sub)
#pragma unroll
        for (int q = 0; q < 16; ++q) { const int kc = 32 * sub + (q & 3) + 8 * (q >> 2) + 4 * hh; int ic = kc - qc + 15; ic = ic < 0 ? 0 : (ic > 30 ? 30 : ic);
            icol[sub][q] = ic; okm[sub] |= ((kc >= cs) && (kc < cs + 16)) ? (1u << q) : 0u; }
    bf16x8 Qf[4];
#pragma unroll
    for (int i = 0; i < 4; ++i) Qf[i] = *(const bf16x8*)(Q1 + (size_t)qrow * 1024 + h * 64 + 16 * i + 8 * hh);
    f32x16 O[2];
#pragma unroll
    for (int eb = 0; eb < 2; ++eb)
#pragma unroll
        for (int q = 0; q < 16; ++q) O[eb][q] = 0.f;
    float mrun = -INFINITY, lrun = 0.f;
    const int kkey = tid >> 3, kch = tid & 7, vkey = tid & 63, vch = tid >> 6;
    u32x4 kreg, vreg;
#define ATT_SRC(st_, ksrc_, vsrc_, ld_) do { const bool ic_ = (st_) < nctx; const int kr_ = kr_lo + ((st_) - nctx); \
        if (ic_) { ksrc_ = CK + ((size_t)((b * 16 + h) * 512 + 64 * (st_))) * 64; vsrc_ = CV + ((size_t)((b * 16 + h) * 512 + 64 * (st_))) * 64; ld_ = 64; } \
        else if (kind == 0) { const size_t row0 = (size_t)b * 256 + 64 * (st_); ksrc_ = K1 + row0 * 1024 + h * 64; vsrc_ = V1 + row0 * 1024 + h * 64; ld_ = 1024; } \
        else { const size_t row0 = (size_t)MPR + b * 2048 + kr_ * 64; ksrc_ = K1 + row0 * 1024 + h * 64; vsrc_ = V1 + row0 * 1024 + h * 64; ld_ = 1024; } } while (0)
    { const bf16* ksrc; const bf16* vsrc; size_t ld; ATT_SRC(0, ksrc, vsrc, ld);
      kreg = *(const u32x4*)(ksrc + (size_t)kkey * ld + kch * 8); vreg = *(const u32x4*)(vsrc + (size_t)vkey * ld + vch * 8); }
#pragma unroll 1
    for (int st = 0; st < nctx + nloc; ++st) {
        const bool isctx = st < nctx; const int kr = kr_lo + (st - nctx);
        __syncthreads();
        *(LAS u32x4*)(Kst + kkey * 72 + kch * 8) = kreg;
        { LAS bf16* d = Vst + (vch * 8) * 72 + vkey;
          d[0] = (bf16)(vreg.x & 0xffffu); d[72] = (bf16)(vreg.x >> 16); d[144] = (bf16)(vreg.y & 0xffffu); d[216] = (bf16)(vreg.y >> 16);
          d[288] = (bf16)(vreg.z & 0xffffu); d[360] = (bf16)(vreg.z >> 16); d[432] = (bf16)(vreg.w & 0xffffu); d[504] = (bf16)(vreg.w >> 16); }
        if (st + 1 < nctx + nloc) { const bf16* ksrc; const bf16* vsrc; size_t ld; ATT_SRC(st + 1, ksrc, vsrc, ld);
            kreg = *(const u32x4*)(ksrc + (size_t)kkey * ld + kch * 8); vreg = *(const u32x4*)(vsrc + (size_t)vkey * ld + vch * 8); }
        __syncthreads();
        const bool active = (kind == 0) || isctx || (kr >= rs && kr < rs + 8);
        if (active) {
#pragma unroll
            for (int sub = 0; sub < 2; ++sub) {
                f32x16 S;
#pragma unroll
                for (int q = 0; q < 16; ++q) S[q] = 0.f;
#pragma unroll
                for (int i = 0; i < 4; ++i) { const bf16x8 kf = *(const LAS bf16x8*)(Kst + (32 * sub + lt) * 72 + 16 * i + 8 * hh); S = MFMA32(kf, Qf[i], S); }
                if (kind == 1 && !isctx) {
                    const LAS float* rb = rpbs + (kr - r + 7) * 31;
                    float bv[16];
#pragma unroll
                    for (int q = 0; q < 16; ++q) bv[q] = rb[icol[sub][q]];
#pragma unroll
                    for (int q = 0; q < 16; ++q) S[q] = ((okm[sub] >> q) & 1u) ? S[q] + bv[q] : -INFINITY;
                }
                float mx = fmaxf(fmaxf(fmaxf(S[0], S[1]), fmaxf(S[2], S[3])), fmaxf(fmaxf(S[4], S[5]), fmaxf(S[6], S[7])));
                mx = fmaxf(mx, fmaxf(fmaxf(fmaxf(S[8], S[9]), fmaxf(S[10], S[11])), fmaxf(fmaxf(S[12], S[13]), fmaxf(S[14], S[15]))));
                { const auto sw_ = __builtin_amdgcn_permlane32_swap(__float_as_uint(mx), __float_as_uint(mx), false, false); mx = fmaxf(__uint_as_float(sw_[0]), __uint_as_float(sw_[1])); }
                if (!__all(mx <= mrun + 8.f)) { const float mnew = fmaxf(mrun, mx); const float alpha = exp2_f(mrun - mnew);
                    lrun *= alpha; mrun = mnew;
#pragma unroll
                    for (int eb = 0; eb < 2; ++eb)
#pragma unroll
                        for (int q = 0; q < 16; ++q) O[eb][q] *= alpha; }
                float ps = 0.f;
#pragma unroll
                for (int q = 0; q < 16; ++q) { const float p = exp2_f(S[q] - mrun); S[q] = p; ps += p; }
                lrun += ps;
                const bf16x8 P0 = pack_frag(S, 0), P1 = pack_frag(S, 1);
#pragma unroll
                for (int eb = 0; eb < 2; ++eb) {
                    O[eb] = MFMA32(ld_vfrag(Vst, 32 * eb + lt, 32 * sub + 4 * hh), P0, O[eb]);
                    O[eb] = MFMA32(ld_vfrag(Vst, 32 * eb + lt, 32 * sub + 16 + 4 * hh), P1, O[eb]); }
            }
        }
    }
    const float inv = 1.f / (lrun + __shfl_xor(lrun, 32));
    bf16* op = obuf + (size_t)qrow * 1024 + h * 64;
#pragma unroll
    for (int eb = 0; eb < 2; ++eb)
#pragma unroll
        for (int g = 0; g < 4; ++g) { u32x2 w; w.x = pk2(O[eb][4 * g] * inv, O[eb][4 * g + 1] * inv); w.y = pk2(O[eb][4 * g + 2] * inv, O[eb][4 * g + 3] * inv);
            *(u32x2*)(op + 32 * eb + 8 * g + 4 * hh) = w; }
    __syncthreads();
#undef ATT_SRC
}
#ifndef MK_AT_N
#define MK_AT_N 1
#define MK_AT_C 1
#endif
DI void ph_attention(const Args& a, LAS unsigned char* lds, int tid, int lane, int wave, int bid, int G) {
    for (int it = bid; it < 768; it += G) {
        if (it < 512) { for (int rp = 0; rp < MK_AT_N; ++rp) attn_unit(a, lds, 1, it >> 7, (it >> 3) & 15, it & 7, tid, lane, wave); }
        else { const int r = it - 512; for (int rp = 0; rp < MK_AT_C; ++rp) attn_unit(a, lds, 0, r >> 4, r & 15, 0, tid, lane, wave); }
    }
}
DI void cache_out(const Args& a, int widx, int nw, int tid) {
    const bf16* K1 = (const bf16*)(a.ws + WS_K1); const bf16* V1 = (const bf16*)(a.ws + WS_V1);
    for (int i = widx * NTHR + tid; i < 2 * MPR * 128; i += nw * NTHR) { const int ten = i >= MPR * 128, j = ten ? i - MPR * 128 : i, row = j >> 7, c8 = (j & 127) * 8;
        float f[8]; unpack8(*(const u32x4*)((ten ? V1 : K1) + (size_t)row * 1024 + c8), f);
        const int hh = c8 >> 6, d = c8 & 63, b = row >> 8, tt = row & 255;
        float* p = a.out + (ten ? OFF_V : OFF_K) + ((size_t)((b * 16 + hh) * 256 + tt)) * 64 + d;
        *(f32x4*)p = (f32x4){f[0], f[1], f[2], f[3]}; *(f32x4*)(p + 4) = (f32x4){f[4], f[5], f[6], f[7]}; }
}
__global__ void __launch_bounds__(NTHR, 2) mk_fwd(Args a) {
    extern __shared__ __attribute__((aligned(16))) unsigned char lds_raw[];
    LAS unsigned char* lds = (LAS unsigned char*)lds_raw;
    const int tid = threadIdx.x, lane = tid & 63, wave = __builtin_amdgcn_readfirstlane(tid >> 6), bid = blockIdx.x, G = gridDim.x;
    const int gw = bid * NWAVES + wave, NGW = G * NWAVES;
    unsigned char* ws = a.ws;
    for (int u = tid; u < (LDS_BYTES - LDSCTL_OFF) / 4; u += NTHR) ((LAS unsigned*)(lds + LDSCTL_OFF))[u] = 0u;
    __syncthreads();
    XcdBarrier bar; bar.bar = (unsigned*)(ws + WS_CTL) + CW_BAR; bar.x = 0; bar.st = nullptr;
    const bool multi = (a.ph_hi - a.ph_lo) > 1;
    if (multi) bar = xcd_barrier_post((unsigned*)(ws + WS_CTL) + CW_BAR, (volatile LAS unsigned*)(lds + MISC_OFF) + 8);
    float* out = a.out;
    float* modF = (float*)(ws + WS_MODF);
    bf16* hbuf = (bf16*)(ws + WS_H);
    bf16* dlt = (bf16*)(ws + WS_DL);
    const float* xsB = a.in[I_XS] - (size_t)MPR * D;
    const int lo = a.ph_lo, hi = a.ph_hi;
#ifndef MK_ALIGN
#define MK_ALIGN true
#endif
#ifndef MK_SP2
#define MK_SP2 true
#endif
#ifndef MK_ONLY
#define MK_ONLY -1
#endif
#define IN(k) ((MK_ONLY < 0 || MK_ONLY == (k)) && lo <= (k) && (k) < hi)
#define SEAM(k) do { if ((k) + 1 < hi) xcd_barrier(bar); } while (0)
#ifndef MK_REPMASK
#define MK_REPMASK 0u
#endif
#define MK_REP(k) (((MK_REPMASK >> (k)) & 1u) ? 2 : 1)
#define PH(k, ...) if (IN(k)) { if (MK_REP(k) == 2) { __VA_ARGS__ xcd_barrier(bar); } { __VA_ARGS__ } SEAM(k); }
#define GEMM_UP(l) do { pg8::Gemm g{hbuf, (const bf16*)(ws + WS_WUP) + (size_t)(l) * 5632 * 1024, M, 2 * FF, D}; pg8::StaticOrder S; S.init(M, 2 * FF, G, bid); \
            pg8::EpiFfn E{(bf16*)(ws + WS_FG), a.in[I_WCFFN] + (size_t)(l) * 3 * FF, (float*)(ws + WS_ABND), (float*)(ws + WS_GBND), (LAS float*)(lds + XCH_OFF)}; \
            pg8::gemm_phase<pg8::EpiFfn, pg8::StaticOrder, MK_ALIGN, MK_SP2>(lds, g, S, E); } while (0)
#define GEMM_DOWN(l) do { pg8::Gemm g{(const bf16*)(ws + WS_FG), (const bf16*)(ws + WS_WDN) + (size_t)(l) * 1024 * FF, M, D, FF}; pg8::StaticOrder S; S.init(M, D, G, bid); \
            { pg8::Unit u_; for (int i_ = 0; S.next(i_, u_); ++i_) ffn_fix_panel(a, (l), u_.pm, tid); }     \
            pg8::EpiDelta E{dlt, modF + (size_t)(l) * 5 * 6144 + 5 * 1024}; \
            pg8::gemm_phase<pg8::EpiDelta, pg8::StaticOrder, MK_ALIGN, MK_SP2>(lds, g, S, E); } while (0)
    PH(0, ph_prologue(a, lds, tid, lane, wave, bid, G);)
    PH(1, ph_modf_norm0(a, lds, tid, lane, wave, bid, G);)
    PH(2, { pg8::Gemm g{hbuf, (const bf16*)(ws + WS_WAB), M, NPROJ, D}; pg8::StaticOrder S; S.init(M, NPROJ, G, bid);
            pg8::EpiInAB E{(bf16*)(ws + WS_QB), (bf16*)(ws + WS_VO), (float*)(ws + WS_GATES), a.in[I_WCQK], (float*)(ws + WS_QKBND), (LAS float*)(lds + XCH_OFF)};
            pg8::gemm_phase<pg8::EpiInAB, pg8::StaticOrder, MK_ALIGN, MK_SP2>(lds, g, S, E); }
          {
            pg8::Gemm g{(const bf16*)(ws + WS_WHY), hbuf, 1536, M, D}; pg8::StaticOrder S; const int nA = (M / 256) * (NPROJ / 256); S.init(1536, M, G, (bid + G - (nA % G)) % G);
            pg8::EpiBf16<0> E{(bf16*)(ws + WS_HYT), M, nullptr, 0, 0, 1.f};
            pg8::gemm_phase<pg8::EpiBf16<0>, pg8::StaticOrder, MK_ALIGN, MK_SP2>(lds, g, S, E); })
    PH(3, ph_e1(a, lds, tid, gw, NGW, lane, wave, bid, G);)
    PH(4, ph_mixers_a(a, lds, tid, lane, wave, bid, G);)
    PH(5, ph_mixers_b(a, lds, tid, lane, wave, bid, G);)
    PH(6, pg8::Gemm g{hbuf, (const bf16*)(ws + WS_WOAB), M, D, D}; pg8::StaticOrder S; S.init(M, D, G, bid);
            pg8::EpiDelta E{dlt, modF + 2 * 1024};
            pg8::gemm_phase<pg8::EpiDelta, pg8::StaticOrder, MK_ALIGN, MK_SP2>(lds, g, S, E);
            { const int busy = (M / 256) * (D / 256); if (G > busy) { if (bid >= busy) bg_convert(a, lds, 1, bid - busy, G - busy, tid); } else bg_convert(a, lds, 1, bid, G, tid); })
    PH(7, ph_norm(a.in[I_XP], xsB, dlt, out, a.in[I_GFFN], modF, 3, 4, hbuf, gw, NGW, lane);)
    PH(8, GEMM_UP(0);)
    PH(9, GEMM_DOWN(0); { const int busy = (M / 256) * (D / 256); if (G > busy) { if (bid >= busy) bg_convert(a, lds, 2, bid - busy, G - busy, tid); } else bg_convert(a, lds, 2, bid, G, tid); })
    PH(10, ph_norm(out, out, dlt, out, a.in[I_GMIX] + D, modF + 5 * 6144, 0, 1, hbuf, gw, NGW, lane);)
    PH(11, pg8::Gemm g{hbuf, (const bf16*)(ws + WS_WC), M, 3 * D, D}; pg8::StaticOrder S; S.init(M, 3 * D, G, bid);
            pg8::EpiQKV E{(bf16*)(ws + WS_Q1), (size_t)(WS_K1 - WS_Q1) / 2};
            pg8::gemm_phase<pg8::EpiQKV, pg8::StaticOrder, MK_ALIGN, MK_SP2>(lds, g, S, E);
            { const int nt_ = (M / 256) * (3 * D / 256), full = nt_ % G; if (full > 0 && full < G) { if (bid >= full) bg_convert(a, lds, 3, bid - full, G - full, tid); } else bg_convert(a, lds, 3, bid, G, tid); })
    PH(12, ph_attention(a, lds, tid, lane, wave, bid, G);)
    PH(13, pg8::Gemm g{hbuf, (const bf16*)(ws + WS_WOC), M, D, D}; pg8::StaticOrder S; S.init(M, D, G, bid);
            pg8::EpiDelta E{dlt, modF + 5 * 6144 + 2 * 1024};
            pg8::gemm_phase<pg8::EpiDelta, pg8::StaticOrder, MK_ALIGN, MK_SP2>(lds, g, S, E);
            { const int busy = (M / 256) * (D / 256); if (G > busy) { if (bid >= busy) cache_out(a, bid - busy, G - busy, tid); } else cache_out(a, bid, G, tid); })
    PH(14, ph_norm(out, out, dlt, out, a.in[I_GFFN] + D, modF + 5 * 6144, 3, 4, hbuf, gw, NGW, lane);)
    PH(15, GEMM_UP(1);)
    PH(16, GEMM_DOWN(1);)
    PH(17, ph_final_norm(out, dlt, a.in[I_GFIN], gw, NGW, lane);)
#undef IN
#undef SEAM
}
}

extern "C" void kernel_launch(void* const* d_in, const int* in_sizes, int n_in, void* d_out, int out_size, void* d_ws, size_t ws_size, hipStream_t stream) {
    using namespace mk;
    static int grid = 0;
    if (grid == 0) {
        if (n_in != 33 || out_size != 23085184 || ws_size < WS_END) { fprintf(stderr, "kernel_launch: unexpected shapes: n_in %d out %d ws %zu\n", n_in, out_size, ws_size); grid = -1; return; }
        int dev = 0, cus = 0, per_cu = 0;
        if (hipGetDevice(&dev) != hipSuccess || hipDeviceGetAttribute(&cus, hipDeviceAttributeMultiprocessorCount, dev) != hipSuccess) { grid = -1; return; }
        if (hipFuncSetAttribute((const void*)mk_fwd, hipFuncAttributeMaxDynamicSharedMemorySize, LDS_BYTES) != hipSuccess) { fprintf(stderr, "kernel_launch: hipFuncSetAttribute failed\n"); grid = -1; return; }
        if (hipOccupancyMaxActiveBlocksPerMultiprocessor(&per_cu, (const void*)mk_fwd, NTHR, LDS_BYTES) != hipSuccess || per_cu < 1) { fprintf(stderr, "kernel_launch: occupancy query says %d\n", per_cu); per_cu = 1; }
        (void)hipGetLastError();
        grid = cus;
    }
    if (grid < 0) return;
    if (hipMemsetAsync((char*)d_ws + WS_CTL, 0, CTL_ZERO_BYTES, stream) != hipSuccess) return;
    Args a{};
    for (int i = 0; i < 33; ++i) a.in[i] = (const float*)d_in[i];
    a.out = (float*)d_out; a.ws = (unsigned char*)d_ws;
#if MK_ONE_LAUNCH
    a.ph_lo = 0; a.ph_hi = NPHASES;
    { void* args[] = {&a};
      hipError_t e = hipLaunchCooperativeKernel((const void*)mk_fwd, dim3(grid), dim3(NTHR), args, LDS_BYTES, stream);
      if (e != hipSuccess) fprintf(stderr, "kernel_launch: cooperative launch failed: %s (grid %d)\n", hipGetErrorString(e), grid); }
#else
    for (int ph = 0; ph < NPHASES; ++ph) { a.ph_lo = ph; a.ph_hi = ph + 1; hipLaunchKernelGGL(mk_fwd, dim3(grid), dim3(NTHR), LDS_BYTES, stream, a); }
#endif
}
```

```cpp
#include <hip/hip_runtime.h>
#include <cstdio>
#include <cstdint>
namespace pg8 {
#define PG8_LAS __attribute__((address_space(3)))
typedef unsigned short bf16_t;
typedef short bf16x8 __attribute__((ext_vector_type(8)));
typedef float f32x4 __attribute__((ext_vector_type(4)));
typedef unsigned u32x4 __attribute__((ext_vector_type(4)));
constexpr int BM = 256, BK = 64, HALF = 128, HTB = HALF * BK * 2  , STAGE_BYTES = 8 * HTB, NXCD = 8, WGM = 8;

__host__ __device__ __forceinline__ int lds_byte(int r, int c) { const int st = (r >> 4) * 2 + (c >> 5), rr = r & 15, cc = c & 31, ob = rr * 64 + cc * 2; return st * 1024 + (ob ^ (((ob >> 9) & 1) << 5)); }
__host__ __device__ __forceinline__ void stage_rc(int b, int& R, int& C) { const int st = b / 1024, sb = b % 1024, swz = sb ^ (((sb >> 9) & 1) << 5); R = (st >> 1) * 16 + swz / 64; C = (st & 1) * 32 + (swz % 64) / 2; }
__host__ __device__ __forceinline__ int perm32(int rho) { const int n = rho >> 4, i = rho & 15; return 8 * (i >> 2) + 4 * n + (i & 3); }

struct Unit { int pm, pn; };
struct Gemm { const bf16_t* A; const bf16_t* Bt; int M, N, K; };

struct StaticOrder {
    int nM, nN, nwg, G, c;
    __host__ __device__ void init(int M, int N, int G_, int c_) { nM = M / BM; nN = N / BM; nwg = nM * nN; G = G_; c = c_; }
    __host__ __device__ __forceinline__ bool next(int i, Unit& u) const {
        const long L = (long)i * G + c; if (L >= nwg) return false;
        int wgid = (int)L; { const int q = nwg / NXCD, r = nwg % NXCD, xcd = wgid % NXCD, off = wgid / NXCD; wgid = (xcd < r ? xcd * (q + 1) : r * (q + 1) + (xcd - r) * q) + off; }
        const int nig = WGM * nN, gid = wgid / nig, fm = gid * WGM, gsz = (nM - fm) < WGM ? (nM - fm) : WGM;
        u.pm = fm + ((wgid % nig) % gsz); u.pn = (wgid % nig) / gsz; return true;
    }
    __device__ __forceinline__ void a_ready(const Unit&) const {}
    __device__ __forceinline__ void done(const Unit&) const {}
};

__device__ __forceinline__ unsigned cvt_pk_bf16(float lo, float hi) { unsigned r; asm volatile("v_cvt_pk_bf16_f32 %0, %1, %2" : "=v"(r) : "v"(lo), "v"(hi)); return r; }
typedef float f32x2 __attribute__((ext_vector_type(2)));
__device__ __forceinline__ f32x2 gelu_pk(f32x2 v) {
    const f32x2 av = __builtin_elementwise_abs(v), d = av * 0.2316418882f + 1.0f;
    f32x2 t; t.x = __builtin_amdgcn_rcpf(d.x); t.y = __builtin_amdgcn_rcpf(d.y);
    f32x2 q = t * 0.5307027145f + (-0.7265760135f); q = q * t + 0.7107068705f; q = q * t + (-0.142248368f); q = q * t + 0.127414796f; q = q * t;
    const f32x2 s = (v * v) * (-0.72134752044f);
    f32x2 e; e.x = __builtin_amdgcn_exp2f(s.x); e.y = __builtin_amdgcn_exp2f(s.y);
    const f32x2 m = v * (q * e), r = v - m;
    f32x2 o; o.x = v.x < 0.f ? m.x : r.x; o.y = v.y < 0.f ? m.y : r.y; return o;
}

template <int ACT  > struct EpiBf16 {
    static constexpr bool PERM = true, AFTER_DRAIN = false; static_assert(ACT == 0 || ACT == 1, "EpiBf16: ACT is 0 (none) or 1 (gelu_pk)");
    bf16_t* O; int ldc; const float* bias; int split_cols; size_t split_stride; float scale0;
    __device__ __forceinline__ void operator()(const f32x4 (&acc)[2][2][4][2], const Unit& u, int wr, int wc, int fr, int fq) const {
        const int row0 = u.pm * BM + wr * 64 + fr; int colt = u.pn * BM; bf16_t* base = O;
        float sc = 1.f; if (split_cols) { const int t = colt / split_cols; base += (size_t)t * split_stride; colt -= t * split_cols; if (t == 0) sc = scale0; }
        const int col0 = colt + wc * 32 + 8 * fq, bcol0 = u.pn * BM + wc * 32 + 8 * fq;
        f32x4 bv[2][2];
#pragma unroll
        for (int bj = 0; bj < 2; ++bj)
#pragma unroll
            for (int n = 0; n < 2; ++n) bv[bj][n] = bias ? *(const f32x4*)(bias + bcol0 + bj * HALF + 4 * n) : (f32x4){0.f, 0.f, 0.f, 0.f};
#pragma unroll
        for (int ai = 0; ai < 2; ++ai)
#pragma unroll
            for (int m = 0; m < 4; ++m) { bf16_t* rowp = base + (size_t)(row0 + ai * HALF + m * 16) * ldc + col0;
#pragma unroll
                for (int bj = 0; bj < 2; ++bj) { f32x4 v0 = acc[ai][bj][m][0] + bv[bj][0], v1 = acc[ai][bj][m][1] + bv[bj][1];
                    if (ACT == 1) { f32x2 a = gelu_pk((f32x2){v0[0], v0[1]}), b = gelu_pk((f32x2){v0[2], v0[3]}), c = gelu_pk((f32x2){v1[0], v1[1]}), d = gelu_pk((f32x2){v1[2], v1[3]});
                        v0 = (f32x4){a.x, a.y, b.x, b.y}; v1 = (f32x4){c.x, c.y, d.x, d.y}; }
                    v0 = v0 * sc; v1 = v1 * sc; u32x4 w; w.x = cvt_pk_bf16(v0[0], v0[1]); w.y = cvt_pk_bf16(v0[2], v0[3]); w.z = cvt_pk_bf16(v1[0], v1[1]); w.w = cvt_pk_bf16(v1[2], v1[3]);
                    *(u32x4*)(rowp + bj * HALF) = w; } }
    }
};
typedef float f32x2e __attribute__((ext_vector_type(2)));
typedef __bf16 bf2e __attribute__((ext_vector_type(2)));
__device__ __forceinline__ unsigned pkbf(float lo, float hi) { f32x2e v = {lo, hi}; bf2e b = __builtin_convertvector(v, bf2e); return __builtin_bit_cast(unsigned, b); }
template <int CTRL> __device__ __forceinline__ float dpp_mov(float old, float src) {
    return __builtin_bit_cast(float, __builtin_amdgcn_update_dpp(__builtin_bit_cast(int, old), __builtin_bit_cast(int, src), CTRL, 0xF, 0xF, false)); }
struct EpiInAB {
    static constexpr bool PERM = true, AFTER_DRAIN = false;
    bf16_t* QK; bf16_t* VO; float* gates; const float* wconv; float* qkbnd; PG8_LAS float* xch;
    __device__ __forceinline__ void operator()(const f32x4 (&acc)[2][2][4][2], const Unit& u, int wr, int wc, int fr, int fq) const {
        const int row0 = u.pm * BM + wr * 64 + fr;
        if (u.pn >= 4) {
            if (u.pn < 8) { const int col0 = (u.pn - 4) * BM + wc * 32 + 8 * fq;
#pragma unroll
                for (int ai = 0; ai < 2; ++ai)
#pragma unroll
                    for (int m = 0; m < 4; ++m) { bf16_t* rowp = VO + (size_t)(row0 + ai * HALF + m * 16) * 1024 + col0;
#pragma unroll
                        for (int bj = 0; bj < 2; ++bj) { const f32x4 v0 = acc[ai][bj][m][0], v1 = acc[ai][bj][m][1];
                            u32x4 w; w.x = pkbf(v0[0], v0[1]); w.y = pkbf(v0[2], v0[3]); w.z = pkbf(v1[0], v1[1]); w.w = pkbf(v1[2], v1[3]); *(u32x4*)(rowp + bj * HALF) = w; } }
            } else if (wc == 0 && fq < 2) {
#pragma unroll
                for (int ai = 0; ai < 2; ++ai)
#pragma unroll
                    for (int m = 0; m < 4; ++m) { float* g = gates + (size_t)(row0 + ai * HALF + m * 16) * 16 + 8 * fq; *(f32x4*)g = acc[ai][0][m][0]; *(f32x4*)(g + 4) = acc[ai][0][m][1]; }
            }
            asm volatile("s_waitcnt lgkmcnt(0)" ::: "memory"); __builtin_amdgcn_s_barrier(); asm volatile("" ::: "memory");
            return;
        }
        const int cl = 32 * wc + 8 * fq;
        const int isk = u.pn >> 1; const float osc = isk ? 0.08838834764831845f : 1.0f;
        bf16_t* obase = QK + (size_t)isk * ((size_t)12288 * 512) + (u.pn & 1) * BM;
#pragma unroll
        for (int ai = 0; ai < 2; ++ai) { const int s = ai * 2 + wr;
#pragma unroll
            for (int bj = 0; bj < 2; ++bj) {
                if (fr == 0) { *(PG8_LAS f32x4*)(xch + (s * 2 + 0) * 256 + bj * HALF + cl) = acc[ai][bj][0][0]; *(PG8_LAS f32x4*)(xch + (s * 2 + 0) * 256 + bj * HALF + cl + 4) = acc[ai][bj][0][1]; }
                if (fr == 15) { *(PG8_LAS f32x4*)(xch + (s * 2 + 1) * 256 + bj * HALF + cl) = acc[ai][bj][3][0]; *(PG8_LAS f32x4*)(xch + (s * 2 + 1) * 256 + bj * HALF + cl + 4) = acc[ai][bj][3][1]; } } }
        asm volatile("s_waitcnt lgkmcnt(0)" ::: "memory"); __builtin_amdgcn_s_barrier(); asm volatile("" ::: "memory");
#pragma unroll
        for (int bj = 0; bj < 2; ++bj) { const int colw = u.pn * BM + bj * HALF + cl;
            float w0[8], w1[8], w2[8];
            { const f32x4 a0 = *(const f32x4*)(wconv + colw), a1 = *(const f32x4*)(wconv + colw + 4), b0 = *(const f32x4*)(wconv + 1024 + colw), b1 = *(const f32x4*)(wconv + 1024 + colw + 4),
                          c0 = *(const f32x4*)(wconv + 2048 + colw), c1 = *(const f32x4*)(wconv + 2048 + colw + 4);
#pragma unroll
              for (int i = 0; i < 4; ++i) { w0[i] = a0[i]; w0[4 + i] = a1[i]; w1[i] = b0[i]; w1[4 + i] = b1[i]; w2[i] = c0[i]; w2[4 + i] = c1[i]; } }
#pragma unroll
            for (int ai = 0; ai < 2; ++ai) { const int s = ai * 2 + wr;
                f32x4 up[2], dn[2];
#pragma unroll
                for (int n = 0; n < 2; ++n) { up[n] = s > 0 ? *(const PG8_LAS f32x4*)(xch + ((s - 1) * 2 + 1) * 256 + bj * HALF + cl + 4 * n) : (f32x4){0.f, 0.f, 0.f, 0.f};
                                              dn[n] = s < 3 ? *(const PG8_LAS f32x4*)(xch + ((s + 1) * 2 + 0) * 256 + bj * HALF + cl + 4 * n) : (f32x4){0.f, 0.f, 0.f, 0.f}; }
#pragma unroll
                for (int m = 0; m < 4; ++m) { const int row = row0 + ai * HALF + m * 16; float o[8];
#pragma unroll
                    for (int n = 0; n < 2; ++n)
#pragma unroll
                        for (int i = 0; i < 4; ++i) { const float cur = acc[ai][bj][m][n][i];
                            const float pold = m > 0 ? dpp_mov<0x121>(0.f, acc[ai][bj][m > 0 ? m - 1 : 0][n][i]) : up[n][i];
                            const float prev = dpp_mov<0x111>(pold, cur);
                            const float nold = m < 3 ? dpp_mov<0x12F>(0.f, acc[ai][bj][m < 3 ? m + 1 : 3][n][i]) : dn[n][i];
                            const float next = dpp_mov<0x101>(nold, cur);
                            const float v = w0[4 * n + i] * prev + w1[4 * n + i] * cur + w2[4 * n + i] * next;
                            o[4 * n + i] = v * __builtin_amdgcn_rcpf(1.f + __builtin_amdgcn_exp2f(-1.4426950408889634f * v)) * osc; }
                    const bool edge = (s == 0 && m == 0 && fr == 0) || (s == 3 && m == 3 && fr == 15);
                    if (!edge) { u32x4 w; w.x = pkbf(o[0], o[1]); w.y = pkbf(o[2], o[3]); w.z = pkbf(o[4], o[5]); w.w = pkbf(o[6], o[7]); *(u32x4*)(obase + (size_t)row * 512 + bj * HALF + cl) = w; }
                    if (s == 0 && m == 0 && fr < 2) { float* p = qkbnd + ((size_t)(u.pm * 4 + fr)) * 1024 + colw; *(f32x4*)p = acc[ai][bj][m][0]; *(f32x4*)(p + 4) = acc[ai][bj][m][1]; }
                    if (s == 3 && m == 3 && fr >= 14) { float* p = qkbnd + ((size_t)(u.pm * 4 + 2 + (fr - 14))) * 1024 + colw; *(f32x4*)p = acc[ai][bj][m][0]; *(f32x4*)(p + 4) = acc[ai][bj][m][1]; }
                }
            }
        }
    }
};
struct EpiDelta {
    static constexpr bool PERM = true, AFTER_DRAIN = false;
    bf16_t* Dl; const float* gate5;
    __device__ __forceinline__ void operator()(const f32x4 (&acc)[2][2][4][2], const Unit& u, int wr, int wc, int fr, int fq) const {
        const int row0 = u.pm * BM + wr * 64 + fr, col0 = u.pn * BM + wc * 32 + 8 * fq;
        const int v = u.pm < 16 ? 4 : ((u.pm - 16) >> 3);
        const float* g = gate5 + (size_t)v * 6144;
        f32x4 gv[2][2];
#pragma unroll
        for (int bj = 0; bj < 2; ++bj)
#pragma unroll
            for (int n = 0; n < 2; ++n) gv[bj][n] = *(const f32x4*)(g + col0 + bj * HALF + 4 * n);
#pragma unroll
        for (int ai = 0; ai < 2; ++ai)
#pragma unroll
            for (int m = 0; m < 4; ++m) { bf16_t* rowp = Dl + (size_t)(row0 + ai * HALF + m * 16) * 1024 + col0;
#pragma unroll
                for (int bj = 0; bj < 2; ++bj) { const f32x4 v0 = acc[ai][bj][m][0] * gv[bj][0], v1 = acc[ai][bj][m][1] * gv[bj][1];
                    u32x4 w; w.x = pkbf(v0[0], v0[1]); w.y = pkbf(v0[2], v0[3]); w.z = pkbf(v1[0], v1[1]); w.w = pkbf(v1[2], v1[3]);
                    *(u32x4*)(rowp + bj * HALF) = w; } }
    }
};
struct EpiQKV {
    static constexpr bool PERM = true, AFTER_DRAIN = false;
    bf16_t* Q; size_t qkv_stride;
    __device__ __forceinline__ void operator()(const f32x4 (&acc)[2][2][4][2], const Unit& u, int wr, int wc, int fr, int fq) const {
        const int t = u.pn >> 2; const int colt = (u.pn & 3) * BM;
        bf16_t* base = Q + (size_t)t * qkv_stride; const float sc = t == 0 ? 0.18033688011112042f : 1.0f;
        const int row0 = u.pm * BM + wr * 64 + fr, col0 = colt + wc * 32 + 8 * fq;
#pragma unroll
        for (int ai = 0; ai < 2; ++ai)
#pragma unroll
            for (int m = 0; m < 4; ++m) { const int row = row0 + ai * HALF + m * 16; bf16_t* rowp = base + (size_t)row * 1024 + col0;
#pragma unroll
                for (int bj = 0; bj < 2; ++bj) { const f32x4 v0 = acc[ai][bj][m][0] * sc, v1 = acc[ai][bj][m][1] * sc;
                    u32x4 w; w.x = pkbf(v0[0], v0[1]); w.y = pkbf(v0[2], v0[3]); w.z = pkbf(v1[0], v1[1]); w.w = pkbf(v1[2], v1[3]);
                    *(u32x4*)(rowp + bj * HALF) = w; } }
    }
};
struct EpiFfn {
    static constexpr bool PERM = true, AFTER_DRAIN = false;
    bf16_t* act; const float* wconv; float* abnd; float* gbnd; PG8_LAS float* xch;
    __device__ __forceinline__ void operator()(const f32x4 (&acc)[2][2][4][2], const Unit& u, int wr, int wc, int fr, int fq) const {
        constexpr int FFW = 2816;
        const int cl = 32 * wc + 8 * fq, col8 = 128 * u.pn + cl;
        float w0[8], w1[8], w2[8];
        { const f32x4 a0 = *(const f32x4*)(wconv + col8), a1 = *(const f32x4*)(wconv + col8 + 4), b0 = *(const f32x4*)(wconv + FFW + col8), b1 = *(const f32x4*)(wconv + FFW + col8 + 4),
                      c0 = *(const f32x4*)(wconv + 2 * FFW + col8), c1 = *(const f32x4*)(wconv + 2 * FFW + col8 + 4);
#pragma unroll
          for (int i = 0; i < 4; ++i) { w0[i] = a0[i]; w0[4 + i] = a1[i]; w1[i] = b0[i]; w1[4 + i] = b1[i]; w2[i] = c0[i]; w2[4 + i] = c1[i]; } }
#pragma unroll
        for (int ai = 0; ai < 2; ++ai) { const int s = ai * 2 + wr;
            if (fr == 0) { *(PG8_LAS f32x4*)(xch + (s * 2 + 0) * 128 + cl) = acc[ai][0][0][0]; *(PG8_LAS f32x4*)(xch + (s * 2 + 0) * 128 + cl + 4) = acc[ai][0][0][1]; }
            if (fr == 15) { *(PG8_LAS f32x4*)(xch + (s * 2 + 1) * 128 + cl) = acc[ai][0][3][0]; *(PG8_LAS f32x4*)(xch + (s * 2 + 1) * 128 + cl + 4) = acc[ai][0][3][1]; } }
        asm volatile("s_waitcnt lgkmcnt(0)" ::: "memory"); __builtin_amdgcn_s_barrier(); asm volatile("" ::: "memory");
#pragma unroll
        for (int ai = 0; ai < 2; ++ai) { const int s = ai * 2 + wr;
            f32x4 up[2], dn[2];
#pragma unroll
            for (int n = 0; n < 2; ++n) { up[n] = s > 0 ? *(const PG8_LAS f32x4*)(xch + ((s - 1) * 2 + 1) * 128 + cl + 4 * n) : (f32x4){0.f, 0.f, 0.f, 0.f};
                                          dn[n] = s < 3 ? *(const PG8_LAS f32x4*)(xch + ((s + 1) * 2 + 0) * 128 + cl + 4 * n) : (f32x4){0.f, 0.f, 0.f, 0.f}; }
#pragma unroll
            for (int m = 0; m < 4; ++m) { const int row = u.pm * BM + ai * HALF + wr * 64 + m * 16 + fr; float o[8];
#pragma unroll
                for (int n = 0; n < 2; ++n)
#pragma unroll
                    for (int i = 0; i < 4; ++i) { const float cur = acc[ai][0][m][n][i];
                        const float pold = m > 0 ? dpp_mov<0x121>(0.f, acc[ai][0][m > 0 ? m - 1 : 0][n][i]) : up[n][i];
                        const float prev = dpp_mov<0x111>(pold, cur);
                        const float nold = m < 3 ? dpp_mov<0x12F>(0.f, acc[ai][0][m < 3 ? m + 1 : 3][n][i]) : dn[n][i];
                        const float next = dpp_mov<0x101>(nold, cur);
                        const float v = w0[4 * n + i] * prev + w1[4 * n + i] * cur + w2[4 * n + i] * next;
                        const float u2 = v * (-2.3022081981f + -0.1029432396f * v * v);
                        o[4 * n + i] = v * __builtin_amdgcn_rcpf(1.f + __builtin_amdgcn_exp2f(u2)) * acc[ai][1][m][n][i]; }
                const bool edge = (s == 0 && m == 0 && fr == 0) || (s == 3 && m == 3 && fr == 15);
                if (!edge) { u32x4 w; w.x = pkbf(o[0], o[1]); w.y = pkbf(o[2], o[3]); w.z = pkbf(o[4], o[5]); w.w = pkbf(o[6], o[7]); *(u32x4*)(act + (size_t)row * FFW + col8) = w; }
                if (s == 0 && m == 0 && fr < 2) { float* p = abnd + ((size_t)(u.pm * 4 + fr)) * FFW + col8; *(f32x4*)p = acc[ai][0][m][0]; *(f32x4*)(p + 4) = acc[ai][0][m][1];
                    if (fr == 0) { float* q = gbnd + ((size_t)(u.pm * 2 + 0)) * FFW + col8; *(f32x4*)q = acc[ai][1][m][0]; *(f32x4*)(q + 4) = acc[ai][1][m][1]; } }
                if (s == 3 && m == 3 && fr >= 14) { float* p = abnd + ((size_t)(u.pm * 4 + 2 + (fr - 14))) * FFW + col8; *(f32x4*)p = acc[ai][0][m][0]; *(f32x4*)(p + 4) = acc[ai][0][m][1];
                    if (fr == 15) { float* q = gbnd + ((size_t)(u.pm * 2 + 1)) * FFW + col8; *(f32x4*)q = acc[ai][1][m][0]; *(f32x4*)(q + 4) = acc[ai][1][m][1]; } }
            }
        }
    }
};
template <class Epi, class Sched, bool ALIGN_EPI = false, bool SP2 = false>
__device__ __forceinline__ void gemm_phase(PG8_LAS unsigned char* lds, const Gemm g, const Sched& S, const Epi& E) {
    const int tid = threadIdx.x, wid = __builtin_amdgcn_readfirstlane(tid >> 6), lane = tid & 63, wr = wid >> 2, wc = wid & 3, fr = lane & 15, fq = lane >> 4;
    const int K = g.K, nt = K / BK;
    unsigned voffA[2], voffB[2];
#pragma unroll
    for (int i = 0; i < 2; ++i) { int R, C; stage_rc(tid * 16 + i * 8192, R, C); const int Rb = Epi::PERM ? ((R & ~31) + perm32(R & 31)) : R;
        voffA[i] = (unsigned)(R * K + C) * 2u; voffB[i] = (unsigned)(Rb * K + C) * 2u; }
    const size_t kstep = (size_t)(BK * 2);
    const size_t hstep = (size_t)HALF * K * 2;
    const size_t tstep = 2 * hstep;
    const unsigned ldsw = (unsigned)wid * 1024u;
    const int aoff = lds_byte(wr * 64 + fr, fq * 8), boff = lds_byte(wc * 32 + fr, fq * 8);
#define PG8_SA(b, h) (((b) * 2 + (h)) * HTB)
#define PG8_SB(b, h) ((4 + (b) * 2 + (h)) * HTB)
#define PG8_STAGE(bufoff, gbase, voff) do { _Pragma("unroll") for (int _i = 0; _i < 2; ++_i) \
        __builtin_amdgcn_global_load_lds((const unsigned*)((const char*)(gbase) + (voff)[_i]), (PG8_LAS unsigned*)(lds + (bufoff) + ldsw + _i * 8192), 16, 0, 0); } while (0)
#define PG8_LDA(dst, b, h) do { _Pragma("unroll") for (int m = 0; m < 4; ++m) _Pragma("unroll") for (int k = 0; k < 2; ++k) dst[m][k] = *(const PG8_LAS bf16x8*)(lds + PG8_SA(b, h) + aoff + m * 2048 + k * 1024); } while (0)
#define PG8_LDB(dst, b, h) do { _Pragma("unroll") for (int n = 0; n < 2; ++n) _Pragma("unroll") for (int k = 0; k < 2; ++k) dst[n][k] = *(const PG8_LAS bf16x8*)(lds + PG8_SB(b, h) + boff + n * 2048 + k * 1024); } while (0)
#define PG8_MMA(ai, bj, At, Bt) do { __builtin_amdgcn_s_setprio(1); _Pragma("unroll") for (int m = 0; m < 4; ++m) _Pragma("unroll") for (int n = 0; n < 2; ++n) _Pragma("unroll") for (int k = 0; k < 2; ++k) \
        acc[ai][bj][m][n] = __builtin_amdgcn_mfma_f32_16x16x32_bf16(Bt[n][k], At[m][k], acc[ai][bj][m][n], 0, 0, 0); __builtin_amdgcn_s_setprio(0); } while (0)
#define PG8_WAIT_V(n) asm volatile("s_waitcnt vmcnt(" #n ")" ::: "memory")
#define PG8_WAIT_L(n) asm volatile("s_waitcnt lgkmcnt(" #n ")" ::: "memory")
#define PG8_BAR __builtin_amdgcn_s_barrier()
#define PG8_SCHED __builtin_amdgcn_sched_barrier(0)
    Unit cur, nxt; int ui = 0;
    if (!S.next(0, cur)) return;
    f32x4 acc[2][2][4][2];
#pragma unroll
    for (int a = 0; a < 2; ++a)
#pragma unroll
        for (int b = 0; b < 2; ++b)
#pragma unroll
            for (int m = 0; m < 4; ++m)
#pragma unroll
                for (int n = 0; n < 2; ++n) acc[a][b][m][n] = (f32x4){0.f, 0.f, 0.f, 0.f};
    bf16x8 At[4][2], B0[2][2], B1[2][2];
    const char* cA = (const char*)g.A + (size_t)cur.pm * tstep; const char* cB = (const char*)g.Bt + (size_t)cur.pn * tstep;
    S.a_ready(cur);
    if constexpr (SP2) {
        PG8_STAGE(PG8_SB(0, 0), cB, voffB); PG8_STAGE(PG8_SB(0, 1), cB + hstep, voffB); PG8_STAGE(PG8_SA(0, 0), cA, voffA); PG8_STAGE(PG8_SA(0, 1), cA + hstep, voffA);
        if (wr == 1) PG8_BAR;
        PG8_WAIT_V(2); PG8_BAR;
        PG8_STAGE(PG8_SB(1, 0), cB + kstep, voffB); PG8_STAGE(PG8_SA(1, 0), cA + kstep, voffA); PG8_STAGE(PG8_SB(1, 1), cB + hstep + kstep, voffB);
        PG8_WAIT_V(6); PG8_BAR;
    } else {
        PG8_STAGE(PG8_SB(0, 0), cB, voffB); PG8_STAGE(PG8_SA(0, 0), cA, voffA); PG8_STAGE(PG8_SB(0, 1), cB + hstep, voffB); PG8_STAGE(PG8_SA(0, 1), cA + hstep, voffA);
        if (wr == 1) PG8_BAR;
        PG8_WAIT_V(4); PG8_BAR;
        PG8_STAGE(PG8_SB(1, 0), cB + kstep, voffB); PG8_STAGE(PG8_SA(1, 0), cA + kstep, voffA); PG8_STAGE(PG8_SB(1, 1), cB + hstep + kstep, voffB);
        PG8_WAIT_V(6); PG8_BAR;
    }
    for (;;) {
        const bool has_next = S.next(ui + 1, nxt);
        const char* nA = has_next ? (const char*)g.A + (size_t)nxt.pm * tstep : cA; const char* nB = has_next ? (const char*)g.Bt + (size_t)nxt.pn * tstep : cB;
        for (int t = 0; t < nt; t += 2) {
            const bool last = (t == nt - 2);
            const char* a1 = cA + (size_t)(t + 1) * kstep;
            const char* a2 = last ? nA : cA + (size_t)(t + 2) * kstep; const char* b2 = last ? nB : cB + (size_t)(t + 2) * kstep;
            const char* a3 = a2 + kstep; const char* b3 = b2 + kstep;
            if (last && has_next) S.a_ready(nxt);
            if constexpr (SP2) {
            PG8_LDB(B0, 0, 0); PG8_LDB(B1, 0, 1); PG8_SCHED; PG8_LDA(At, 0, 0); PG8_STAGE(PG8_SA(1, 1), a1 + hstep, voffA);
            PG8_WAIT_V(8); PG8_WAIT_L(0); PG8_BAR; PG8_MMA(0, 0, At, B0); PG8_MMA(0, 1, At, B1); PG8_BAR; PG8_SCHED;
            PG8_LDA(At, 0, 1); PG8_STAGE(PG8_SB(0, 0), b2, voffB); PG8_STAGE(PG8_SB(0, 1), b2 + hstep, voffB); PG8_STAGE(PG8_SA(0, 0), a2, voffA);
            PG8_WAIT_V(8); PG8_WAIT_L(0); PG8_BAR; PG8_MMA(1, 0, At, B0); PG8_MMA(1, 1, At, B1); PG8_BAR; PG8_SCHED;
            PG8_LDB(B0, 1, 0); PG8_LDB(B1, 1, 1); PG8_SCHED; PG8_LDA(At, 1, 0); PG8_STAGE(PG8_SA(0, 1), a2 + hstep, voffA);
            PG8_WAIT_V(8); PG8_WAIT_L(0); PG8_BAR; PG8_MMA(0, 0, At, B0); PG8_MMA(0, 1, At, B1); PG8_BAR; PG8_SCHED;
            PG8_LDA(At, 1, 1); PG8_STAGE(PG8_SB(1, 0), b3, voffB); PG8_STAGE(PG8_SB(1, 1), b3 + hstep, voffB); PG8_STAGE(PG8_SA(1, 0), a3, voffA);
            PG8_WAIT_V(8); PG8_WAIT_L(0); PG8_BAR; PG8_MMA(1, 0, At, B0); PG8_MMA(1, 1, At, B1); PG8_BAR; PG8_SCHED;
            } else {
            PG8_LDB(B0, 0, 0); PG8_SCHED; PG8_LDA(At, 0, 0); PG8_STAGE(PG8_SA(1, 1), a1 + hstep, voffA);
            PG8_WAIT_L(8); PG8_BAR; PG8_WAIT_L(0); PG8_MMA(0, 0, At, B0); PG8_BAR; PG8_SCHED;
            PG8_LDB(B1, 0, 1); PG8_STAGE(PG8_SB(0, 0), b2, voffB);
            PG8_BAR; PG8_WAIT_L(0); PG8_MMA(0, 1, At, B1); PG8_BAR;
            PG8_LDA(At, 0, 1); PG8_STAGE(PG8_SA(0, 0), a2, voffA);
            PG8_BAR; PG8_WAIT_L(0); PG8_MMA(1, 0, At, B0); PG8_BAR; PG8_SCHED;
            PG8_STAGE(PG8_SB(0, 1), b2 + hstep, voffB);
            PG8_WAIT_V(6); PG8_BAR; PG8_MMA(1, 1, At, B1); PG8_BAR;
            PG8_LDB(B0, 1, 0); PG8_SCHED; PG8_LDA(At, 1, 0); PG8_STAGE(PG8_SA(0, 1), a2 + hstep, voffA);
            PG8_WAIT_L(8); PG8_BAR; PG8_WAIT_L(0); PG8_MMA(0, 0, At, B0); PG8_BAR; PG8_SCHED;
            PG8_LDB(B1, 1, 1); PG8_STAGE(PG8_SB(1, 0), b3, voffB);
            PG8_BAR; PG8_WAIT_L(0); PG8_MMA(0, 1, At, B1); PG8_BAR;
            PG8_LDA(At, 1, 1); PG8_STAGE(PG8_SA(1, 0), a3, voffA);
            PG8_BAR; PG8_WAIT_L(0); PG8_MMA(1, 0, At, B0); PG8_BAR; PG8_SCHED;
            PG8_STAGE(PG8_SB(1, 1), b3 + hstep, voffB);
            PG8_WAIT_V(6); PG8_BAR; PG8_MMA(1, 1, At, B1); PG8_BAR;
            }
        }
        if constexpr (ALIGN_EPI) { if (wr == 0) PG8_BAR; }
        if constexpr (!Epi::AFTER_DRAIN) { E(acc, cur, wr, wc, fr, fq); S.done(cur); }
        if (!has_next) break;
#pragma unroll
        for (int a = 0; a < 2; ++a)
#pragma unroll
            for (int b = 0; b < 2; ++b)
#pragma unroll
                for (int m = 0; m < 4; ++m)
#pragma unroll
                    for (int n = 0; n < 2; ++n) acc[a][b][m][n] = (f32x4){0.f, 0.f, 0.f, 0.f};
        cur = nxt; cA = nA; cB = nB; ++ui;
        if constexpr (ALIGN_EPI) { if (wr == 1) PG8_BAR; }
    }
    PG8_WAIT_V(0);
    if constexpr (!ALIGN_EPI) { if (wr == 0) PG8_BAR; }
    PG8_BAR;
    if constexpr (Epi::AFTER_DRAIN) { E.fused(acc, cur, wr, wc, fr, fq, lds, wid, lane); S.done(cur); }
#undef PG8_SA
#undef PG8_SB
#undef PG8_STAGE
#undef PG8_LDA
#undef PG8_LDB
#undef PG8_MMA
#undef PG8_WAIT_V
#undef PG8_WAIT_L
#undef PG8_BAR
#undef PG8_SCHED
}
}
#define GAS __attribute__((address_space(1)))
#define LAS __attribute__((address_space(3)))
#define DI __device__ __forceinline__
typedef unsigned short bf16;
typedef float f32x2 __attribute__((ext_vector_type(2)));
typedef float f32x4 __attribute__((ext_vector_type(4)));
typedef float f32x16 __attribute__((ext_vector_type(16)));
typedef short bf16x8 __attribute__((ext_vector_type(8)));
typedef unsigned u32x2 __attribute__((ext_vector_type(2)));
typedef unsigned u32x4 __attribute__((ext_vector_type(4)));
#define MFMA32(a, b, c) __builtin_amdgcn_mfma_f32_32x32x16_bf16((a), (b), (c), 0, 0, 0)

#ifndef MK_ONE_LAUNCH
#define MK_ONE_LAUNCH 1
#endif
namespace mk {
constexpr int NWAVES = 8, NTHR = 512;
constexpr int D = 1024, M = 12288, MPR = 4096;
constexpr int NPROJ = 2304, FF = 2816;
constexpr float EPS = 1e-6f;
constexpr int NPHASES = 18;
constexpr size_t OFF_C = 12582912, OFF_N = 14680064, OFF_MM = 14696448, OFF_K = 14696576, OFF_V = 18890880;
constexpr size_t MiB = 1u << 20;
constexpr size_t WS_CTL = 0, CTL_ZERO_BYTES = 1 * MiB;
constexpr size_t WS_MODP = 105 * MiB;
constexpr size_t WS_MODF = 5 * MiB;
constexpr size_t WS_GATES = 6 * MiB;
constexpr size_t WS_AS = 7 * MiB, WS_MS = 7 * MiB + 512 * 1024, WS_BS = 8 * MiB;
constexpr size_t WS_H2 = 10 * MiB;
constexpr size_t WS_NS = 9 * MiB;
constexpr size_t WS_R2048 = 12 * MiB;
constexpr size_t WS_R256 = 16 * MiB;
constexpr size_t WS_CK = 22 * MiB, WS_CV = 26 * MiB;
constexpr size_t WS_WAB = 30 * MiB, WS_WHY = 35 * MiB, WS_WOAB = 38 * MiB, WS_WC = 40 * MiB, WS_WOC = 46 * MiB, WS_WUP = 48 * MiB, WS_WDN = 70 * MiB;
constexpr size_t WS_H = 81 * MiB;
constexpr size_t WS_BIG = 105 * MiB;
constexpr size_t WS_VO = WS_BIG;
constexpr size_t WS_HYT = 129 * MiB;
constexpr size_t WS_QKBND = 166 * MiB;
constexpr size_t WS_QB = 195 * MiB, WS_KB = 207 * MiB;
constexpr size_t WS_FG = 171 * MiB;
constexpr size_t WS_XBF = 129 * MiB;
constexpr size_t WS_ABND = 154 * MiB, WS_GBND = 158 * MiB;
constexpr size_t WS_Q1 = 171 * MiB, WS_K1 = 195 * MiB, WS_V1 = 219 * MiB;
constexpr size_t WS_DL = WS_BIG;
constexpr size_t WS_END = 256 * MiB;
constexpr int CW_BAR = 4096;
constexpr int RING_BYTES = 131072, LDSCTL_OFF = RING_BYTES, MISC_OFF = LDSCTL_OFF + 320, XCH_OFF = RING_BYTES + 1024, LDS_BYTES = 147456;

DI float bf2f(unsigned short b) { return __uint_as_float((unsigned)b << 16); }
DI unsigned pk2(float lo, float hi) { return pg8::pkbf(lo, hi); }
DI void unpack8(const u32x4 v, float (&f)[8]) {
    f[0] = __uint_as_float(v.x << 16); f[1] = __uint_as_float(v.x & 0xffff0000u); f[2] = __uint_as_float(v.y << 16); f[3] = __uint_as_float(v.y & 0xffff0000u);
    f[4] = __uint_as_float(v.z << 16); f[5] = __uint_as_float(v.z & 0xffff0000u); f[6] = __uint_as_float(v.w << 16); f[7] = __uint_as_float(v.w & 0xffff0000u); }
DI u32x4 pack8(const float (&f)[8]) { u32x4 w; w.x = pk2(f[0], f[1]); w.y = pk2(f[2], f[3]); w.z = pk2(f[4], f[5]); w.w = pk2(f[6], f[7]); return w; }
DI float rcp_f(float x) { return __builtin_amdgcn_rcpf(x); }
DI float exp2_f(float x) { return __builtin_amdgcn_exp2f(x); }
DI float silu_f(float x) { return x * rcp_f(1.f + exp2_f(-1.4426950408889634f * x)); }
DI float sigm_f(float x) { return rcp_f(1.f + exp2_f(-1.4426950408889634f * x)); }
DI float gelu_tanh_f(float x) { const float u2 = x * (-2.3022081986f + -0.1029432396f * x * x); return x * rcp_f(1.f + exp2_f(u2)); }
DI float logsig_f(float x) { return fminf(x, 0.f) - log1pf(__expf(-fabsf(x))); }
DI float wave_sum(float v) {
#pragma unroll
    for (int o = 1; o < 64; o <<= 1) v += __shfl_xor(v, o);
    return v; }
#define LDS_WAIT() asm volatile("s_waitcnt lgkmcnt(0)" ::: "memory")

#define XB_TMO      128
#define XB_XCNT(j)  (256  + 64 * (j))
#define XB_XSUB(j)  (1280 + 64 * (j))
#define XB_XGEN(j)  (2304 + 64 * (j))
#define XB_TOP      3328
#define XB_TOPGEN   3392
#define XCD_BAR_WORDS 3456
#define XB_SPIN_CAP (1u << 20)
DI unsigned xb_ld(unsigned* p)              { return __hip_atomic_load(p, __ATOMIC_RELAXED, __HIP_MEMORY_SCOPE_AGENT); }
DI unsigned xb_add(unsigned* p, unsigned v) { return __hip_atomic_fetch_add(p, v, __ATOMIC_RELAXED, __HIP_MEMORY_SCOPE_AGENT); }
DI unsigned xb_xcc_id() { return (unsigned)__builtin_amdgcn_s_getreg((3 << 11) | 20) & 0xFu; }
#define XB_SPIN(cond, bar) do { unsigned _sp = 0; while (cond) { __builtin_amdgcn_s_sleep(1); \
    if ((++_sp & 255u) == 0u) { if (xb_ld(&(bar)[XB_TMO])) break; if (_sp > XB_SPIN_CAP) { atomicAdd(&(bar)[XB_TMO], 1u); break; } } } } while (0)
struct XcdBarrier { unsigned* bar; unsigned x; volatile LAS unsigned* st; };
DI XcdBarrier xcd_barrier_post(unsigned* bar, volatile LAS unsigned* st) {
    XcdBarrier b; b.bar = bar; b.x = xb_xcc_id(); b.st = st;
    if (threadIdx.x == 0) (void)xb_add(&bar[XB_XCNT(b.x)], 1u);
    return b;
}
DI void xcd_barrier_complete(unsigned* bar, unsigned x, unsigned& nloc, unsigned& nx) {
    const unsigned G = gridDim.x * gridDim.y * gridDim.z;
    unsigned sum, cnt, mine, sp = 0u;
    for (;;) {
        sum = 0u; cnt = 0u; mine = 0u;
#pragma unroll
        for (unsigned j = 0; j < 16; ++j) { const unsigned c = xb_ld(&bar[XB_XCNT(j)]); sum += c; cnt += (c > 0u) ? 1u : 0u; mine = (j == x) ? c : mine; }
        if (sum == G) break;
        __builtin_amdgcn_s_sleep(1);
        if ((++sp & 255u) == 0u) { if (xb_ld(&bar[XB_TMO])) break; if (sp > XB_SPIN_CAP) { atomicAdd(&bar[XB_TMO], 1u); break; } }
    }
    nloc = mine > 0u ? mine : 1u; nx = cnt > 0u ? cnt : 1u;
}
DI void xcd_barrier(const XcdBarrier& b) {
    asm volatile("s_waitcnt vmcnt(0)" ::: "memory");
    __syncthreads();
    if (threadIdx.x == 0) {
        unsigned* bar = b.bar;
        __builtin_amdgcn_s_waitcnt(0);
        unsigned nloc = b.st[0], nx = b.st[1];
        if (nloc == 0u) { xcd_barrier_complete(bar, b.x, nloc, nx); b.st[0] = nloc; b.st[1] = nx; }
        const unsigned old = xb_add(&bar[XB_XSUB(b.x)], 1u);
        const unsigned gen = old / nloc;
        if (old + 1u == (gen + 1u) * nloc) {
            __builtin_amdgcn_fence(__ATOMIC_RELEASE, "agent");
            asm volatile("s_waitcnt vmcnt(0)" ::: "memory");
            const unsigned og = xb_add(&bar[XB_TOP], 1u);
            const unsigned tg = og / nx;
            if (og + 1u == (tg + 1u) * nx) xb_add(&bar[XB_TOPGEN], 1u);
            else XB_SPIN(xb_ld(&bar[XB_TOPGEN]) == tg, bar);
            __builtin_amdgcn_fence(__ATOMIC_ACQUIRE, "agent");
            xb_add(&bar[XB_XGEN(b.x)], 1u);
            asm volatile("s_waitcnt vmcnt(0)" ::: "memory");
        } else {
            XB_SPIN(xb_ld(&bar[XB_XGEN(b.x)]) == gen, bar);
            __builtin_amdgcn_fence(__ATOMIC_ACQUIRE, "agent");
            asm volatile("s_waitcnt vmcnt(0)" ::: "memory");
        }
    }
    __syncthreads();
}

struct Args { const float* in[33]; float* out; unsigned char* ws; int ph_lo, ph_hi; };
enum { I_XP = 0, I_XS, I_STC, I_STN, I_STM, I_CK, I_CV, I_C, I_CCTX, I_WADA, I_BADA, I_GMIX, I_GFFN, I_GFIN, I_WINAB, I_BGATES, I_WCQK, I_GMLSTM, I_WCHY,
       I_WF1, I_BF1, I_WF2, I_BF2, I_WF3, I_FREQ, I_HYB, I_WOUTAB, I_WINC, I_RPB, I_WOUTC, I_WUP, I_WCFFN, I_WDOWN };

DI void row_seq(int row, int& base, int& L) { if (row < MPR) { base = row & ~255; L = 256; } else { base = MPR + ((row - MPR) & ~2047); L = 2048; } }
DI int row_vec(int row) { return row < MPR ? 4 : ((row - MPR) >> 11); }
template <bool FFN_PERM = false> DI void p0_transpose_tile(const float* W, int K, int N, int Npad, bf16* WT, LAS float* T, int item, int tid, int ldw = 0) {
    if (ldw == 0) ldw = N;
    const int nblk = Npad / 256, kb = item / nblk, nb = item % nblk, k0 = 64 * kb, n0 = 256 * nb;
    __syncthreads();
    { const int col = n0 + (tid & 63) * 4; const bool ok = col < N; const float* src = W + (size_t)k0 * ldw + col;
      f32x4 v[8];
#pragma unroll
      for (int i = 0; i < 8; ++i) { const int kk = i * 8 + (tid >> 6); v[i] = ok ? *(const f32x4*)(src + (size_t)kk * ldw) : (f32x4){0.f, 0.f, 0.f, 0.f}; }
#pragma unroll
      for (int i = 0; i < 8; ++i) { const int kk = i * 8 + (tid >> 6); *(LAS f32x4*)(T + kk * 260 + (tid & 63) * 4) = v[i]; } }
    __syncthreads();
#pragma unroll
    for (int j = 0; j < 4; ++j) { const int n = tid & 255, kg = (tid >> 8) + 2 * j; const LAS float* p = T + (8 * kg) * 260 + n;
        u32x4 o; o.x = pk2(p[0], p[260]); o.y = pk2(p[520], p[780]); o.z = pk2(p[1040], p[1300]); o.w = pk2(p[1560], p[1820]);
        int dr = n0 + n;
        if (FFN_PERM) { const int gsel = dr >= 2816, c = gsel ? dr - 2816 : dr; dr = (c >> 7) * 256 + gsel * 128 + (c & 127); }
        *(u32x4*)(WT + (size_t)dr * K + k0 + 8 * kg) = o; }
}
DI void p0_filter_stage1(const Args& a, int L, int p0, int gcol0, float* H2, LAS float* T, int tid, int lane, int wave) {
    const float* b1 = a.in[I_BF1]; const float* b2 = a.in[I_BF2]; const float* fr = a.in[I_FREQ];
    LAS float* w1s = T; LAS float* w2s = T + 2112; LAS float* hs = T + 2112 + 4096;
    __syncthreads();
    for (int i = tid; i < 2112; i += NTHR) w1s[i] = a.in[I_WF1][i];
    for (int i = tid; i < 4096; i += NTHR) w2s[i] = a.in[I_WF2][i];
    __syncthreads();
    const int p = p0 + lane; const float tpos = (float)p / (float)(L - 1), wrev = (float)p / (float)L;
    float z[33]; z[0] = tpos;
#pragma unroll
    for (int k = 0; k < 16; ++k) { const float band = 1e-4f + (float)k * ((15.0f - 1e-4f) / 15.0f); const float rv = band * wrev; const float ph = 6.283185307179586f * (rv - floorf(rv));
        z[1 + k] = __cosf(ph); z[17 + k] = -__sinf(ph); }
#pragma unroll
    for (int jj = 0; jj < 8; ++jj) { const int j = 8 * wave + jj; float t = b1[j];
#pragma unroll
        for (int i = 0; i < 33; ++i) t += z[i] * w1s[i * 64 + j];
        hs[j * 64 + lane] = sinf(fr[j] * t); }
    __syncthreads();
    float acc[8];
#pragma unroll
    for (int jj = 0; jj < 8; ++jj) acc[jj] = b2[8 * wave + jj];
#pragma unroll 8
    for (int i = 0; i < 64; ++i) { const float hv = hs[i * 64 + lane]; const LAS float* wr = w2s + i * 64 + 8 * wave;
#pragma unroll
        for (int jj = 0; jj < 8; ++jj) acc[jj] += hv * wr[jj]; }
#pragma unroll
    for (int jj = 0; jj < 8; ++jj) { const int j = 8 * wave + jj; H2[(size_t)j * 2304 + gcol0 + lane] = sinf(fr[j] * acc[jj]); }
}
DI void p1_filter_stage2(const Args& a, int L, int p0, int gcol0, int cb, const float* H2, bf16* R, LAS float* w3t, int lane) {
    const float* w3 = a.in[I_WF3];
    const int p = p0 + lane; const float tpos = (float)p / (float)(L - 1);
    float h2[64];
#pragma unroll
    for (int i = 0; i < 64; ++i) h2[i] = H2[(size_t)i * 2304 + gcol0 + lane];
#pragma unroll
    for (int r = 0; r < 16; ++r) { const int i = (lane >> 4) + 4 * r; w3t[(lane & 15) * 64 + i] = w3[i * 1024 + cb * 16 + (lane & 15)]; }
    LDS_WAIT(); asm volatile("" ::: "memory");
    const float mind = -3.0701134573f, maxd = -15.3505672866f;
#pragma unroll 2
    for (int cc = 0; cc < 16; ++cc) { const int c = cb * 16 + cc, c5 = c & 511; float t0 = 0.f, t1 = 0.f, t2 = 0.f, t3 = 0.f;
#pragma unroll
        for (int q = 0; q < 16; ++q) { const f32x4 w = *(const LAS f32x4*)(w3t + cc * 64 + 4 * q); t0 += h2[4 * q] * w[0]; t1 += h2[4 * q + 1] * w[1]; t2 += h2[4 * q + 2] * w[2]; t3 += h2[4 * q + 3] * w[3]; }
        const float delta = fabsf(mind + (float)c5 * ((maxd - mind) / 511.0f)); const float v = ((t0 + t1) + (t2 + t3)) * __expf(-tpos * delta);
        const bf16 vb = (bf16)(pk2(v, 0.f) & 0xffffu);
        if (c < 512) { R[(size_t)c * (2 * L) + (L - p)] = vb; if (p == 0) R[(size_t)c * (2 * L)] = 0; }
        else if (p >= 1) R[(size_t)c5 * (2 * L) + (L + p)] = vb; }
    LDS_WAIT(); asm volatile("" ::: "memory");
}
DI void bg_convert(const Args& a, LAS unsigned char* lds, int set, int widx, int nw, int tid) {
    unsigned char* ws = a.ws; LAS float* T = (LAS float*)lds;
    constexpr int I2 = 16 * 12, I3 = 16 * 4, I4 = 16 * 22, I5 = 44 * 4;
    if (set == 0) { for (int r = widx; r < I4; r += nw) p0_transpose_tile<true>(a.in[I_WUP], 1024, 5632, 5632, (bf16*)(ws + WS_WUP), T, r, tid); }
    else if (set == 1) { for (int r = widx; r < I5; r += nw) p0_transpose_tile(a.in[I_WDOWN], 2816, 1024, 1024, (bf16*)(ws + WS_WDN), T, r, tid); }
    else if (set == 2) { for (int r = widx; r < I2 + I3; r += nw) {
            if (r < I2) p0_transpose_tile(a.in[I_WINC], 1024, 3072, 3072, (bf16*)(ws + WS_WC), T, r, tid);
            else p0_transpose_tile(a.in[I_WOUTC], 1024, 1024, 1024, (bf16*)(ws + WS_WOC), T, r - I2, tid); } }
    else { for (int r = widx; r < I4 + I5; r += nw) {
            if (r < I4) p0_transpose_tile<true>(a.in[I_WUP] + (size_t)1024 * 5632, 1024, 5632, 5632, (bf16*)(ws + WS_WUP) + (size_t)5632 * 1024, T, r, tid);
            else p0_transpose_tile(a.in[I_WDOWN] + (size_t)2816 * 1024, 2816, 1024, 1024, (bf16*)(ws + WS_WDN) + (size_t)1024 * 2816, T, r - I4, tid); } }
    __syncthreads();
}
DI void ph_prologue(const Args& a, LAS unsigned char* lds, int tid, int lane, int wave, int bid, int G) {
    unsigned char* ws = a.ws;
    constexpr int NF1 = 36, NA = 192, I0 = 16 * 9, IH = 16 * 6, I1 = 16 * 4, NT = I0 + IH + I1;
    LAS float* T = (LAS float*)lds;
#ifndef MK_P0A
#define MK_P0A 1
#define MK_P0T 1
#define MK_P0F 1
#endif
    for (int rep_ = 0; rep_ < (MK_P0A > MK_P0T ? (MK_P0A > MK_P0F ? MK_P0A : MK_P0F) : (MK_P0T > MK_P0F ? MK_P0T : MK_P0F)); ++rep_)
    for (int it0 = bid; it0 < NF1 + NA + NT; it0 += G) {
        if (it0 < NF1) { if (rep_ < MK_P0F) p0_filter_stage1(a, it0 < 32 ? 2048 : 256, it0 < 32 ? 64 * it0 : 64 * (it0 - 32), 64 * it0, (float*)(ws + WS_H2), T, tid, lane, wave); continue; }
        const int it = it0 - NF1;
        if (it < NA ? rep_ >= MK_P0A : rep_ >= MK_P0T) continue;
        if (it < NA) {
            const int l = it / 96, rem = it % 96, cb = rem >> 5, ks = rem & 31;
            __syncthreads();
            if (tid < 160) { const int v = tid >> 5, k = tid & 31; const float cv = v < 4 ? a.in[I_C][v * 1024 + ks * 32 + k] : a.in[I_CCTX][ks * 32 + k]; T[tid] = silu_f(cv); }
            __syncthreads();
            const int col = cb * 2048 + tid * 4; const float* w = a.in[I_WADA] + ((size_t)(l * 1024 + ks * 32)) * 6144 + col;
            f32x4 a0 = {0.f, 0.f, 0.f, 0.f}, a1 = a0, a2 = a0, a3 = a0, a4 = a0;
#pragma unroll
            for (int kb = 0; kb < 2; ++kb) { f32x4 wv[16];
#pragma unroll
                for (int k = 0; k < 16; ++k) wv[k] = *(const f32x4*)(w + (size_t)(16 * kb + k) * 6144);
#pragma unroll
                for (int k = 0; k < 16; ++k) { const int kk = 16 * kb + k; a0 += wv[k] * T[kk]; a1 += wv[k] * T[32 + kk]; a2 += wv[k] * T[64 + kk]; a3 += wv[k] * T[96 + kk]; a4 += wv[k] * T[128 + kk]; } }
            float* o = (float*)(ws + WS_MODP) + ((size_t)((ks * 2 + l) * 5)) * 6144 + col;
            *(f32x4*)o = a0; *(f32x4*)(o + 6144) = a1; *(f32x4*)(o + 2 * 6144) = a2; *(f32x4*)(o + 3 * 6144) = a3; *(f32x4*)(o + 4 * 6144) = a4;
            continue;
        }
        int r = it - NA;
        if (r < I0) { p0_transpose_tile(a.in[I_WINAB], 1024, 2064, 2304, (bf16*)(ws + WS_WAB), T, r, tid, 3600); continue; } r -= I0;
        if (r < IH) { p0_transpose_tile(a.in[I_WINAB] + 2064, 1024, 1536, 1536, (bf16*)(ws + WS_WHY), T, r, tid, 3600); continue; } r -= IH;
        p0_transpose_tile(a.in[I_WOUTAB], 1024, 1024, 1024, (bf16*)(ws + WS_WOAB), T, r, tid);
    }
    __syncthreads();
    { const int gt = bid * NTHR + tid, NGT = G * NTHR;
      for (int i = gt; i < 2 * 262144; i += NGT) { const int which = i >= 262144, j = which ? i - 262144 : i;
        const float* src = a.in[which ? I_CV : I_CK] + (size_t)j * 8; bf16* dst = (bf16*)(ws + (which ? WS_CV : WS_CK)) + (size_t)j * 8;
        const f32x4 x0 = *(const f32x4*)src, x1 = *(const f32x4*)(src + 4);
        u32x4 o; o.x = pk2(x0[0], x0[1]); o.y = pk2(x0[2], x0[3]); o.z = pk2(x1[0], x1[1]); o.w = pk2(x1[2], x1[3]); *(u32x4*)dst = o; } }
}
DI void ph_modf_norm0(const Args& a, LAS unsigned char* lds, int tid, int lane, int wave, int bid, int G) {
    const float* modP = (const float*)(a.ws + WS_MODP); float* modF = (float*)(a.ws + WS_MODF); const float* bada = a.in[I_BADA];
    for (int i = bid * NTHR + tid; i < 2 * 5 * 6144; i += G * NTHR) { const int l = i / 30720, rem = i % 30720, v = rem / 6144, col = rem % 6144;
        float s = bada[l * 6144 + col];
#pragma unroll 8
        for (int ks = 0; ks < 32; ++ks) s += modP[((size_t)((ks * 2 + l) * 5 + v)) * 6144 + col];
        modF[i] = s; }
    const int rpw = (M + G - 1) / G, r0 = rpw * bid, r1 = (r0 + rpw < M) ? r0 + rpw : M;
    LAS float* shs = (LAS float*)lds;
    for (int v = 0; v < 5; ++v) {
        const bool need = r0 < r1 && (v == 4 ? (r0 < MPR) : (r1 > MPR && ((r0 > MPR ? r0 : MPR) - MPR) >> 11 <= v && v <= ((r1 - 1 - MPR) >> 11)));
        if (!need) continue;
        { const int i = tid; const int ch = i >> 8, c4 = (i & 255) * 4;
            f32x4 s = *(const f32x4*)(bada + ch * 1024 + c4);
#pragma unroll 8
            for (int ks = 0; ks < 32; ++ks) s += *(const f32x4*)(modP + ((size_t)((ks * 2 + 0) * 5 + v)) * 6144 + ch * 1024 + c4);
            *(LAS f32x4*)(shs + (v * 2 + ch) * 1024 + c4) = s; }
    }
    const int NGW = G * NWAVES;
    for (int it = wave * G + bid; it < 2304; it += NGW) { const int pg = it >> 6, cb = it & 63;
        p1_filter_stage2(a, pg < 32 ? 2048 : 256, pg < 32 ? 64 * pg : 64 * (pg - 32), 64 * pg, cb, (const float*)(a.ws + WS_H2), (bf16*)(a.ws + (pg < 32 ? WS_R2048 : WS_R256)), (LAS float*)(lds + 65536 + wave * 4096), lane); }
    __syncthreads();
    { const float* xsB = a.in[I_XS] - (size_t)MPR * D; const float* gvec = a.in[I_GMIX]; bf16* hbuf = (bf16*)(a.ws + WS_H);
        for (int row = r0 + wave; row < r1; row += NWAVES) {
            const float* xr = (row < MPR ? a.in[I_XP] : xsB) + (size_t)row * D; const int slot = row_vec(row);
            f32x4 x[4]; float ss = 0.f;
#pragma unroll
            for (int j = 0; j < 4; ++j) { x[j] = *(const f32x4*)(xr + 4 * lane + 256 * j); ss += (x[j][0] * x[j][0] + x[j][1] * x[j][1]) + (x[j][2] * x[j][2] + x[j][3] * x[j][3]); }
            const float rstd = rsqrtf(wave_sum(ss) * (1.f / D) + EPS);
#pragma unroll
            for (int j = 0; j < 4; ++j) { const int col = 4 * lane + 256 * j; const f32x4 g = *(const f32x4*)(gvec + col), sh = *(const LAS f32x4*)(shs + (slot * 2 + 0) * 1024 + col), sc = *(const LAS f32x4*)(shs + (slot * 2 + 1) * 1024 + col);
                const f32x4 y = x[j] * rstd * g * (sc + 1.f) + sh; u32x2 o; o.x = pk2(y[0], y[1]); o.y = pk2(y[2], y[3]); *(u32x2*)(hbuf + (size_t)row * D + col) = o; }
        }
    }
}
DI void ph_norm(const float* xA, const float* xB, const bf16* delta, bf16* xb, const float* gvec, const float* mod5  , int chS, int chC, bf16* hbuf, int gw, int NGW, int lane) {
    for (int row0 = gw; row0 < M; row0 += 2 * NGW) {
        f32x4 x[2][4]; u32x2 dq[2][4];
#pragma unroll
        for (int r = 0; r < 2; ++r) { const int row = row0 + r * NGW; if (row < M) {
#pragma unroll
            for (int j = 0; j < 4; ++j) { const size_t o = (size_t)row * D + 4 * lane + 256 * j; dq[r][j] = *(const u32x2*)(delta + o);
                if (xA) x[r][j] = *(const f32x4*)((row < MPR ? xA : xB) + o);
                else { const u32x2 q = *(const u32x2*)(xb + o); x[r][j] = (f32x4){__uint_as_float(q.x << 16), __uint_as_float(q.x & 0xffff0000u), __uint_as_float(q.y << 16), __uint_as_float(q.y & 0xffff0000u)}; } } } }
#pragma unroll
        for (int r = 0; r < 2; ++r) { const int row = row0 + r * NGW; if (row < M) { const int v = row_vec(row);
            const float* shp = mod5 + (size_t)v * 6144 + chS * 1024; const float* scp = mod5 + (size_t)v * 6144 + chC * 1024; float ss = 0.f;
#pragma unroll
            for (int j = 0; j < 4; ++j) { x[r][j][0] += __uint_as_float(dq[r][j].x << 16); x[r][j][1] += __uint_as_float(dq[r][j].x & 0xffff0000u); x[r][j][2] += __uint_as_float(dq[r][j].y << 16); x[r][j][3] += __uint_as_float(dq[r][j].y & 0xffff0000u);
                u32x2 o; o.x = pk2(x[r][j][0], x[r][j][1]); o.y = pk2(x[r][j][2], x[r][j][3]); *(u32x2*)(xb + (size_t)row * D + 4 * lane + 256 * j) = o; }
#pragma unroll
            for (int j = 0; j < 4; ++j) ss += (x[r][j][0] * x[r][j][0] + x[r][j][1] * x[r][j][1]) + (x[r][j][2] * x[r][j][2] + x[r][j][3] * x[r][j][3]);
            const float rstd = rsqrtf(wave_sum(ss) * (1.f / D) + EPS);
#pragma unroll
            for (int j = 0; j < 4; ++j) { const int col = 4 * lane + 256 * j; const f32x4 g = *(const f32x4*)(gvec + col), sh = *(const f32x4*)(shp + col), sc = *(const f32x4*)(scp + col);
                const f32x4 y = x[r][j] * rstd * g * (sc + 1.f) + sh; u32x2 o; o.x = pk2(y[0], y[1]); o.y = pk2(y[2], y[3]); *(u32x2*)(hbuf + (size_t)row * D + col) = o; } } }
    }
}
DI void ph_final_norm(float* out, const bf16* xb, const bf16* delta, const float* gvec, int gw, int NGW, int lane) {
    for (int row0 = gw; row0 < M; row0 += 2 * NGW) {
        f32x4 x[2][4];
#pragma unroll
        for (int r = 0; r < 2; ++r) { const int row = row0 + r * NGW; if (row < M) {
#pragma unroll
            for (int j = 0; j < 4; ++j) { const size_t o = (size_t)row * D + 4 * lane + 256 * j; const u32x2 q = *(const u32x2*)(xb + o), dq = *(const u32x2*)(delta + o);
                x[r][j] = (f32x4){__uint_as_float(q.x << 16) + __uint_as_float(dq.x << 16), __uint_as_float(q.x & 0xffff0000u) + __uint_as_float(dq.x & 0xffff0000u),
                                  __uint_as_float(q.y << 16) + __uint_as_float(dq.y << 16), __uint_as_float(q.y & 0xffff0000u) + __uint_as_float(dq.y & 0xffff0000u)}; } } }
#pragma unroll
        for (int r = 0; r < 2; ++r) { const int row = row0 + r * NGW; if (row < M) { float ss = 0.f;
#pragma unroll
            for (int j = 0; j < 4; ++j) ss += (x[r][j][0] * x[r][j][0] + x[r][j][1] * x[r][j][1]) + (x[r][j][2] * x[r][j][2] + x[r][j][3] * x[r][j][3]);
            const float rstd = rsqrtf(wave_sum(ss) * (1.f / D) + EPS);
#pragma unroll
            for (int j = 0; j < 4; ++j) { const int col = 4 * lane + 256 * j; const f32x4 g = *(const f32x4*)(gvec + col); *(f32x4*)(out + (size_t)row * D + col) = x[r][j] * rstd * g; } } }
    }
}
DI void ph_e1(const Args& a, LAS unsigned char* lds, int tid, int gw, int NGW, int lane, int wave, int bid, int G) {
    unsigned char* ws = a.ws;
    { const float* qkb = (const float*)(ws + WS_QKBND); bf16* QB = (bf16*)(ws + WS_QB); const float* w = a.in[I_WCQK];
      for (int i = bid * NTHR + tid; i < 96 * 1024; i += G * NTHR) { const int c = i & 1023, rr = i >> 10, pm = rr >> 1, which = rr & 1, row = pm * 256 + (which ? 255 : 0);
        int sbase, L; row_seq(row, sbase, L);
        float prev, cur, next;
        if (which == 0) { cur = qkb[(size_t)(pm * 4 + 0) * 1024 + c]; next = qkb[(size_t)(pm * 4 + 1) * 1024 + c]; prev = row > sbase ? qkb[(size_t)((pm - 1) * 4 + 3) * 1024 + c] : 0.f; }
        else { cur = qkb[(size_t)(pm * 4 + 3) * 1024 + c]; prev = qkb[(size_t)(pm * 4 + 2) * 1024 + c]; next = row < sbase + L - 1 ? qkb[(size_t)((pm + 1) * 4 + 0) * 1024 + c] : 0.f; }
        const float v = silu_f(w[c] * prev + w[1024 + c] * cur + w[2048 + c] * next) * (c >= 512 ? 0.08838834764831845f : 1.0f);
        QB[(size_t)(c >> 9) * ((size_t)M * 512) + (size_t)row * 512 + (c & 511)] = (bf16)(pk2(v, 0.f) & 0xffffu); } }
    bg_convert(a, lds, 0, bid, G, tid);
    const float* gates = (const float*)(ws + WS_GATES); const float* bg = a.in[I_BGATES];
    float* aS = (float*)(ws + WS_AS); float* MSv = (float*)(ws + WS_MS); float* bS = (float*)(ws + WS_BS);
    for (int it = wave * G + bid; it < 160; it += NGW) {
        const int seq = it >> 3, h = (it >> 1) & 3, dir = it & 1;
        const int L = seq < 16 ? 256 : 2048, base = seq < 16 ? seq * 256 : MPR + (seq - 16) * 2048, per = L / 64;
        const float m0 = seq < 16 ? 0.f : a.in[I_STM][((seq - 16) * 2 + dir) * 4 + h];
        const int gi = dir * 8 + h, gf = dir * 8 + 4 + h; const float bi = bg[gi], bf_ = bg[gf];
        float lf[32], iv[32];
#pragma unroll
        for (int k = 0; k < 32; ++k) if (k < per) { const int p = 64 * k + lane, t = dir ? L - 1 - p : p; const size_t gr = (size_t)(base + t) * 16; lf[k] = gates[gr + gf]; iv[k] = gates[gr + gi]; }
        float cb_ = 0.f, cM = m0;
#pragma unroll
        for (int k = 0; k < 32; ++k) if (k < per) {
            float x = logsig_f(lf[k] + bf_);
#pragma unroll
            for (int o = 1; o < 64; o <<= 1) { const float n = __shfl_up(x, o); if (lane >= o) x += n; }
            const float b = cb_ + x, av = (iv[k] + bi) - b;
            float y = av;
#pragma unroll
            for (int o = 1; o < 64; o <<= 1) { const float n = __shfl_up(y, o); if (lane >= o) y = fmaxf(y, n); }
            const float Mv = fmaxf(cM, y);
            const int p = 64 * k + lane, t = dir ? L - 1 - p : p; const size_t o_ = (size_t)(base + t) * 8 + dir * 4 + h;
            aS[o_] = av; MSv[o_] = Mv; bS[o_] = b;
            cb_ = __shfl(b, 63); cM = __shfl(Mv, 63); }
    }
}
DI void ffn_fix_panel(const Args& a, int layer, int pm, int tid) {
    const float* abnd = (const float*)(a.ws + WS_ABND); const float* gbnd = (const float*)(a.ws + WS_GBND); bf16* act = (bf16*)(a.ws + WS_FG); const float* w = a.in[I_WCFFN] + (size_t)layer * 3 * FF;
    for (int i = tid; i < 2 * FF; i += NTHR) { const int c = i % FF, which = i / FF, row = pm * 256 + (which ? 255 : 0);
        int sbase, L; row_seq(row, sbase, L);
        float prev, cur, next;
        if (which == 0) { cur = abnd[(size_t)(pm * 4 + 0) * FF + c]; next = abnd[(size_t)(pm * 4 + 1) * FF + c]; prev = row > sbase ? abnd[(size_t)((pm - 1) * 4 + 3) * FF + c] : 0.f; }
        else { cur = abnd[(size_t)(pm * 4 + 3) * FF + c]; prev = abnd[(size_t)(pm * 4 + 2) * FF + c]; next = row < sbase + L - 1 ? abnd[(size_t)((pm + 1) * 4 + 0) * FF + c] : 0.f; }
        const float v = w[c] * prev + w[FF + c] * cur + w[2 * FF + c] * next;
        act[(size_t)row * FF + c] = (bf16)(pk2(gelu_tanh_f(v) * gbnd[(size_t)(pm * 2 + which) * FF + c], 0.f) & 0xffffu); }
    asm volatile("s_waitcnt vmcnt(0)" ::: "memory");
    __syncthreads();
}
template <int DK> DI void stage_k_rows(LAS bf16* Kst, const bf16* src, size_t ld, int tid) {
    constexpr int CPR = DK / 8;
#pragma unroll
    for (int c = tid; c < 64 * CPR; c += NTHR) { const int key = c / CPR, ch = c % CPR;
        const u32x4 v = *(const u32x4*)(src + (size_t)key * ld + ch * 8); *(LAS u32x4*)(Kst + key * (DK + 8) + ch * 8) = v; }
}
template <int DV> DI void stage_v_transposed(LAS bf16* Vst, const bf16* src, size_t ld, int tid) {
    constexpr int NCH = DV / 8;
#pragma unroll
    for (int c = tid; c < 64 * NCH; c += NTHR) { const int key = c & 63, ch = c >> 6;
        const u32x4 v = *(const u32x4*)(src + (size_t)key * ld + ch * 8); LAS bf16* d = Vst + (ch * 8) * 72 + key;
        d[0] = (bf16)(v.x & 0xffffu); d[72] = (bf16)(v.x >> 16); d[144] = (bf16)(v.y & 0xffffu); d[216] = (bf16)(v.y >> 16);
        d[288] = (bf16)(v.z & 0xffffu); d[360] = (bf16)(v.z >> 16); d[432] = (bf16)(v.w & 0xffffu); d[504] = (bf16)(v.w >> 16); }
}
DI bf16x8 pack_frag(const f32x16& x, int s) {
    u32x4 p; p.x = pk2(x[8 * s], x[8 * s + 1]); p.y = pk2(x[8 * s + 2], x[8 * s + 3]); p.z = pk2(x[8 * s + 4], x[8 * s + 5]); p.w = pk2(x[8 * s + 6], x[8 * s + 7]);
    return __builtin_bit_cast(bf16x8, p); }
DI bf16x8 ld_vfrag(const LAS bf16* Vst, int e, int s) {
    const u32x2 lo = *(const LAS u32x2*)(Vst + e * 72 + s), hi = *(const LAS u32x2*)(Vst + e * 72 + s + 8);
    u32x4 r; r.x = lo.x; r.y = lo.y; r.z = hi.x; r.w = hi.y; return __builtin_bit_cast(bf16x8, r); }

DI void mlstm_unit(const Args& a, LAS unsigned char* lds, int seq, int h, int qt, int tid, int lane, int wave) {
    unsigned char* ws = a.ws;
    const bf16* QB = (const bf16*)(ws + WS_QB); const bf16* KB = (const bf16*)(ws + WS_KB); const bf16* VO = (const bf16*)(ws + WS_VO);
    const float* aS = (const float*)(ws + WS_AS); const float* MSv = (const float*)(ws + WS_MS); const float* bS = (const float*)(ws + WS_BS);
    float* hscr = a.out + OFF_K;
    bf16* ycat = (bf16*)(ws + WS_H);
    const bool isS = seq >= 16; const int L = isS ? 2048 : 256, base = isS ? MPR + (seq - 16) * 2048 : seq * 256, bs = seq - 16;
    LAS bf16* Kst = (LAS bf16*)lds;
    LAS bf16* Vst = (LAS bf16*)(lds + 17408);
    LAS bf16* C0t = (LAS bf16*)lds;
    LAS float* aT = (LAS float*)(lds + 35840);
    LAS float* n0s = (LAS float*)(lds + 36864);
    LAS bf16* Qw = (LAS bf16*)(lds + 37888 + wave * 8704);
    const bf16* GS = (const bf16*)(a.out + OFF_K + (size_t)M * 512);
    const float* NS = (const float*)(ws + WS_NS);
    asm volatile("" : "+v"(lane), "+v"(tid));
    const int lt = lane & 31, hh = lane >> 5, q0 = qt * 256 + 32 * wave, trow = base + q0 + lt;
    { u32x4 qv[8];
#pragma unroll
      for (int i = 0; i < 8; ++i) qv[i] = *(const u32x4*)(QB + (size_t)trow * 512 + h * 128 + 16 * i + 8 * hh);
#pragma unroll
      for (int i = 0; i < 8; ++i) *(LAS u32x4*)(Qw + lt * 136 + 16 * i + 8 * hh) = qv[i]; }
    LDS_WAIT(); asm volatile("" ::: "memory");
#define QF(i) (*(const LAS bf16x8*)(Qw + lt * 136 + 16 * (i) + 8 * hh))
    f32x16 O[4];
#pragma unroll 1
    for (int dir = 0; dir < 2; ++dir) {
#pragma unroll
        for (int eb = 0; eb < 4; ++eb)
#pragma unroll
            for (int r = 0; r < 16; ++r) O[eb][r] = 0.f;
        float den = 0.f;
        const float Mt = MSv[(size_t)trow * 8 + dir * 4 + h], bt = bS[(size_t)trow * 8 + dir * 4 + h];
        if (isS) {
            __syncthreads();
            const int sidx = (bs * 2 + dir) * 4 + h;
            const float m0 = a.in[I_STM][sidx];
            float cf[8]; float Mref = m0;
#pragma unroll
            for (int i = 0; i < 8; ++i) cf[i] = MSv[(size_t)(base + 256 * i + (dir ? 0 : 255)) * 8 + dir * 4 + h];
            if (dir == 0) { if (qt > 0) Mref = cf[0];
#pragma unroll
                for (int i = 1; i < 8; ++i) if (i < qt) Mref = cf[i]; }
            else { if (qt < 7) Mref = cf[7];
#pragma unroll
                for (int i = 6; i >= 0; --i) if (i > qt) Mref = cf[i]; }
            const float c0f = __expf(m0 - Mref);
#pragma unroll
            for (int i = 0; i < 8; ++i) { const bool inc = dir ? (i > qt) : (i < qt); cf[i] = inc ? __expf(cf[i] - Mref) : 0.f; }
            const float* C0 = a.in[I_STC] + (size_t)sidx * 16384; const bf16* Gb = GS + (size_t)sidx * 8 * 16384;
            for (int c = tid; c < 2048; c += NTHR) { const int d = c >> 4, e8 = (c & 15) * 8;
                const f32x4 c0a = *(const f32x4*)(C0 + d * 128 + e8), c0b = *(const f32x4*)(C0 + d * 128 + e8 + 4);
                u32x4 gq[8];
#pragma unroll
                for (int i = 0; i < 8; ++i) gq[i] = *(const u32x4*)(Gb + (size_t)i * 16384 + d * 128 + e8);
                float v[8];
#pragma unroll
                for (int j = 0; j < 4; ++j) { v[j] = c0a[j] * c0f; v[4 + j] = c0b[j] * c0f; }
#pragma unroll
                for (int i = 0; i < 8; ++i) { float g[8]; unpack8(gq[i], g);
#pragma unroll
                    for (int j = 0; j < 8; ++j) v[j] += cf[i] * g[j]; }
                const u32x4 pk = pack8(v);
                C0t[(e8 + 0) * 136 + d] = (bf16)(pk.x & 0xffffu); C0t[(e8 + 1) * 136 + d] = (bf16)(pk.x >> 16); C0t[(e8 + 2) * 136 + d] = (bf16)(pk.y & 0xffffu); C0t[(e8 + 3) * 136 + d] = (bf16)(pk.y >> 16);
                C0t[(e8 + 4) * 136 + d] = (bf16)(pk.z & 0xffffu); C0t[(e8 + 5) * 136 + d] = (bf16)(pk.z >> 16); C0t[(e8 + 6) * 136 + d] = (bf16)(pk.w & 0xffffu); C0t[(e8 + 7) * 136 + d] = (bf16)(pk.w >> 16); }
            if (tid < 128) { float nsv[8];
#pragma unroll
                for (int i = 0; i < 8; ++i) nsv[i] = NS[((size_t)sidx * 8 + i) * 128 + tid];
                float nv = a.in[I_STN][sidx * 128 + tid] * c0f;
#pragma unroll
                for (int i = 0; i < 8; ++i) nv += cf[i] * nsv[i];
                n0s[tid] = nv; }
            __syncthreads();
            const float sc = __expf(Mref - Mt);
            float dq = 0.f;
#pragma unroll
            for (int i = 0; i < 8; ++i) { float q[8]; const u32x4 qq = __builtin_bit_cast(u32x4, QF(i));
                unpack8(qq, q);
#pragma unroll
                for (int j = 0; j < 8; ++j) { dq += q[j] * n0s[16 * i + 8 * hh + j]; q[j] *= sc; }
                const bf16x8 Qs = __builtin_bit_cast(bf16x8, pack8(q));
#pragma unroll
                for (int eb = 0; eb < 4; ++eb) { const bf16x8 cf = *(const LAS bf16x8*)(C0t + (32 * eb + lt) * 136 + 16 * i + 8 * hh); O[eb] = MFMA32(cf, Qs, O[eb]); }
                asm volatile("" ::: "memory"); }
            den += sc * dq;
        }
        const int kt_lo = 4 * qt, kt_hi = 4 * qt + 3;
        u32x4 kreg[2], vreg[2]; float areg = 0.f;
#define ML_LOAD(kt_) do { const int kr0_ = base + 64 * (kt_); _Pragma("unroll") for (int i_ = 0; i_ < 2; ++i_) { const int c_ = tid + NTHR * i_; \
            kreg[i_] = *(const u32x4*)(KB + (size_t)(kr0_ + (c_ >> 4)) * 512 + h * 128 + (c_ & 15) * 8); \
            vreg[i_] = *(const u32x4*)(VO + (size_t)(kr0_ + (c_ & 63)) * 1024 + h * 128 + (c_ >> 6) * 8); } \
            if (tid < 64) areg = aS[(size_t)(kr0_ + tid) * 8 + dir * 4 + h]; } while (0)
        ML_LOAD(kt_lo);
#pragma unroll 1
        for (int kt = kt_lo; kt <= kt_hi; ++kt) {
            __syncthreads();
#pragma unroll
            for (int i_ = 0; i_ < 2; ++i_) { const int c_ = tid + NTHR * i_;
                *(LAS u32x4*)(Kst + (c_ >> 4) * 136 + (c_ & 15) * 8) = kreg[i_];
                LAS bf16* d = Vst + ((c_ >> 6) * 8) * 72 + (c_ & 63); const u32x4 v = vreg[i_];
                d[0] = (bf16)(v.x & 0xffffu); d[72] = (bf16)(v.x >> 16); d[144] = (bf16)(v.y & 0xffffu); d[216] = (bf16)(v.y >> 16);
                d[288] = (bf16)(v.z & 0xffffu); d[360] = (bf16)(v.z >> 16); d[432] = (bf16)(v.w & 0xffffu); d[504] = (bf16)(v.w >> 16); }
            if (tid < 64) aT[tid] = areg;
            if (kt < kt_hi) ML_LOAD(kt + 1);
            __syncthreads();
#pragma unroll 1
            for (int sub = 0; sub < 2; ++sub) {
                const int s0 = 64 * kt + 32 * sub;
                const bool skip = dir ? (s0 + 31 < q0) : (s0 > q0 + 31);
                if (!skip) {
                    f32x16 S;
#pragma unroll
                    for (int r = 0; r < 16; ++r) S[r] = 0.f;
#pragma unroll
                    for (int i = 0; i < 8; ++i) { const bf16x8 kf = *(const LAS bf16x8*)(Kst + (32 * sub + lt) * 136 + 16 * i + 8 * hh); S = MFMA32(kf, QF(i), S); }
                    const bool diag = (s0 == q0);
                    const int vlo = (diag && dir) ? lt : 0, vhi = (diag && !dir) ? lt : 31;
#pragma unroll
                    for (int r = 0; r < 16; ++r) { const int sl = (r & 3) + 8 * (r >> 2) + 4 * hh; const float av = aT[32 * sub + sl];
                        float wgt = __expf(av - Mt);
                        wgt = (sl >= vlo && sl <= vhi) ? wgt : 0.f;
                        const float p = S[r] * wgt; den += p; S[r] = p; }
                    const bf16x8 P0 = pack_frag(S, 0), P1 = pack_frag(S, 1);
#pragma unroll
                    for (int eb = 0; eb < 4; ++eb) {
                        O[eb] = MFMA32(ld_vfrag(Vst, 32 * eb + lt, 32 * sub + 4 * hh), P0, O[eb]);
                        O[eb] = MFMA32(ld_vfrag(Vst, 32 * eb + lt, 32 * sub + 16 + 4 * hh), P1, O[eb]); }
                }
            }
        }
#undef ML_LOAD
        const float dent = den + __shfl_xor(den, 32);
        const float inv = 1.f / fmaxf(fabsf(dent), __expf(-(bt + Mt)));
        int trow2 = trow; asm volatile("" : "+v"(trow2));
        float* hp = hscr + (size_t)trow2 * 512 + h * 128 + 4 * hh;
        if (dir == 0) {
#pragma unroll
            for (int eb = 0; eb < 4; ++eb)
#pragma unroll
                for (int g = 0; g < 4; ++g) { f32x4 v; v[0] = O[eb][4 * g] * inv; v[1] = O[eb][4 * g + 1] * inv; v[2] = O[eb][4 * g + 2] * inv; v[3] = O[eb][4 * g + 3] * inv;
                    *(f32x4*)(hp + 32 * eb + 8 * g) = v; }
        } else {
            float ss = 0.f;
#pragma unroll
            for (int eb = 0; eb < 4; ++eb)
#pragma unroll
                for (int g = 0; g < 4; ++g) { const f32x4 v = *(const f32x4*)(hp + 32 * eb + 8 * g);
#pragma unroll
                    for (int j = 0; j < 4; ++j) { const float x = __builtin_fmaf(O[eb][4 * g + j], inv, v[j]); O[eb][4 * g + j] = x; ss = __builtin_fmaf(x, x, ss); }
                    asm volatile("" ::: "memory"); }
            ss += __shfl_xor(ss, 32);
            const float rs = rsqrtf(ss * (1.f / 128.f) + EPS);
            const float* gh = a.in[I_GMLSTM] + h * 128 + 4 * hh; const bf16* op = VO + (size_t)trow2 * 1024 + 512 + h * 128 + 4 * hh; bf16* yp = ycat + (size_t)trow2 * 1024 + h * 128 + 4 * hh;
#pragma unroll
            for (int eb = 0; eb < 4; ++eb)
#pragma unroll
                for (int g = 0; g < 4; ++g) { const int e = 32 * eb + 8 * g; const u32x2 ov = *(const u32x2*)(op + e); const f32x4 gv = *(const f32x4*)(gh + e);
                    const float o0 = __uint_as_float(ov.x << 16), o1 = __uint_as_float(ov.x & 0xffff0000u), o2 = __uint_as_float(ov.y << 16), o3 = __uint_as_float(ov.y & 0xffff0000u);
                    u32x2 w; w.x = pk2(O[eb][4 * g] * rs * gv[0] * sigm_f(o0), O[eb][4 * g + 1] * rs * gv[1] * sigm_f(o1));
                    w.y = pk2(O[eb][4 * g + 2] * rs * gv[2] * sigm_f(o2), O[eb][4 * g + 3] * rs * gv[3] * sigm_f(o3)); *(u32x2*)(yp + e) = w;
                    if (g == 3) asm volatile("" ::: "memory"); }
        }
    }
    __syncthreads();
#undef QF
}
DI void mlstm_state_unit(const Args& a, LAS unsigned char* lds, int seq, int h, int dir, int blk, int tid, int lane, int wave) {
    unsigned char* ws = a.ws;
    const bf16* KB = (const bf16*)(ws + WS_KB); const bf16* VO = (const bf16*)(ws + WS_VO);
    const float* aS = (const float*)(ws + WS_AS); const float* MSv = (const float*)(ws + WS_MS); const float* bS = (const float*)(ws + WS_BS);
    asm volatile("" : "+v"(lane), "+v"(tid));
    const bool isS = seq >= 16; const int base = (isS ? MPR + (seq - 16) * 2048 : seq * 256) + 256 * blk, lastrow = base + (dir ? 0 : 255);
    const float ML = MSv[(size_t)lastrow * 8 + dir * 4 + h], bL = bS[(size_t)lastrow * 8 + dir * 4 + h];
    LAS bf16* Kt = (LAS bf16*)lds;
    LAS bf16* Vst = (LAS bf16*)(lds + 18432);
    const int lt = lane & 31, hh = lane >> 5, db = wave >> 1, eb0 = 2 * (wave & 1);
    f32x16 C[2];
#pragma unroll
    for (int j = 0; j < 2; ++j)
#pragma unroll
        for (int r = 0; r < 16; ++r) C[j][r] = 0.f;
    float nacc = 0.f;
    u32x4 kreg[2], vreg[2]; float wreg[2];
#define ST_LOAD(kt_) do { const int kr0_ = base + 64 * (kt_); _Pragma("unroll") for (int i_ = 0; i_ < 2; ++i_) { const int c_ = tid + NTHR * i_, key_ = c_ & 63, ch_ = c_ >> 6; \
        kreg[i_] = *(const u32x4*)(KB + (size_t)(kr0_ + key_) * 512 + h * 128 + ch_ * 8); vreg[i_] = *(const u32x4*)(VO + (size_t)(kr0_ + key_) * 1024 + h * 128 + ch_ * 8); \
        wreg[i_] = aS[(size_t)(kr0_ + key_) * 8 + dir * 4 + h]; } } while (0)
    ST_LOAD(0);
#pragma unroll 1
    for (int kt = 0; kt < 4; ++kt) {
        __syncthreads();
#pragma unroll
        for (int i_ = 0; i_ < 2; ++i_) { const int c_ = tid + NTHR * i_, key = c_ & 63, ch = c_ >> 6; float k[8]; unpack8(kreg[i_], k);
            const float w = __expf(wreg[i_] - ML);
#pragma unroll
            for (int j = 0; j < 8; j += 2) { const unsigned p = pk2(k[j] * w, k[j + 1] * w); Kt[(ch * 8 + j) * 72 + key] = (bf16)(p & 0xffffu); Kt[(ch * 8 + j + 1) * 72 + key] = (bf16)(p >> 16); }
            LAS bf16* d = Vst + (ch * 8) * 72 + key; const u32x4 v = vreg[i_];
            d[0] = (bf16)(v.x & 0xffffu); d[72] = (bf16)(v.x >> 16); d[144] = (bf16)(v.y & 0xffffu); d[216] = (bf16)(v.y >> 16);
            d[288] = (bf16)(v.z & 0xffffu); d[360] = (bf16)(v.z >> 16); d[432] = (bf16)(v.w & 0xffffu); d[504] = (bf16)(v.w >> 16); }
        if (kt < 3) ST_LOAD(kt + 1);
        __syncthreads();
#pragma unroll
        for (int i = 0; i < 4; ++i) { const bf16x8 kf = *(const LAS bf16x8*)(Kt + (32 * db + lt) * 72 + 16 * i + 8 * hh);
#pragma unroll
            for (int j = 0; j < 2; ++j) { const bf16x8 vf = *(const LAS bf16x8*)(Vst + (32 * (eb0 + j) + lt) * 72 + 16 * i + 8 * hh); C[j] = MFMA32(kf, vf, C[j]); } }
        if (tid < 128) { float s = 0.f;
#pragma unroll 8
            for (int k = 0; k < 64; ++k) s += bf2f(Kt[tid * 72 + k]);
            nacc += s; }
    }
#undef ST_LOAD
    if (!isS) {
        float* oc = a.out + OFF_C + ((size_t)((seq * 2 + dir) * 4 + h)) * 16384;
#pragma unroll
        for (int j = 0; j < 2; ++j)
#pragma unroll
            for (int r = 0; r < 16; ++r) { const int d = 32 * db + (r & 3) + 8 * (r >> 2) + 4 * hh, e = 32 * (eb0 + j) + lt; oc[d * 128 + e] = C[j][r]; }
        if (tid < 128) a.out[OFF_N + ((size_t)((seq * 2 + dir) * 4 + h)) * 128 + tid] = nacc;
        if (tid == 0) a.out[OFF_MM + (seq * 2 + dir) * 4 + h] = bL + ML;
    } else {
        const size_t u = ((size_t)(((seq - 16) * 2 + dir) * 4 + h)) * 8 + blk;
        bf16* og = (bf16*)(a.out + OFF_K + (size_t)M * 512) + u * 16384;
#pragma unroll
        for (int j = 0; j < 2; ++j)
#pragma unroll
            for (int r = 0; r < 16; ++r) { const int d = 32 * db + (r & 3) + 8 * (r >> 2) + 4 * hh, e = 32 * (eb0 + j) + lt; og[d * 128 + e] = (bf16)(pk2(C[j][r], 0.f) & 0xffffu); }
        if (tid < 128) ((float*)(ws + WS_NS))[u * 128 + tid] = nacc;
    }
    __syncthreads();
}
constexpr int HY_CP = 8224;
constexpr int HY_UB = 65792, HY_XB = 90624;
DI u32x4 ld16_or0(const bf16* p, bool ok) { u32x4 z = {0u, 0u, 0u, 0u}; return ok ? *(const u32x4*)p : z; }
DI void hy_build_copies(LAS unsigned char* lds, const bf16* R, int RL, int tid) {
    const int nch = RL / 8;
    for (int mch = tid; mch <= nch; mch += NTHR) {
        u32x4 lo = *(const u32x4*)(R + 8 * (mch >= 1 ? mch - 1 : 0)), hi = *(const u32x4*)(R + 8 * (mch < nch ? mch : nch - 1));
        if (mch < 1) lo = (u32x4){0u, 0u, 0u, 0u}; if (mch >= nch) hi = (u32x4){0u, 0u, 0u, 0u};
        const unsigned W[8] = {lo.x, lo.y, lo.z, lo.w, hi.x, hi.y, hi.z, hi.w};
#pragma unroll
        for (int sg = 0; sg < 8; ++sg) { u32x4 o;
            if ((sg & 1) == 0) { o.x = W[sg / 2]; o.y = W[sg / 2 + 1]; o.z = W[sg / 2 + 2]; o.w = W[sg / 2 + 3]; }
            else { const int q = (sg - 1) / 2; o.x = __builtin_amdgcn_alignbit(W[q + 1], W[q], 16); o.y = __builtin_amdgcn_alignbit(W[q + 2], W[q + 1], 16);
                   o.z = __builtin_amdgcn_alignbit(W[q + 3], W[q + 2], 16); o.w = __builtin_amdgcn_alignbit(W[q + 4], W[q + 3], 16); }
            *(LAS u32x4*)(lds + sg * HY_CP + 16 * mch) = o; }
    }
}
DI f32x16 hy_mfma_loop(LAS unsigned char* lds, unsigned abase, unsigned bbase, int dlo, int dhi) {
    f32x16 acc;
#pragma unroll
    for (int r = 0; r < 16; ++r) acc[r] = 0.f;
#pragma unroll 2
    for (int dl = dlo; dl <= dhi; ++dl) { const int off = -64 * dl;
        const bf16x8 a0 = *(const LAS bf16x8*)(lds + abase + off), b0 = *(const LAS bf16x8*)(lds + bbase + off);
        const bf16x8 a1 = *(const LAS bf16x8*)(lds + abase + off + 32), b1 = *(const LAS bf16x8*)(lds + bbase + off + 32);
        acc = MFMA32(a0, b0, acc); acc = MFMA32(a1, b1, acc); }
    return acc;
}
DI void hyena_channel(const Args& a, LAS unsigned char* lds, int c, int tid, int lane, int wave) {
    unsigned char* ws = a.ws;
    const bf16* HV = (const bf16*)(ws + WS_HYT) + (size_t)c * M; const bf16* H1 = HV + (size_t)512 * M; const bf16* H2 = HV + (size_t)1024 * M;
    const float* wch = a.in[I_WCHY] + c;
    const float wv0 = wch[0], wv1 = wch[1536], wv2 = wch[3072], w10 = wch[512], w11 = wch[512 + 1536], w12 = wch[512 + 3072], w20 = wch[1024], w21 = wch[1024 + 1536], w22 = wch[1024 + 3072];
#define HY_CONV8(g_, sb_, L_, uo_, xo_) do { const bool hp_ = (g_) > (sb_), hn_ = (g_) + 8 < (sb_) + (L_); float o_u[8], o_x[8]; \
        _Pragma("unroll") for (int tn_ = 0; tn_ < 3; ++tn_) { const bf16* p_ = tn_ == 0 ? HV : (tn_ == 1 ? H1 : H2); const float k0_ = tn_ == 0 ? wv0 : (tn_ == 1 ? w10 : w20), k1_ = tn_ == 0 ? wv1 : (tn_ == 1 ? w11 : w21), k2_ = tn_ == 0 ? wv2 : (tn_ == 1 ? w12 : w22); \
            float x_[8]; unpack8(*(const u32x4*)(p_ + (g_)), x_); const float xm_ = bf2f(p_[hp_ ? (g_) - 1 : (g_)]) * (hp_ ? 1.f : 0.f), xp_ = bf2f(p_[hn_ ? (g_) + 8 : (g_)]) * (hn_ ? 1.f : 0.f); \
            _Pragma("unroll") for (int j_ = 0; j_ < 8; ++j_) { const float r_ = k0_ * (j_ ? x_[j_ ? j_ - 1 : 0] : xm_) + k1_ * x_[j_] + k2_ * (j_ < 7 ? x_[j_ < 7 ? j_ + 1 : 7] : xp_); \
                if (tn_ == 0) o_u[j_] = r_; else if (tn_ == 1) o_u[j_] *= r_; else o_x[j_] = r_; } } \
        uo_ = pack8(o_u); xo_ = pack8(o_x); } while (0)
    bf16* ycat = (bf16*)(ws + WS_H) + 512 + c; const float hb = a.in[I_HYB][c];
    const int lt = lane & 31, hh = lane >> 5, sg = (8 - (lt & 7)) & 7, i8 = (lt + 7) & ~7;
    LAS bf16* Ub = (LAS bf16*)(lds + HY_UB); LAS bf16* Xb = (LAS bf16*)(lds + HY_XB);
    __syncthreads();
    for (int i = tid; i < 4 * 65; i += NTHR) { const int b = i / 65, k = i % 65; *(LAS u32x4*)(Ub + b * 2568 + (k < 32 ? 8 * k : 2304 + 8 * (k - 32))) = (u32x4){0u, 0u, 0u, 0u}; }
    hy_build_copies(lds, (const bf16*)(ws + WS_R2048) + (size_t)c * 4096, 4096, tid);
#pragma unroll 1
    for (int it = 0; it < 2; ++it) { const int i = tid + NTHR * it, b = i >> 8, mch = i & 255; const int sb = MPR + b * 2048, g = sb + 8 * mch; u32x4 uo, xo; HY_CONV8(g, sb, 2048, uo, xo);
        *(LAS u32x4*)(Ub + b * 2568 + 256 + 8 * mch) = uo; *(LAS u32x4*)(Xb + b * 2568 + 256 + 8 * mch) = xo; }
    __syncthreads();
    { const int bq = lt & 3, Ib = 8 * wave + (lt >> 2);
      const unsigned abase = sg * HY_CP + 2 * (2048 + 8 + 8 * hh - i8), bbase = HY_UB + 2 * (bq * 2568 + 256 + 32 * Ib + 8 * hh);
      const f32x16 acc = hy_mfma_loop(lds, abase, bbase, 8 * wave - 63, 8 * wave + 7);
#pragma unroll
      for (int r = 0; r < 16; ++r) { int t = 32 * Ib + (r & 3) + 8 * (r >> 2) + 4 * hh; asm volatile("" : "+v"(t));
          const float u = bf2f(Ub[bq * 2568 + 256 + t]), x2 = bf2f(Xb[bq * 2568 + 256 + t]);
          const float y = x2 * (acc[r] + hb * u); ycat[(size_t)(MPR + bq * 2048 + t) * 1024] = (bf16)(pk2(y, 0.f) & 0xffffu); } }
    __syncthreads();
    for (int i = tid; i < 16 * 65; i += NTHR) { const int sq = i / 65, k = i % 65; *(LAS u32x4*)(Ub + sq * 776 + (k < 32 ? 8 * k : 512 + 8 * (k - 32))) = (u32x4){0u, 0u, 0u, 0u}; }
    hy_build_copies(lds, (const bf16*)(ws + WS_R256) + (size_t)c * 512, 512, tid);
    { const int sq = tid >> 5, mch = tid & 31; const int sb = sq * 256, g = sb + 8 * mch; u32x4 uo, xo; HY_CONV8(g, sb, 256, uo, xo);
      *(LAS u32x4*)(Ub + sq * 776 + 256 + 8 * mch) = uo; *(LAS u32x4*)(Xb + sq * 776 + 256 + 8 * mch) = xo; }
#undef HY_CONV8
    __syncthreads();
    if (wave < 4) { const int bq = 4 * wave + (lt & 3), Ib = lt >> 2;
      const unsigned abase = sg * HY_CP + 2 * (256 + 8 + 8 * hh - i8), bbase = HY_UB + 2 * (bq * 776 + 256 + 32 * Ib + 8 * hh);
      const f32x16 acc = hy_mfma_loop(lds, abase, bbase, -7, 7);
#pragma unroll
      for (int r = 0; r < 16; ++r) { int t = 32 * Ib + (r & 3) + 8 * (r >> 2) + 4 * hh; asm volatile("" : "+v"(t));
          const float u = bf2f(Ub[bq * 776 + 256 + t]), x2 = bf2f(Xb[bq * 776 + 256 + t]);
          const float y = x2 * (acc[r] + hb * u); ycat[(size_t)(bq * 256 + t) * 1024] = (bf16)(pk2(y, 0.f) & 0xffffu); } }
    __syncthreads();
}
#ifndef MK_MB_S
#define MK_MB_S 1
#define MK_MB_P 1
#define MK_MA_H 1
#define MK_MA_S 1
#endif
constexpr int HY_A1 = 256, HY_A2 = 384;
DI void hyena_range(const Args& a, LAS unsigned char* lds, int c_lo, int c_hi, int widx, int nw, int tid, int lane, int wave) {
    const int nch = c_hi - c_lo, nlines = nch / 64;
    if (nch % 64 == 0 && nw % 8 == 0 && nch % nw == 0 && 64 % (8 * nlines) == 0) { const int x = widx & 7, cnt = nch / nw, c0 = c_lo + x * 8 * nlines + (widx >> 3) * cnt;
        for (int c = 0; c < cnt; ++c) hyena_channel(a, lds, c0 + c, tid, lane, wave); }
    else for (int c = c_lo + widx; c < c_hi; c += nw) hyena_channel(a, lds, c, tid, lane, wave);
}
DI void ph_mixers_a(const Args& a, LAS unsigned char* lds, int tid, int lane, int wave, int bid, int G) {
    if (G == 256) { for (int rp = 0; rp < MK_MA_H; ++rp) { hyena_range(a, lds, 0, HY_A1, bid, G, tid, lane, wave); if (bid >= 128) hyena_range(a, lds, HY_A1, HY_A2, bid - 128, 128, tid, lane, wave); } }
    else hyena_range(a, lds, 0, 512, bid, G, tid, lane, wave);
    for (int it = bid; it < 384; it += G) { const bool smp = it < 256; const int rr = smp ? it : it - 256;
        for (int rp = 0; rp < MK_MA_S; ++rp)
        mlstm_state_unit(a, lds, smp ? 16 + (rr >> 6) : (rr >> 3), smp ? (rr >> 4) & 3 : (rr >> 1) & 3, smp ? (rr >> 3) & 1 : rr & 1, smp ? rr & 7 : 0, tid, lane, wave); }
}
DI void ph_mixers_b(const Args& a, LAS unsigned char* lds, int tid, int lane, int wave, int bid, int G) {
    if (G == 256 && bid >= 192) hyena_range(a, lds, HY_A2, 512, bid - 192, 64, tid, lane, wave);
    for (int it = bid; it < 192; it += G) { const bool smp = it < 128; const int rr = smp ? it : it - 128;
        for (int rp = 0; rp < (smp ? MK_MB_S : MK_MB_P); ++rp)
        mlstm_unit(a, lds, smp ? 16 + (rr >> 5) : (rr >> 2), smp ? (rr >> 3) & 3 : rr & 3, smp ? rr & 7 : 0, tid, lane, wave); }
}
DI void attn_unit(const Args& a, LAS unsigned char* lds, int kind, int b, int h, int blk, int tid, int lane, int wave) {
    unsigned char* ws = a.ws;
    const bf16* Q1 = (const bf16*)(ws + WS_Q1); const bf16* K1 = (const bf16*)(ws + WS_K1); const bf16* V1 = (const bf16*)(ws + WS_V1);
    const bf16* CK = (const bf16*)(ws + WS_CK); const bf16* CV = (const bf16*)(ws + WS_CV);
    bf16* obuf = (bf16*)(ws + WS_H);
    LAS bf16* Kst = (LAS bf16*)lds;
    LAS bf16* Vst = (LAS bf16*)(lds + 9216);
    LAS float* rpbs = (LAS float*)(lds + 18432);
    asm volatile("" : "+v"(lane), "+v"(tid));
    const int lt = lane & 31, hh = lane >> 5;
    int qrow, r = 0, qc = 0, nctx, nloc, kr_lo = 0, rs = 0, cs = 0;
    if (kind == 0) { qrow = b * 256 + 32 * wave + lt; nctx = 0; nloc = 4; }
    else { const int r0 = 4 * blk; r = r0 + (wave >> 1); qc = 32 * (wave & 1) + lt; qrow = MPR + b * 2048 + r * 64 + qc; nctx = 8;
        const int lo = r0 - 4 < 0 ? 0 : (r0 - 4 > 24 ? 24 : r0 - 4); const int r3 = r0 + 3 - 4; const int hi = (r3 < 0 ? 0 : (r3 > 24 ? 24 : r3)) + 7;
        kr_lo = lo; nloc = hi - lo + 1; rs = r - 4 < 0 ? 0 : (r - 4 > 24 ? 24 : r - 4); cs = qc - 8 < 0 ? 0 : (qc - 8 > 48 ? 48 : qc - 8);
        __syncthreads();
        if (tid < 465) rpbs[tid] = a.in[I_RPB][h * 465 + tid] * 1.4426950408889634f;
    }
    int icol[2][16]; unsigned okm[2] = {0u, 0u};
#pragma unroll
    for (int sub = 0; sub < 2; ++sub)
#pragma unroll
        for (int q = 0; q < 16; ++q) { const int kc = 32 * sub + (q & 3) + 8 * (q >> 2) + 4 * hh; int ic = kc - qc + 15; ic = ic < 0 ? 0 : (ic > 30 ? 30 : ic);
            icol[sub][q] = ic; okm[sub] |= ((kc >= cs) && (kc < cs + 16)) ? (1u << q) : 0u; }
    bf16x8 Qf[4];
#pragma unroll
    for (int i = 0; i < 4; ++i) Qf[i] = *(const bf16x8*)(Q1 + (size_t)qrow * 1024 + h * 64 + 16 * i + 8 * hh);
    f32x16 O[2];
#pragma unroll
    for (int eb = 0; eb < 2; ++eb)
#pragma unroll
        for (int q = 0; q < 16; ++q) O[eb][q] = 0.f;
    float mrun = -INFINITY, lrun = 0.f;
    const int kkey = tid >> 3, kch = tid & 7, vkey = tid & 63, vch = tid >> 6;
    u32x4 kreg, vreg;
#define ATT_SRC(st_, ksrc_, vsrc_, ld_) do { const bool ic_ = (st_) < nctx; const int kr_ = kr_lo + ((st_) - nctx); \
        if (ic_) { ksrc_ = CK + ((size_t)((b * 16 + h) * 512 + 64 * (st_))) * 64; vsrc_ = CV + ((size_t)((b * 16 + h) * 512 + 64 * (st_))) * 64; ld_ = 64; } \
        else if (kind == 0) { const size_t row0 = (size_t)b * 256 + 64 * (st_); ksrc_ = K1 + row0 * 1024 + h * 64; vsrc_ = V1 + row0 * 1024 + h * 64; ld_ = 1024; } \
        else { const size_t row0 = (size_t)MPR + b * 2048 + kr_ * 64; ksrc_ = K1 + row0 * 1024 + h * 64; vsrc_ = V1 + row0 * 1024 + h * 64; ld_ = 1024; } } while (0)
    { const bf16* ksrc; const bf16* vsrc; size_t ld; ATT_SRC(0, ksrc, vsrc, ld);
      kreg = *(const u32x4*)(ksrc + (size_t)kkey * ld + kch * 8); vreg = *(const u32x4*)(vsrc + (size_t)vkey * ld + vch * 8); }
#pragma unroll 1
    for (int st = 0; st < nctx + nloc; ++st) {
        const bool isctx = st < nctx; const int kr = kr_lo + (st - nctx);
        __syncthreads();
        *(LAS u32x4*)(Kst + kkey * 72 + kch * 8) = kreg;
        { LAS bf16* d = Vst + (vch * 8) * 72 + vkey;
          d[0] = (bf16)(vreg.x & 0xffffu); d[72] = (bf16)(vreg.x >> 16); d[144] = (bf16)(vreg.y & 0xffffu); d[216] = (bf16)(vreg.y >> 16);
          d[288] = (bf16)(vreg.z & 0xffffu); d[360] = (bf16)(vreg.z >> 16); d[432] = (bf16)(vreg.w & 0xffffu); d[504] = (bf16)(vreg.w >> 16); }
        if (st + 1 < nctx + nloc) { const bf16* ksrc; const bf16* vsrc; size_t ld; ATT_SRC(st + 1, ksrc, vsrc, ld);
            kreg = *(const u32x4*)(ksrc + (size_t)kkey * ld + kch * 8); vreg = *(const u32x4*)(vsrc + (size_t)vkey * ld + vch * 8); }
        __syncthreads();
        const bool active = (kind == 0) || isctx || (kr >= rs && kr < rs + 8);
        if (active) {
#pragma unroll
            for (int sub = 0; sub < 2; ++sub) {
                f32x16 S;
#pragma unroll
                for (int q = 0; q < 16; ++q) S[q] = 0.f;
#pragma unroll
                for (int i = 0; i < 4; ++i) { const bf16x8 kf = *(const LAS bf16x8*)(Kst + (32 * sub + lt) * 72 + 16 * i + 8 * hh); S = MFMA32(kf, Qf[i], S); }
                if (kind == 1 && !isctx) {
                    const LAS float* rb = rpbs + (kr - r + 7) * 31;
                    float bv[16];
#pragma unroll
                    for (int q = 0; q < 16; ++q) bv[q] = rb[icol[sub][q]];
#pragma unroll
                    for (int q = 0; q < 16; ++q) S[q] = ((okm[sub] >> q) & 1u) ? S[q] + bv[q] : -INFINITY;
                }
                float mx = fmaxf(fmaxf(fmaxf(S[0], S[1]), fmaxf(S[2], S[3])), fmaxf(fmaxf(S[4], S[5]), fmaxf(S[6], S[7])));
                mx = fmaxf(mx, fmaxf(fmaxf(fmaxf(S[8], S[9]), fmaxf(S[10], S[11])), fmaxf(fmaxf(S[12], S[13]), fmaxf(S[14], S[15]))));
                { const auto sw_ = __builtin_amdgcn_permlane32_swap(__float_as_uint(mx), __float_as_uint(mx), false, false); mx = fmaxf(__uint_as_float(sw_[0]), __uint_as_float(sw_[1])); }
                if (!__all(mx <= mrun + 8.f)) { const float mnew = fmaxf(mrun, mx); const float alpha = exp2_f(mrun - mnew);
                    lrun *= alpha; mrun = mnew;
#pragma unroll
                    for (int eb = 0; eb < 2; ++eb)
#pragma unroll
                        for (int q = 0; q < 16; ++q) O[eb][q] *= alpha; }
                float ps = 0.f;
#pragma unroll
                for (int q = 0; q < 16; ++q) { const float p = exp2_f(S[q] - mrun); S[q] = p; ps += p; }
                lrun += ps;
                const bf16x8 P0 = pack_frag(S, 0), P1 = pack_frag(S, 1);
#pragma unroll
                for (int eb = 0; eb < 2; ++eb) {
                    O[eb] = MFMA32(ld_vfrag(Vst, 32 * eb + lt, 32 * sub + 4 * hh), P0, O[eb]);
                    O[eb] = MFMA32(ld_vfrag(Vst, 32 * eb + lt, 32 * sub + 16 + 4 * hh), P1, O[eb]); }
            }
        }
    }
    const float inv = 1.f / (lrun + __shfl_xor(lrun, 32));
    bf16* op = obuf + (size_t)qrow * 1024 + h * 64;
#pragma unroll
    for (int eb = 0; eb < 2; ++eb)
#pragma unroll
        for (int g = 0; g < 4; ++g) { u32x2 w; w.x = pk2(O[eb][4 * g] * inv, O[eb][4 * g + 1] * inv); w.y = pk2(O[eb][4 * g + 2] * inv, O[eb][4 * g + 3] * inv);
            *(u32x2*)(op + 32 * eb + 8 * g + 4 * hh) = w; }
    __syncthreads();
#undef ATT_SRC
}
#ifndef MK_AT_N
#define MK_AT_N 1
#define MK_AT_C 1
#endif
DI void ph_attention(const Args& a, LAS unsigned char* lds, int tid, int lane, int wave, int bid, int G) {
    for (int it = bid; it < 768; it += G) {
        if (it < 512) { for (int rp = 0; rp < MK_AT_N; ++rp) attn_unit(a, lds, 1, it >> 7, (it >> 3) & 15, it & 7, tid, lane, wave); }
        else { const int r = it - 512; for (int rp = 0; rp < MK_AT_C; ++rp) attn_unit(a, lds, 0, r >> 4, r & 15, 0, tid, lane, wave); }
    }
}
DI void cache_out(const Args& a, int widx, int nw, int tid) {
    const bf16* K1 = (const bf16*)(a.ws + WS_K1); const bf16* V1 = (const bf16*)(a.ws + WS_V1);
    for (int i = widx * NTHR + tid; i < 2 * MPR * 128; i += nw * NTHR) { const int ten = i >= MPR * 128, j = ten ? i - MPR * 128 : i, row = j >> 7, c8 = (j & 127) * 8;
        float f[8]; unpack8(*(const u32x4*)((ten ? V1 : K1) + (size_t)row * 1024 + c8), f);
        const int hh = c8 >> 6, d = c8 & 63, b = row >> 8, tt = row & 255;
        float* p = a.out + (ten ? OFF_V : OFF_K) + ((size_t)((b * 16 + hh) * 256 + tt)) * 64 + d;
        *(f32x4*)p = (f32x4){f[0], f[1], f[2], f[3]}; *(f32x4*)(p + 4) = (f32x4){f[4], f[5], f[6], f[7]}; }
}
__global__ void __launch_bounds__(NTHR, 2) mk_fwd(Args a) {
    extern __shared__ __attribute__((aligned(16))) unsigned char lds_raw[];
    LAS unsigned char* lds = (LAS unsigned char*)lds_raw;
    const int tid = threadIdx.x, lane = tid & 63, wave = __builtin_amdgcn_readfirstlane(tid >> 6), bid = blockIdx.x, G = gridDim.x;
    const int gw = bid * NWAVES + wave, NGW = G * NWAVES;
    unsigned char* ws = a.ws;
    for (int u = tid; u < (LDS_BYTES - LDSCTL_OFF) / 4; u += NTHR) ((LAS unsigned*)(lds + LDSCTL_OFF))[u] = 0u;
    __syncthreads();
    XcdBarrier bar; bar.bar = (unsigned*)(ws + WS_CTL) + CW_BAR; bar.x = 0; bar.st = nullptr;
    const bool multi = (a.ph_hi - a.ph_lo) > 1;
    if (multi) bar = xcd_barrier_post((unsigned*)(ws + WS_CTL) + CW_BAR, (volatile LAS unsigned*)(lds + MISC_OFF) + 8);
    float* out = a.out;
    float* modF = (float*)(ws + WS_MODF);
    bf16* hbuf = (bf16*)(ws + WS_H);
    bf16* dlt = (bf16*)(ws + WS_DL);
    bf16* xbf = (bf16*)(ws + WS_XBF);
    const float* xsB = a.in[I_XS] - (size_t)MPR * D;
    const int lo = a.ph_lo, hi = a.ph_hi;
#ifndef MK_ALIGN
#define MK_ALIGN true
#endif
#ifndef MK_SP2
#define MK_SP2 true
#endif
#ifndef MK_ONLY
#define MK_ONLY -1
#endif
#define IN(k) ((MK_ONLY < 0 || MK_ONLY == (k)) && lo <= (k) && (k) < hi)
#define SEAM(k) do { if ((k) + 1 < hi) xcd_barrier(bar); } while (0)
#ifndef MK_REPMASK
#define MK_REPMASK 0u
#endif
#define MK_REP(k) (((MK_REPMASK >> (k)) & 1u) ? 2 : 1)
#define PH(k, ...) if (IN(k)) { if (MK_REP(k) == 2) { __VA_ARGS__ xcd_barrier(bar); } { __VA_ARGS__ } SEAM(k); }
#define GEMM_UP(l) do { pg8::Gemm g{hbuf, (const bf16*)(ws + WS_WUP) + (size_t)(l) * 5632 * 1024, M, 2 * FF, D}; pg8::StaticOrder S; S.init(M, 2 * FF, G, bid); \
            pg8::EpiFfn E{(bf16*)(ws + WS_FG), a.in[I_WCFFN] + (size_t)(l) * 3 * FF, (float*)(ws + WS_ABND), (float*)(ws + WS_GBND), (LAS float*)(lds + XCH_OFF)}; \
            pg8::gemm_phase<pg8::EpiFfn, pg8::StaticOrder, MK_ALIGN, MK_SP2>(lds, g, S, E); } while (0)
#define GEMM_DOWN(l) do { pg8::Gemm g{(const bf16*)(ws + WS_FG), (const bf16*)(ws + WS_WDN) + (size_t)(l) * 1024 * FF, M, D, FF}; pg8::StaticOrder S; S.init(M, D, G, bid); \
            { pg8::Unit u_; for (int i_ = 0; S.next(i_, u_); ++i_) ffn_fix_panel(a, (l), u_.pm, tid); }     \
            pg8::EpiDelta E{dlt, modF + (size_t)(l) * 5 * 6144 + 5 * 1024}; \
            pg8::gemm_phase<pg8::EpiDelta, pg8::StaticOrder, MK_ALIGN, MK_SP2>(lds, g, S, E); } while (0)
    PH(0, ph_prologue(a, lds, tid, lane, wave, bid, G);)
    PH(1, ph_modf_norm0(a, lds, tid, lane, wave, bid, G);)
    PH(2, { pg8::Gemm g{hbuf, (const bf16*)(ws + WS_WAB), M, NPROJ, D}; pg8::StaticOrder S; S.init(M, NPROJ, G, bid);
            pg8::EpiInAB E{(bf16*)(ws + WS_QB), (bf16*)(ws + WS_VO), (float*)(ws + WS_GATES), a.in[I_WCQK], (float*)(ws + WS_QKBND), (LAS float*)(lds + XCH_OFF)};
            pg8::gemm_phase<pg8::EpiInAB, pg8::StaticOrder, MK_ALIGN, MK_SP2>(lds, g, S, E); }
          {
            pg8::Gemm g{(const bf16*)(ws + WS_WHY), hbuf, 1536, M, D}; pg8::StaticOrder S; const int nA = (M / 256) * (NPROJ / 256); S.init(1536, M, G, (bid + G - (nA % G)) % G);
            pg8::EpiBf16<0> E{(bf16*)(ws + WS_HYT), M, nullptr, 0, 0, 1.f};
            pg8::gemm_phase<pg8::EpiBf16<0>, pg8::StaticOrder, MK_ALIGN, MK_SP2>(lds, g, S, E); })
    PH(3, ph_e1(a, lds, tid, gw, NGW, lane, wave, bid, G);)
    PH(4, ph_mixers_a(a, lds, tid, lane, wave, bid, G);)
    PH(5, ph_mixers_b(a, lds, tid, lane, wave, bid, G);)
    PH(6, pg8::Gemm g{hbuf, (const bf16*)(ws + WS_WOAB), M, D, D}; pg8::StaticOrder S; S.init(M, D, G, bid);
            pg8::EpiDelta E{dlt, modF + 2 * 1024};
            pg8::gemm_phase<pg8::EpiDelta, pg8::StaticOrder, MK_ALIGN, MK_SP2>(lds, g, S, E);
            { const int busy = (M / 256) * (D / 256); if (G > busy) { if (bid >= busy) bg_convert(a, lds, 1, bid - busy, G - busy, tid); } else bg_convert(a, lds, 1, bid, G, tid); })
    PH(7, ph_norm(a.in[I_XP], xsB, dlt, xbf, a.in[I_GFFN], modF, 3, 4, hbuf, gw, NGW, lane);)
    PH(8, GEMM_UP(0);)
    PH(9, GEMM_DOWN(0); { const int busy = (M / 256) * (D / 256); if (G > busy) { if (bid >= busy) bg_convert(a, lds, 2, bid - busy, G - busy, tid); } else bg_convert(a, lds, 2, bid, G, tid); })
    PH(10, ph_norm(nullptr, nullptr, dlt, xbf, a.in[I_GMIX] + D, modF + 5 * 6144, 0, 1, hbuf, gw, NGW, lane);)
    PH(11, pg8::Gemm g{hbuf, (const bf16*)(ws + WS_WC), M, 3 * D, D}; pg8::StaticOrder S; S.init(M, 3 * D, G, bid);
            pg8::EpiQKV E{(bf16*)(ws + WS_Q1), (size_t)(WS_K1 - WS_Q1) / 2};
            pg8::gemm_phase<pg8::EpiQKV, pg8::StaticOrder, MK_ALIGN, MK_SP2>(lds, g, S, E);
            { const int nt_ = (M / 256) * (3 * D / 256), full = nt_ % G; if (full > 0 && full < G) { if (bid >= full) bg_convert(a, lds, 3, bid - full, G - full, tid); } else bg_convert(a, lds, 3, bid, G, tid); })
    PH(12, ph_attention(a, lds, tid, lane, wave, bid, G);)
    PH(13, pg8::Gemm g{hbuf, (const bf16*)(ws + WS_WOC), M, D, D}; pg8::StaticOrder S; S.init(M, D, G, bid);
            pg8::EpiDelta E{dlt, modF + 5 * 6144 + 2 * 1024};
            pg8::gemm_phase<pg8::EpiDelta, pg8::StaticOrder, MK_ALIGN, MK_SP2>(lds, g, S, E);
            { const int busy = (M / 256) * (D / 256); if (G > busy) { if (bid >= busy) cache_out(a, bid - busy, G - busy, tid); } else cache_out(a, bid, G, tid); })
    PH(14, ph_norm(nullptr, nullptr, dlt, xbf, a.in[I_GFFN] + D, modF + 5 * 6144, 3, 4, hbuf, gw, NGW, lane);)
    PH(15, GEMM_UP(1);)
    PH(16, GEMM_DOWN(1);)
    PH(17, ph_final_norm(out, xbf, dlt, a.in[I_GFIN], gw, NGW, lane);)
#undef IN
#undef SEAM
}
}

extern "C" void kernel_launch(void* const* d_in, const int* in_sizes, int n_in, void* d_out, int out_size, void* d_ws, size_t ws_size, hipStream_t stream) {
    using namespace mk;
    static int grid = 0;
    if (grid == 0) {
        if (n_in != 33 || out_size != 23085184 || ws_size < WS_END) { fprintf(stderr, "kernel_launch: unexpected shapes: n_in %d out %d ws %zu\n", n_in, out_size, ws_size); grid = -1; return; }
        int dev = 0, cus = 0, per_cu = 0;
        if (hipGetDevice(&dev) != hipSuccess || hipDeviceGetAttribute(&cus, hipDeviceAttributeMultiprocessorCount, dev) != hipSuccess) { grid = -1; return; }
        if (hipFuncSetAttribute((const void*)mk_fwd, hipFuncAttributeMaxDynamicSharedMemorySize, LDS_BYTES) != hipSuccess) { fprintf(stderr, "kernel_launch: hipFuncSetAttribute failed\n"); grid = -1; return; }
        if (hipOccupancyMaxActiveBlocksPerMultiprocessor(&per_cu, (const void*)mk_fwd, NTHR, LDS_BYTES) != hipSuccess || per_cu < 1) { fprintf(stderr, "kernel_launch: occupancy query says %d\n", per_cu); per_cu = 1; }
        (void)hipGetLastError();
        grid = cus;
    }
    if (grid < 0) return;
    if (hipMemsetAsync((char*)d_ws + WS_CTL, 0, CTL_ZERO_BYTES, stream) != hipSuccess) return;
    Args a{};
    for (int i = 0; i < 33; ++i) a.in[i] = (const float*)d_in[i];
    a.out = (float*)d_out; a.ws = (unsigned char*)d_ws;
#if MK_ONE_LAUNCH
    a.ph_lo = 0; a.ph_hi = NPHASES;
    { void* args[] = {&a};
      hipError_t e = hipLaunchCooperativeKernel((const void*)mk_fwd, dim3(grid), dim3(NTHR), args, LDS_BYTES, stream);
      if (e != hipSuccess) fprintf(stderr, "kernel_launch: cooperative launch failed: %s (grid %d)\n", hipGetErrorString(e), grid); }
#else
    for (int ph = 0; ph < NPHASES; ++ph) { a.ph_lo = ph; a.ph_hi = ph + 1; hipLaunchKernelGGL(mk_fwd, dim3(grid), dim3(NTHR), LDS_BYTES, stream, a); }
#endif
}
```
